# Optimizing an MI355X kernel written in HIP

```python
import math
import jax, jax.numpy as jnp
from jax import lax
import numpy as np

D_MODEL = 1024
BATCH = 8
SEQ = 8192
DEPTH = 2

N_MIXERS = 2
HGRN_EXPAND = 128
HGRN_HEADS = D_MODEL // HGRN_EXPAND
HGRN_CHUNK = 64
DIFF_HEADS = 8
DIFF_HEAD_DIM = D_MODEL // DIFF_HEADS // 2
Q_BLOCK = 128
FFN_DIM = 2816
N_EXPERTS = 8
TOP_K = 2
EXPERT_DIM = 3584
MOE_SEQ_BLOCK = 128
NORM_EPS = 1e-6

kernel_name = "hgrn2_diffattn_moe_hybrid"

F32 = jnp.float32


def rms_norm(x, g):
    xf = x.astype(F32)
    y = xf * lax.rsqrt(jnp.mean(xf * xf, axis=-1, keepdims=True) + NORM_EPS)
    return (y * g.astype(F32)).astype(x.dtype)


def diff_lambda_init(layer_idx):
    return 0.8 - 0.6 * math.exp(-0.3 * layer_idx)


def alibi_slopes(n_heads):
    return 2.0 ** (-8.0 * jnp.arange(1, n_heads + 1, dtype=F32) / n_heads)


def hgrn2_mixer(h, w_in, out_norm, w_out, lower_bound):
    B, T, _ = h.shape
    H, dh, C = HGRN_HEADS, HGRN_EXPAND, HGRN_CHUNK
    nC = T // C
    q, f, v, g = jnp.split(h @ w_in, 4, axis=-1)
    q = jax.nn.silu(q.astype(F32))
    lb = lower_bound.astype(F32)
    forget = lb + (1.0 - lb) * jax.nn.sigmoid(f.astype(F32))
    k = 1.0 - forget
    log_f = jnp.log(forget)

    def chunks(a):
        return a.astype(F32).reshape(B, nC, C, H, dh).transpose(1, 0, 3, 2, 4)

    causal = jnp.tril(jnp.ones((C, C), dtype=bool))[None, None, :, :, None]

    def step(S, inp):
        qc, kc, vc, lc = inp
        b = jnp.cumsum(lc, axis=2)
        rel = b[:, :, :, None, :] - b[:, :, None, :, :]
        decay = jnp.exp(jnp.where(causal, rel, -jnp.inf))
        scores = jnp.einsum('bhtk,bhsk,bhtsk->bhts', qc, kc, decay)
        o = (jnp.einsum('bhts,bhsv->bhtv', scores, vc)
             + jnp.einsum('bhtk,bhkv->bhtv', qc * jnp.exp(b), S))
        b_end = b[:, :, -1:, :]
        S = (jnp.exp(b_end[:, :, 0, :])[..., None] * S
             + jnp.einsum('bhsk,bhsv->bhkv', kc * jnp.exp(b_end - b), vc))
        return S, o

    S0 = jnp.zeros((B, H, dh, dh), F32)
    _, o = lax.scan(step, S0, (chunks(q), chunks(k), chunks(v), chunks(log_f)))
    o = o.transpose(1, 0, 3, 2, 4).reshape(B, T, H, dh)
    o = rms_norm(o, out_norm.reshape(H, dh)) * jax.nn.silu(g.astype(F32)).reshape(B, T, H, dh)
    return o.reshape(B, T, D_MODEL).astype(h.dtype) @ w_out


def diff_attention_mixer(h, w_in, q_norm, k_norm, lq1, lk1, lq2, lk2, sub_norm, w_out, lambda_init):
    B, T, _ = h.shape
    H, dh, QB = DIFF_HEADS, DIFF_HEAD_DIM, Q_BLOCK
    nQ = T // QB
    q, k, v = jnp.split(h @ w_in, 3, axis=-1)
    q = rms_norm(q.reshape(B, T, H, 2, dh), q_norm)
    k = rms_norm(k.reshape(B, T, H, 2, dh), k_norm)
    v = v.reshape(B, T, H, 2 * dh)
    lam = (jnp.exp(jnp.sum(lq1.astype(F32) * lk1.astype(F32)))
           - jnp.exp(jnp.sum(lq2.astype(F32) * lk2.astype(F32))) + lambda_init)
    k_t = k.transpose(0, 2, 3, 1, 4).astype(F32)
    v_t = v.transpose(0, 2, 1, 3).astype(F32)
    q_blocks = q.reshape(B, nQ, QB, H, 2, dh).transpose(1, 0, 3, 4, 2, 5).astype(F32)
    slopes = alibi_slopes(H)[None, :, None, None, None]
    key_pos = jnp.arange(T)
    scale = dh ** -0.5

    def attend(args):
        qb, blk = args
        dist = (blk * QB + jnp.arange(QB))[:, None] - key_pos[None, :]
        logits = (jnp.einsum('bhcqd,bhckd->bhcqk', qb, k_t) * scale
                  - slopes * dist.astype(F32))
        logits = jnp.where(dist >= 0, logits, -jnp.inf)
        p = jax.nn.softmax(logits, axis=-1)
        w = p[:, :, 0] - lam * p[:, :, 1]
        return jnp.einsum('bhqk,bhkv->bhqv', w, v_t)

    o = lax.map(attend, (q_blocks, jnp.arange(nQ)))
    o = o.transpose(1, 0, 3, 2, 4).reshape(B, T, H, 2 * dh)
    o = rms_norm(o, sub_norm) * (1.0 - lambda_init)
    return o.reshape(B, T, D_MODEL).astype(h.dtype) @ w_out


def swiglu(h, w_gate_up, w_down):
    a, b = jnp.split(h @ w_gate_up, 2, axis=-1)
    return (jax.nn.silu(a) * b) @ w_down


def moe_swiglu(h, router, w_gate_up, w_down):
    B, T, Dm = h.shape
    nb = T // MOE_SEQ_BLOCK
    logits = (h @ router).astype(F32)
    top_val, top_idx = lax.top_k(logits, TOP_K)
    top_w = jax.nn.softmax(top_val, axis=-1)
    gates = jnp.sum(jax.nn.one_hot(top_idx, N_EXPERTS, dtype=F32) * top_w[..., None], axis=-2)

    def block(args):
        xb, gb = args
        a, b = jnp.split(jnp.einsum('bnd,edf->ebnf', xb, w_gate_up), 2, axis=-1)
        y = jnp.einsum('ebnf,efd->ebnd', jax.nn.silu(a) * b, w_down)
        return jnp.einsum('ebnd,bne->bnd', y, gb.astype(y.dtype))

    xs = h.reshape(B, nb, MOE_SEQ_BLOCK, Dm).transpose(1, 0, 2, 3)
    gs = gates.reshape(B, nb, MOE_SEQ_BLOCK, N_EXPERTS).transpose(1, 0, 2, 3)
    y = lax.map(block, (xs, gs))
    return y.transpose(1, 0, 2, 3).reshape(B, T, Dm)


def setup_inputs(seed: int = 0) -> dict:
    key = jax.random.key(seed)
    ks = jax.random.split(key, 24)
    D = D_MODEL
    nrm = lambda k, shape, s: jax.random.normal(k, shape, F32) * s
    gain = lambda k, n: 1.0 + 0.02 * jax.random.normal(k, (n,), F32)
    return {
        "x": jax.random.normal(ks[0], (BATCH, SEQ, D), F32),
        "lower_bounds": nrm(ks[1], (DEPTH + 1, D), 0.1),
        "l0_mix_norm": gain(ks[2], D),
        "l0_hgrn_w_in": nrm(ks[3], (D, 4 * D), D ** -0.5),
        "l0_hgrn_out_norm": gain(ks[4], D),
        "l0_hgrn_w_out": nrm(ks[5], (D, D), D ** -0.5),
        "l0_ffn_norm": gain(ks[6], D),
        "l0_ffn_w_gate_up": nrm(ks[7], (D, 2 * FFN_DIM), D ** -0.5),
        "l0_ffn_w_down": nrm(ks[8], (FFN_DIM, D), FFN_DIM ** -0.5),
        "l1_mix_norm": gain(ks[9], D),
        "l1_diff_w_in": nrm(ks[10], (D, 3 * D), D ** -0.5),
        "l1_q_norm": gain(ks[11], DIFF_HEAD_DIM),
        "l1_k_norm": gain(ks[12], DIFF_HEAD_DIM),
        "l1_lambda_q1": nrm(ks[13], (DIFF_HEAD_DIM,), 0.1),
        "l1_lambda_k1": nrm(ks[14], (DIFF_HEAD_DIM,), 0.1),
        "l1_lambda_q2": nrm(ks[15], (DIFF_HEAD_DIM,), 0.1),
        "l1_lambda_k2": nrm(ks[16], (DIFF_HEAD_DIM,), 0.1),
        "l1_diff_sub_norm": gain(ks[17], 2 * DIFF_HEAD_DIM),
        "l1_diff_w_out": nrm(ks[18], (D, D), D ** -0.5),
        "l1_ffn_norm": gain(ks[19], D),
        "l1_router": nrm(ks[20], (D, N_EXPERTS), D ** -0.5),
        "l1_moe_w_gate_up": nrm(ks[21], (N_EXPERTS, D, 2 * EXPERT_DIM), D ** -0.5),
        "l1_moe_w_down": nrm(ks[22], (N_EXPERTS, EXPERT_DIM, D), EXPERT_DIM ** -0.5),
    }


def reference(x, lower_bounds, l0_mix_norm, l0_hgrn_w_in, l0_hgrn_out_norm, l0_hgrn_w_out,
              l0_ffn_norm, l0_ffn_w_gate_up, l0_ffn_w_down, l1_mix_norm, l1_diff_w_in,
              l1_q_norm, l1_k_norm, l1_lambda_q1, l1_lambda_k1, l1_lambda_q2, l1_lambda_k2,
              l1_diff_sub_norm, l1_diff_w_out, l1_ffn_norm, l1_router, l1_moe_w_gate_up,
              l1_moe_w_down):
    lb_all = jnp.cumsum(jax.nn.softmax(lower_bounds.astype(F32), axis=0), axis=0)
    layers = [
        dict(mix_norm=l0_mix_norm, ffn_norm=l0_ffn_norm,
             mixer=(l0_hgrn_w_in, l0_hgrn_out_norm, l0_hgrn_w_out),
             ffn=(l0_ffn_w_gate_up, l0_ffn_w_down)),
        dict(mix_norm=l1_mix_norm, ffn_norm=l1_ffn_norm,
             mixer=(l1_diff_w_in, l1_q_norm, l1_k_norm, l1_lambda_q1, l1_lambda_k1,
                    l1_lambda_q2, l1_lambda_k2, l1_diff_sub_norm, l1_diff_w_out),
             ffn=(l1_router, l1_moe_w_gate_up, l1_moe_w_down)),
    ]
    h = x
    for i in range(DEPTH):
        p = layers[i]
        hn = rms_norm(h, p["mix_norm"])
        if i % N_MIXERS == 0:
            h = h + hgrn2_mixer(hn, *p["mixer"], lb_all[i])
        else:
            h = h + diff_attention_mixer(hn, *p["mixer"], diff_lambda_init(i))
        hn = rms_norm(h, p["ffn_norm"])
        if i % 2 == 0:
            h = h + swiglu(hn, *p["ffn"])
        else:
            h = h + moe_swiglu(hn, *p["ffn"])
    return h
```

```cpp
#include <hip/hip_runtime.h>
#include <cstdio>
#include <cstdint>
#include <cmath>
namespace pg8 {
#define PG8_LAS __attribute__((address_space(3)))
typedef unsigned short bf16_t;
typedef short bf16x8 __attribute__((ext_vector_type(8)));
typedef float f32x4 __attribute__((ext_vector_type(4)));
typedef unsigned u32x4 __attribute__((ext_vector_type(4)));
constexpr int BM = 256, BK = 64, HALF = 128, HTB = HALF * BK * 2  , STAGE_BYTES = 8 * HTB, NXCD = 8, WGM = 8;

__host__ __device__ __forceinline__ int lds_byte(int r, int c) { const int st = (r >> 4) * 2 + (c >> 5), rr = r & 15, cc = c & 31, ob = rr * 64 + cc * 2; return st * 1024 + (ob ^ (((ob >> 9) & 1) << 5)); }
__host__ __device__ __forceinline__ void stage_rc(int b, int& R, int& C) { const int st = b / 1024, sb = b % 1024, swz = sb ^ (((sb >> 9) & 1) << 5); R = (st >> 1) * 16 + swz / 64; C = (st & 1) * 32 + (swz % 64) / 2; }
__host__ __device__ __forceinline__ int perm32(int rho) { const int n = rho >> 4, i = rho & 15; return 8 * (i >> 2) + 4 * n + (i & 3); }

struct Unit { int pm, pn; };
struct Gemm { const bf16_t* A; const bf16_t* Bt; int M, N, K; };

struct StaticOrder {
    int nM, nN, nwg, G, c;
    __host__ __device__ void init(int M, int N, int G_, int c_) { nM = M / BM; nN = N / BM; nwg = nM * nN; G = G_; c = c_; }
    __host__ __device__ bool next(int i, Unit& u) const {
        const long L = (long)i * G + c; if (L >= nwg) return false;
        int wgid = (int)L; { const int q = nwg / NXCD, r = nwg % NXCD, xcd = wgid % NXCD, off = wgid / NXCD; wgid = (xcd < r ? xcd * (q + 1) : r * (q + 1) + (xcd - r) * q) + off; }
        const int nig = WGM * nN, gid = wgid / nig, fm = gid * WGM, gsz = (nM - fm) < WGM ? (nM - fm) : WGM;
        u.pm = fm + ((wgid % nig) % gsz); u.pn = (wgid % nig) / gsz; return true;
    }
    __device__ __forceinline__ void a_ready(const Unit&) const {}
    __device__ __forceinline__ void done(const Unit&) const {}
};

__device__ __forceinline__ unsigned cvt_pk_bf16(float lo, float hi) { unsigned r; asm volatile("v_cvt_pk_bf16_f32 %0, %1, %2" : "=v"(r) : "v"(lo), "v"(hi)); return r; }
typedef float f32x2 __attribute__((ext_vector_type(2)));

template <class Epi, class Sched, bool ALIGN_EPI = false, bool SP2 = false>
__device__ __forceinline__ void gemm_phase(PG8_LAS unsigned char* lds, const Gemm g, const Sched& S, const Epi& E) {
    const int tid = threadIdx.x, wid = __builtin_amdgcn_readfirstlane(tid >> 6), lane = tid & 63, wr = wid >> 2, wc = wid & 3, fr = lane & 15, fq = lane >> 4;
    const int K = g.K, nt = K / BK;
    unsigned voffA[2], voffB[2];
#pragma unroll
    for (int i = 0; i < 2; ++i) { int R, C; stage_rc(tid * 16 + i * 8192, R, C); const int Rb = Epi::PERM ? ((R & ~31) + perm32(R & 31)) : R;
        voffA[i] = (unsigned)(R * K + C) * 2u; voffB[i] = (unsigned)(Rb * K + C) * 2u; }
    const size_t kstep = (size_t)(BK * 2);
    const size_t hstep = (size_t)HALF * K * 2;
    const size_t tstep = 2 * hstep;
    const unsigned ldsw = (unsigned)wid * 1024u;
    const int aoff = lds_byte(wr * 64 + fr, fq * 8), boff = lds_byte(wc * 32 + fr, fq * 8);
#define PG8_SA(b, h) (((b) * 2 + (h)) * HTB)
#define PG8_SB(b, h) ((4 + (b) * 2 + (h)) * HTB)
#define PG8_STAGE(bufoff, gbase, voff) do { _Pragma("unroll") for (int _i = 0; _i < 2; ++_i) \
        __builtin_amdgcn_global_load_lds((const unsigned*)((const char*)(gbase) + (voff)[_i]), (PG8_LAS unsigned*)(lds + (bufoff) + ldsw + _i * 8192), 16, 0, 0); } while (0)
#define PG8_LDA(dst, b, h) do { _Pragma("unroll") for (int m = 0; m < 4; ++m) _Pragma("unroll") for (int k = 0; k < 2; ++k) dst[m][k] = *(const PG8_LAS bf16x8*)(lds + PG8_SA(b, h) + aoff + m * 2048 + k * 1024); } while (0)
#define PG8_LDB(dst, b, h) do { _Pragma("unroll") for (int n = 0; n < 2; ++n) _Pragma("unroll") for (int k = 0; k < 2; ++k) dst[n][k] = *(const PG8_LAS bf16x8*)(lds + PG8_SB(b, h) + boff + n * 2048 + k * 1024); } while (0)
#define PG8_MMA(ai, bj, At, Bt) do { __builtin_amdgcn_s_setprio(1); _Pragma("unroll") for (int m = 0; m < 4; ++m) _Pragma("unroll") for (int n = 0; n < 2; ++n) _Pragma("unroll") for (int k = 0; k < 2; ++k) \
        acc[ai][bj][m][n] = __builtin_amdgcn_mfma_f32_16x16x32_bf16(Bt[n][k], At[m][k], acc[ai][bj][m][n], 0, 0, 0); __builtin_amdgcn_s_setprio(0); } while (0)
#define PG8_WAIT_V(n) asm volatile("s_waitcnt vmcnt(" #n ")" ::: "memory")
#define PG8_WAIT_L(n) asm volatile("s_waitcnt lgkmcnt(" #n ")" ::: "memory")
#define PG8_BAR __builtin_amdgcn_s_barrier()
#define PG8_SCHED __builtin_amdgcn_sched_barrier(0)
    Unit cur, nxt; int ui = 0;
    if (!S.next(0, cur)) return;
    f32x4 acc[2][2][4][2];
#pragma unroll
    for (int a = 0; a < 2; ++a)
#pragma unroll
        for (int b = 0; b < 2; ++b)
#pragma unroll
            for (int m = 0; m < 4; ++m)
#pragma unroll
                for (int n = 0; n < 2; ++n) acc[a][b][m][n] = (f32x4){0.f, 0.f, 0.f, 0.f};
    bf16x8 At[4][2], B0[2][2], B1[2][2];
    const char* cA = (const char*)g.A + (size_t)cur.pm * tstep; const char* cB = (const char*)g.Bt + (size_t)cur.pn * tstep;
    S.a_ready(cur);
    if constexpr (SP2) {
        PG8_STAGE(PG8_SB(0, 0), cB, voffB); PG8_STAGE(PG8_SB(0, 1), cB + hstep, voffB); PG8_STAGE(PG8_SA(0, 0), cA, voffA); PG8_STAGE(PG8_SA(0, 1), cA + hstep, voffA);
        if (wr == 1) PG8_BAR;
        PG8_WAIT_V(2); PG8_BAR;
        PG8_STAGE(PG8_SB(1, 0), cB + kstep, voffB); PG8_STAGE(PG8_SA(1, 0), cA + kstep, voffA); PG8_STAGE(PG8_SB(1, 1), cB + hstep + kstep, voffB);
        PG8_WAIT_V(6); PG8_BAR;
    } else {
        PG8_STAGE(PG8_SB(0, 0), cB, voffB); PG8_STAGE(PG8_SA(0, 0), cA, voffA); PG8_STAGE(PG8_SB(0, 1), cB + hstep, voffB); PG8_STAGE(PG8_SA(0, 1), cA + hstep, voffA);
        if (wr == 1) PG8_BAR;
        PG8_WAIT_V(4); PG8_BAR;
        PG8_STAGE(PG8_SB(1, 0), cB + kstep, voffB); PG8_STAGE(PG8_SA(1, 0), cA + kstep, voffA); PG8_STAGE(PG8_SB(1, 1), cB + hstep + kstep, voffB);
        PG8_WAIT_V(6); PG8_BAR;
    }
    for (;;) {
        const bool has_next = S.next(ui + 1, nxt);
        const char* nA = has_next ? (const char*)g.A + (size_t)nxt.pm * tstep : cA; const char* nB = has_next ? (const char*)g.Bt + (size_t)nxt.pn * tstep : cB;
        for (int t = 0; t < nt; t += 2) {
            const bool last = (t == nt - 2);
            const char* a1 = cA + (size_t)(t + 1) * kstep;
            const char* a2 = last ? nA : cA + (size_t)(t + 2) * kstep; const char* b2 = last ? nB : cB + (size_t)(t + 2) * kstep;
            const char* a3 = a2 + kstep; const char* b3 = b2 + kstep;
            if (last && has_next) S.a_ready(nxt);
            if constexpr (SP2) {
            PG8_LDB(B0, 0, 0); PG8_LDB(B1, 0, 1); PG8_SCHED; PG8_LDA(At, 0, 0); PG8_STAGE(PG8_SA(1, 1), a1 + hstep, voffA);
            PG8_WAIT_V(8); PG8_WAIT_L(0); PG8_BAR; PG8_MMA(0, 0, At, B0); PG8_MMA(0, 1, At, B1); PG8_BAR; PG8_SCHED;
            PG8_LDA(At, 0, 1); PG8_STAGE(PG8_SB(0, 0), b2, voffB); PG8_STAGE(PG8_SB(0, 1), b2 + hstep, voffB); PG8_STAGE(PG8_SA(0, 0), a2, voffA);
            PG8_WAIT_V(8); PG8_WAIT_L(0); PG8_BAR; PG8_MMA(1, 0, At, B0); PG8_MMA(1, 1, At, B1); PG8_BAR; PG8_SCHED;
            PG8_LDB(B0, 1, 0); PG8_LDB(B1, 1, 1); PG8_SCHED; PG8_LDA(At, 1, 0); PG8_STAGE(PG8_SA(0, 1), a2 + hstep, voffA);
            PG8_WAIT_V(8); PG8_WAIT_L(0); PG8_BAR; PG8_MMA(0, 0, At, B0); PG8_MMA(0, 1, At, B1); PG8_BAR; PG8_SCHED;
            PG8_LDA(At, 1, 1); PG8_STAGE(PG8_SB(1, 0), b3, voffB); PG8_STAGE(PG8_SB(1, 1), b3 + hstep, voffB); PG8_STAGE(PG8_SA(1, 0), a3, voffA);
            PG8_WAIT_V(8); PG8_WAIT_L(0); PG8_BAR; PG8_MMA(1, 0, At, B0); PG8_MMA(1, 1, At, B1); PG8_BAR; PG8_SCHED;
            } else {
            PG8_LDB(B0, 0, 0); PG8_SCHED; PG8_LDA(At, 0, 0); PG8_STAGE(PG8_SA(1, 1), a1 + hstep, voffA);
            PG8_WAIT_L(8); PG8_BAR; PG8_WAIT_L(0); PG8_MMA(0, 0, At, B0); PG8_BAR; PG8_SCHED;
            PG8_LDB(B1, 0, 1); PG8_STAGE(PG8_SB(0, 0), b2, voffB);
            PG8_BAR; PG8_WAIT_L(0); PG8_MMA(0, 1, At, B1); PG8_BAR;
            PG8_LDA(At, 0, 1); PG8_STAGE(PG8_SA(0, 0), a2, voffA);
            PG8_BAR; PG8_WAIT_L(0); PG8_MMA(1, 0, At, B0); PG8_BAR; PG8_SCHED;
            PG8_STAGE(PG8_SB(0, 1), b2 + hstep, voffB);
            PG8_WAIT_V(6); PG8_BAR; PG8_MMA(1, 1, At, B1); PG8_BAR;
            PG8_LDB(B0, 1, 0); PG8_SCHED; PG8_LDA(At, 1, 0); PG8_STAGE(PG8_SA(0, 1), a2 + hstep, voffA);
            PG8_WAIT_L(8); PG8_BAR; PG8_WAIT_L(0); PG8_MMA(0, 0, At, B0); PG8_BAR; PG8_SCHED;
            PG8_LDB(B1, 1, 1); PG8_STAGE(PG8_SB(1, 0), b3, voffB);
            PG8_BAR; PG8_WAIT_L(0); PG8_MMA(0, 1, At, B1); PG8_BAR;
            PG8_LDA(At, 1, 1); PG8_STAGE(PG8_SA(1, 0), a3, voffA);
            PG8_BAR; PG8_WAIT_L(0); PG8_MMA(1, 0, At, B0); PG8_BAR; PG8_SCHED;
            PG8_STAGE(PG8_SB(1, 1), b3 + hstep, voffB);
            PG8_WAIT_V(6); PG8_BAR; PG8_MMA(1, 1, At, B1); PG8_BAR;
            }
        }
        if constexpr (ALIGN_EPI) { if (wr == 0) PG8_BAR; }
        if constexpr (!Epi::AFTER_DRAIN) { E(acc, cur, wr, wc, fr, fq); S.done(cur); }
        if (!has_next) break;
#pragma unroll
        for (int a = 0; a < 2; ++a)
#pragma unroll
            for (int b = 0; b < 2; ++b)
#pragma unroll
                for (int m = 0; m < 4; ++m)
#pragma unroll
                    for (int n = 0; n < 2; ++n) acc[a][b][m][n] = (f32x4){0.f, 0.f, 0.f, 0.f};
        cur = nxt; cA = nA; cB = nB; ++ui;
        if constexpr (ALIGN_EPI) { if (wr == 1) PG8_BAR; }
    }
    PG8_WAIT_V(0);
    if constexpr (!ALIGN_EPI) { if (wr == 0) PG8_BAR; }
    PG8_BAR;
    if constexpr (Epi::AFTER_DRAIN) { E.fused(acc, cur, wr, wc, fr, fq, lds, wid, lane); S.done(cur); }
#undef PG8_SA
#undef PG8_SB
#undef PG8_STAGE
#undef PG8_LDA
#undef PG8_LDB
#undef PG8_MMA
#undef PG8_WAIT_V
#undef PG8_WAIT_L
#undef PG8_BAR
#undef PG8_SCHED
}
}
namespace pg8 {
constexpr float LOG2E = 1.4426950408889634f;
constexpr float NORM_EPS = 1e-6f;
__device__ __forceinline__ float fast_exp2(float x) { return __builtin_amdgcn_exp2f(x); }
__device__ __forceinline__ float fast_rcp(float x) { return __builtin_amdgcn_rcpf(x); }
__device__ __forceinline__ float fast_rsq(float x) { return __builtin_amdgcn_rsqf(x); }
__device__ __forceinline__ float silu_f(float v) { return v * fast_rcp(1.f + fast_exp2(-LOG2E * v)); }
__device__ __forceinline__ float sigm_f(float v) { return fast_rcp(1.f + fast_exp2(-LOG2E * v)); }
__device__ __forceinline__ float st_rscale(const unsigned long long* st, int row) { return fast_rsq((float)st[row] * (1.f / (16777216.f * 1024.f)) + NORM_EPS); }
typedef float f32x2e __attribute__((ext_vector_type(2))); typedef __bf16 bf16x2e __attribute__((ext_vector_type(2)));
__device__ __forceinline__ unsigned cvt2(float lo, float hi) { f32x2e v = {lo, hi}; bf16x2e b = __builtin_convertvector(v, bf16x2e); return __builtin_bit_cast(unsigned, b); }
__device__ __forceinline__ u32x4 pack8(const f32x4& a, const f32x4& b) { u32x4 w; w.x = cvt2(a[0], a[1]); w.y = cvt2(a[2], a[3]); w.z = cvt2(b[0], b[1]); w.w = cvt2(b[2], b[3]); return w; }

struct EpiHgrnIn {
    static constexpr bool PERM = true, AFTER_DRAIN = false;
    bf16_t* O; const float* st; const float* lb;
    __device__ __forceinline__ void operator()(const f32x4 (&acc)[2][2][4][2], const Unit& u, int wr, int wc, int fr, int fq) const {
        const int row0 = u.pm * BM + wr * 64 + fr, type = u.pn >> 2, col0 = u.pn * BM + wc * 32 + 8 * fq;
        f32x4 lbv[2][2];
#pragma unroll
        for (int bj = 0; bj < 2; ++bj)
#pragma unroll
            for (int n = 0; n < 2; ++n) lbv[bj][n] = (type == 1) ? *(const f32x4*)(lb + ((col0 + bj * HALF + 4 * n) & 1023)) : (f32x4){0.f, 0.f, 0.f, 0.f};
#pragma unroll
        for (int ai = 0; ai < 2; ++ai)
#pragma unroll
            for (int m = 0; m < 4; ++m) {
                const int row = row0 + ai * HALF + m * 16;
                const float r = fast_rsq(st[row] * (1.f / 1024.f) + NORM_EPS);
                bf16_t* rowp = O + (size_t)row * 4096 + col0;
#pragma unroll
                for (int bj = 0; bj < 2; ++bj) {
                    f32x4 v[2];
#pragma unroll
                    for (int n = 0; n < 2; ++n) {
                        v[n] = acc[ai][bj][m][n] * r;
                        if (type == 0 || type == 3) {
#pragma unroll
                            for (int j = 0; j < 4; ++j) v[n][j] = silu_f(v[n][j]);
                        } else if (type == 1) {
#pragma unroll
                            for (int j = 0; j < 4; ++j) { const float l = lbv[bj][n][j]; v[n][j] = __builtin_amdgcn_logf(l + (1.f - l) * sigm_f(v[n][j])); }
                        }
                    }
                    *(u32x4*)(rowp + bj * HALF) = pack8(v[0], v[1]);
                }
            }
    }
};

struct EpiRes {
    static constexpr bool PERM = true, AFTER_DRAIN = false;
    const float* res; float* out; bf16_t* ob; unsigned long long* st;
    __device__ __forceinline__ void operator()(const f32x4 (&acc)[2][2][4][2], const Unit& u, int wr, int wc, int fr, int fq) const {
        const int row0 = u.pm * BM + wr * 64 + fr, col0 = u.pn * BM + wc * 32 + 8 * fq;
#pragma unroll
        for (int ai = 0; ai < 2; ++ai)
#pragma unroll
            for (int m = 0; m < 4; ++m) {
                const int row = row0 + ai * HALF + m * 16; const size_t off = (size_t)row * 1024 + col0;
                float ss = 0.f;
#pragma unroll
                for (int bj = 0; bj < 2; ++bj) {
                    const f32x4 r0 = *(const f32x4*)(res + off + bj * HALF), r1 = *(const f32x4*)(res + off + bj * HALF + 4);
                    const f32x4 v0 = acc[ai][bj][m][0] + r0, v1 = acc[ai][bj][m][1] + r1;
                    *(f32x4*)(out + off + bj * HALF) = v0; *(f32x4*)(out + off + bj * HALF + 4) = v1;
                    *(u32x4*)(ob + off + bj * HALF) = pack8(v0, v1);
                    ss += (v0[0] * v0[0] + v0[1] * v0[1]) + (v0[2] * v0[2] + v0[3] * v0[3]) + (v1[0] * v1[0] + v1[1] * v1[1]) + (v1[2] * v1[2] + v1[3] * v1[3]);
                }
                ss += __shfl_xor(ss, 16); ss += __shfl_xor(ss, 32);
                if (fq == 0) __hip_atomic_fetch_add(st + row, (unsigned long long)(ss * 16777216.f + 0.5f), __ATOMIC_RELAXED, __HIP_MEMORY_SCOPE_AGENT);
            }
    }
};

struct EpiSwiGLU {
    static constexpr bool PERM = true, AFTER_DRAIN = false;
    bf16_t* O; int ldc; const unsigned long long* st; const float* sc; int nNloc;
    __device__ __forceinline__ void operator()(const f32x4 (&acc)[2][2][4][2], const Unit& u, int wr, int wc, int fr, int fq) const {
        const int row0 = u.pm * BM + wr * 64 + fr, col0 = (u.pn % nNloc) * HALF + wc * 32 + 8 * fq;
#pragma unroll
        for (int ai = 0; ai < 2; ++ai)
#pragma unroll
            for (int m = 0; m < 4; ++m) {
                const int row = row0 + ai * HALF + m * 16;
                const float r = sc ? sc[row] : st_rscale(st, row);
                f32x4 h[2];
#pragma unroll
                for (int n = 0; n < 2; ++n)
#pragma unroll
                    for (int j = 0; j < 4; ++j) h[n][j] = silu_f(acc[ai][0][m][n][j] * r) * (acc[ai][1][m][n][j] * r);
                *(u32x4*)(O + (size_t)row * ldc + col0) = pack8(h[0], h[1]);
            }
    }
};

struct EpiQKV {
    static constexpr bool PERM = true, AFTER_DRAIN = false;
    bf16_t* O; const unsigned long long* st; const float* qg; const float* kg;
    __device__ __forceinline__ void operator()(const f32x4 (&acc)[2][2][4][2], const Unit& u, int wr, int wc, int fr, int fq) const {
        const int row0 = u.pm * BM + wr * 64 + fr, type = u.pn >> 2, lc0 = u.pn * BM + 64 * wc + 8 * fq;
        const float* gp = (type == 0) ? qg : kg;
        f32x4 gv[2][2];
#pragma unroll
        for (int bj = 0; bj < 2; ++bj)
#pragma unroll
            for (int n = 0; n < 2; ++n) gv[bj][n] = (type < 2) ? *(const f32x4*)(gp + 32 * bj + 8 * fq + 4 * n) : (f32x4){1.f, 1.f, 1.f, 1.f};
        const float qs = (type == 0) ? 0.125f * LOG2E : 1.f;
#pragma unroll
        for (int ai = 0; ai < 2; ++ai)
#pragma unroll
            for (int m = 0; m < 4; ++m) {
                const int row = row0 + ai * HALF + m * 16;
                const float r = st_rscale(st, row);
                f32x4 v[2][2]; float ss = 0.f;
#pragma unroll
                for (int bj = 0; bj < 2; ++bj)
#pragma unroll
                    for (int n = 0; n < 2; ++n) { v[bj][n] = acc[ai][bj][m][n] * r; const f32x4 x = v[bj][n]; ss += (x[0] * x[0] + x[1] * x[1]) + (x[2] * x[2] + x[3] * x[3]); }
                if (type < 2) {
                    ss += __shfl_xor(ss, 16); ss += __shfl_xor(ss, 32);
                    const float rr = fast_rsq(ss * (1.f / 64.f) + NORM_EPS) * qs;
#pragma unroll
                    for (int bj = 0; bj < 2; ++bj)
#pragma unroll
                        for (int n = 0; n < 2; ++n) v[bj][n] = v[bj][n] * gv[bj][n] * rr;
                }
#pragma unroll
                for (int bj = 0; bj < 2; ++bj) *(u32x4*)(O + (size_t)row * 3072 + lc0 + 32 * bj) = pack8(v[bj][0], v[bj][1]);
            }
    }
};

struct EpiMoeDown {
    static constexpr bool PERM = true, AFTER_DRAIN = false;
    float* out; const int* s2t; const float* sg; int nNloc;
    __device__ __forceinline__ void operator()(const f32x4 (&acc)[2][2][4][2], const Unit& u, int wr, int wc, int fr, int fq) const {
        const int row0 = u.pm * BM + wr * 64 + fr, col0 = (u.pn % nNloc) * BM + wc * 32 + 8 * fq;
#pragma unroll
        for (int ai = 0; ai < 2; ++ai)
#pragma unroll
            for (int m = 0; m < 4; ++m) {
                const int slot = row0 + ai * HALF + m * 16; const int tok = s2t[slot];
                if (tok >= 0) {
                    const float g = sg[slot]; float* p = out + (size_t)tok * 1024 + col0;
#pragma unroll
                    for (int bj = 0; bj < 2; ++bj)
#pragma unroll
                        for (int n = 0; n < 2; ++n) { f32x4* q = (f32x4*)(p + bj * HALF + 4 * n); *q = *q + acc[ai][bj][m][n] * g; }
                }
            }
    }
};

struct GroupedOrder {
    StaticOrder so; const int* rts; int nNloc;
    __device__ __forceinline__ void init(const int* rts_, int nNloc_, int G, int c) { rts = rts_; nNloc = nNloc_; so.init(rts_[8] * BM, nNloc_ * BM, G, c); }
    __device__ __forceinline__ bool next(int i, Unit& u) const {
        if (!so.next(i, u)) return false;
        int e = 0;
#pragma unroll
        for (int k = 1; k < 8; ++k) e += (u.pm >= rts[k]) ? 1 : 0;
        u.pn += e * nNloc; return true;
    }
    __device__ __forceinline__ void a_ready(const Unit&) const {}
    __device__ __forceinline__ void done(const Unit&) const {}
};
}
#define GAS __attribute__((address_space(1)))
#define LAS __attribute__((address_space(3)))
typedef unsigned short bf16;
typedef unsigned v4u __attribute__((ext_vector_type(4)));
typedef float f32x4 __attribute__((ext_vector_type(4)));
typedef short bf16x8 __attribute__((ext_vector_type(8)));
typedef GAS unsigned gu32;
typedef GAS unsigned long long gu64;
#define RLX_AGENT __ATOMIC_RELAXED, __HIP_MEMORY_SCOPE_AGENT
#define LDS_WAIT() asm volatile("s_waitcnt lgkmcnt(0)" ::: "memory")
#define VM_WAIT() asm volatile("s_waitcnt vmcnt(0)" ::: "memory")
__device__ __forceinline__ unsigned long long rt() { return __builtin_amdgcn_s_memrealtime(); }
__device__ __forceinline__ unsigned f2bf(float f) { unsigned u = __builtin_bit_cast(unsigned, f); return (u + 0x7fffu + ((u >> 16) & 1u)) >> 16; }
__device__ __forceinline__ unsigned pk2(float lo, float hi) { return f2bf(lo) | (f2bf(hi) << 16); }
#define XB_TMO      128
#define XB_XCNT(j)  (256  + 64 * (j))
#define XB_XSUB(j)  (1280 + 64 * (j))
#define XB_XGEN(j)  (2304 + 64 * (j))
#define XB_TOP      3328
#define XB_TOPGEN   3392
#define XCD_BAR_WORDS 3456
#define XB_SPIN_CAP (1u << 18)

__device__ __forceinline__ unsigned xb_ld(unsigned* p)              { return __hip_atomic_load(p, __ATOMIC_RELAXED, __HIP_MEMORY_SCOPE_AGENT); }
__device__ __forceinline__ unsigned xb_add(unsigned* p, unsigned v) { return __hip_atomic_fetch_add(p, v, __ATOMIC_RELAXED, __HIP_MEMORY_SCOPE_AGENT); }
__device__ __forceinline__ unsigned xb_xcc_id() { return (unsigned)__builtin_amdgcn_s_getreg((3 << 11) | 20) & 0xFu; }
#define XB_SPIN(cond, bar) do { unsigned _sp = 0; while (cond) { __builtin_amdgcn_s_sleep(1); \
    if ((++_sp & 255u) == 0u) { if (xb_ld(&(bar)[XB_TMO])) break; if (_sp > XB_SPIN_CAP) { atomicAdd(&(bar)[XB_TMO], 1u); break; } } } } while (0)

struct XcdBarrier {
    unsigned* bar; unsigned x;
    volatile LAS unsigned* st;
};

__device__ __forceinline__ XcdBarrier xcd_barrier_post(unsigned* bar, volatile LAS unsigned* st) {
    XcdBarrier b; b.bar = bar; b.x = xb_xcc_id(); b.st = st;
    if (threadIdx.x == 0) (void)xb_add(&bar[XB_XCNT(b.x)], 1u);
    return b;
}
__device__ __forceinline__ void xcd_barrier_complete(unsigned* bar, unsigned x, unsigned& nloc, unsigned& nx) {
    const unsigned G = gridDim.x * gridDim.y * gridDim.z;
    unsigned sum, cnt, mine, sp = 0u;
    for (;;) {
        sum = 0u; cnt = 0u; mine = 0u;
#pragma unroll
        for (unsigned j = 0; j < 16; ++j) { const unsigned c = xb_ld(&bar[XB_XCNT(j)]); sum += c; cnt += (c > 0u) ? 1u : 0u; mine = (j == x) ? c : mine; }
        if (sum == G) break;
        __builtin_amdgcn_s_sleep(1);
        if ((++sp & 255u) == 0u) { if (xb_ld(&bar[XB_TMO])) break; if (sp > XB_SPIN_CAP) { atomicAdd(&bar[XB_TMO], 1u); break; } }
    }
    nloc = mine > 0u ? mine : 1u; nx = cnt > 0u ? cnt : 1u;
}

__device__ __forceinline__ void xcd_barrier(const XcdBarrier& b) {
    asm volatile("s_waitcnt vmcnt(0)" ::: "memory");
    __syncthreads();
    if (threadIdx.x == 0) {
        unsigned* bar = b.bar;
        __builtin_amdgcn_s_waitcnt(0);
        unsigned nloc = b.st[0], nx = b.st[1];
        if (nloc == 0u) { xcd_barrier_complete(bar, b.x, nloc, nx); b.st[0] = nloc; b.st[1] = nx; }
        const unsigned old = xb_add(&bar[XB_XSUB(b.x)], 1u);
        const unsigned gen = old / nloc;
        if (old + 1u == (gen + 1u) * nloc) {
            __builtin_amdgcn_fence(__ATOMIC_RELEASE, "agent");
            asm volatile("s_waitcnt vmcnt(0)" ::: "memory");
            const unsigned og = xb_add(&bar[XB_TOP], 1u);
            const unsigned tg = og / nx;
            if (og + 1u == (tg + 1u) * nx) xb_add(&bar[XB_TOPGEN], 1u);
            else XB_SPIN(xb_ld(&bar[XB_TOPGEN]) == tg, bar);
            __builtin_amdgcn_fence(__ATOMIC_ACQUIRE, "agent");
            xb_add(&bar[XB_XGEN(b.x)], 1u);
            asm volatile("s_waitcnt vmcnt(0)" ::: "memory");
        } else {
            XB_SPIN(xb_ld(&bar[XB_XGEN(b.x)]) == gen, bar);
            __builtin_amdgcn_fence(__ATOMIC_ACQUIRE, "agent");
            asm volatile("s_waitcnt vmcnt(0)" ::: "memory");
        }
    }
    __syncthreads();
}
constexpr int NWAVES = 8;
constexpr int BATCH = 8, T = 8192, D = 1024, M = BATCH * T;
constexpr int NH = 8, HDK = 128;
constexpr int FF = 2816, NE = 8, EF = 3584;
constexpr int SLOTS_MAX = M + NE * 256;
constexpr float LAMBDA_INIT = 0.35550906759f;
constexpr float EPS = 1e-6f;
constexpr float LOG2E = 1.4426950408889634f;
#ifndef MK_N_LAUNCHES
#define MK_N_LAUNCHES 1
#endif
constexpr int N_PHASES = 16;
constexpr int N_LAUNCHES = MK_N_LAUNCHES;

constexpr size_t MiB = 1u << 20, KiB = 1u << 10;
constexpr size_t WS_CTL = 0, CTL_ZERO_BYTES = 2 * MiB;
constexpr size_t WS_ST1 = 512 * KiB, WS_ST2 = 1 * MiB, WS_ST3 = 1 * MiB + 512 * KiB;
constexpr size_t WS_ST0 = 2 * MiB;
constexpr size_t WS_WGCNT = 2 * MiB + 256 * KiB;
constexpr size_t WS_RTS = WS_WGCNT + 16 * KiB;
constexpr size_t WS_UORDER = WS_RTS + 1 * KiB;
constexpr size_t WS_LB = WS_UORDER + 2 * KiB;
constexpr size_t WS_ROUTER = 2 * MiB + 512 * KiB;
constexpr size_t WS_TOKE = 3 * MiB, WS_TOKG = 3 * MiB + 512 * KiB;
constexpr size_t WS_TOKS = 4 * MiB;
constexpr size_t WS_S2T = 5 * MiB, WS_SG = 6 * MiB, WS_SR = 7 * MiB;
constexpr size_t WS_W1 = 8 * MiB, WS_W2 = 16 * MiB, WS_W3 = 18 * MiB, WS_W4 = 29 * MiB, WS_W5 = 35 * MiB, WS_W6 = 41 * MiB, WS_W7 = 43 * MiB, WS_W8 = 155 * MiB;
constexpr size_t WS_ACT0 = 212 * MiB, WS_ACT1 = 340 * MiB, WS_BIG = 474 * MiB, WS_END = 1024 * MiB;
static_assert(WS_W4 + (size_t)FF * D * 2 <= WS_W5 && WS_W8 + (size_t)NE * D * EF * 2 <= WS_ACT0 && WS_ACT1 + (size_t)SLOTS_MAX * D * 2 <= WS_BIG, "d_ws map");
static_assert(WS_BIG + (size_t)M * 4096 * 2 <= WS_END && WS_BIG + (size_t)SLOTS_MAX * EF * 2 <= WS_END && 2 * SLOTS_MAX * 4 <= (int)MiB, "d_ws map");
constexpr int CW_TMO = 0, CW_CODE = 1, CW_BAR = 4096;

constexpr int RING_OFF = 0, RING_BYTES = 131072;
constexpr int LDSCTL_OFF = RING_BYTES, MISC_OFF = LDSCTL_OFF + 320;
constexpr int LDS_BYTES = 147456;

struct Frame {
    LAS unsigned char* lds;
    volatile LAS unsigned* MISC;
    gu32* ctl;
    unsigned char* ws;
    int tid, lane, wave, vcu, G;
};

__device__ __forceinline__ float wave_sum(float v) {
#pragma unroll
    for (int o = 1; o < 64; o <<= 1) v += __shfl_xor(v, o);
    return v;
}
typedef float f32x2 __attribute__((ext_vector_type(2)));
typedef unsigned u32x2 __attribute__((ext_vector_type(2)));
__device__ __forceinline__ unsigned lds_add(LAS unsigned* p, unsigned v) { return __hip_atomic_fetch_add(p, v, __ATOMIC_RELAXED, __HIP_MEMORY_SCOPE_WORKGROUP); }
__device__ __forceinline__ void lds_inc(LAS unsigned* p) { (void)lds_add(p, 1u); }
__device__ __forceinline__ float bf2f(unsigned short b) { return __builtin_bit_cast(float, (unsigned)b << 16); }
__device__ __forceinline__ float bflo(unsigned u) { return __builtin_bit_cast(float, u << 16); }
__device__ __forceinline__ float bfhi(unsigned u) { return __builtin_bit_cast(float, u & 0xffff0000u); }
typedef float f32x2_t __attribute__((ext_vector_type(2))); typedef __bf16 bf16x2_t __attribute__((ext_vector_type(2)));
__device__ __forceinline__ unsigned cvtpk(float lo, float hi) { f32x2_t v = {lo, hi}; bf16x2_t b = __builtin_convertvector(v, bf16x2_t); return __builtin_bit_cast(unsigned, b); }

template <int MODE>
__device__ __forceinline__ void tr_item(const float* W, int K, int N, bf16* WT, int FFD, const float* gain, int gmask, float gscale, LAS float* scr, int item, int lane) {
    const int nblk = N / 32, kb = item / nblk, nb = item % nblk, k0 = 64 * kb, n0 = 32 * nb;
    int src = n0;
    if (MODE != 0) { const int pn = n0 >> 8, rem = n0 & 255, bj = rem >> 7, wc = (rem >> 5) & 3; src = (MODE == 1) ? bj * FFD + 128 * pn + 32 * wc : 256 * pn + 64 * wc + 32 * bj; }
#pragma unroll 8
    for (int i = 0; i < 32; ++i) { const int kk = 2 * i + (lane >> 5); scr[kk * 33 + (lane & 31)] = W[(size_t)(k0 + kk) * N + src + (lane & 31)]; }
    LDS_WAIT(); asm volatile("" ::: "memory");
    const int c = lane & 7;
    float g[8];
#pragma unroll
    for (int i = 0; i < 8; ++i) g[i] = gain ? gain[(k0 + 8 * c + i) & gmask] * gscale : 1.f;
#pragma unroll
    for (int j = 0; j < 4; ++j) { const int n = (lane >> 3) + 8 * j; const LAS float* s = scr + (8 * c) * 33 + n;
        v4u o; o.x = cvtpk(s[0 * 33] * g[0], s[1 * 33] * g[1]); o.y = cvtpk(s[2 * 33] * g[2], s[3 * 33] * g[3]); o.z = cvtpk(s[4 * 33] * g[4], s[5 * 33] * g[5]); o.w = cvtpk(s[6 * 33] * g[6], s[7 * 33] * g[7]);
        *(GAS v4u*)(WT + (size_t)(n0 + n) * K + k0 + 8 * c) = o; }
    LDS_WAIT(); asm volatile("" ::: "memory");
}

__device__ __forceinline__ int attn_jlo(int h, int qt) { const int Wk = (int)(150.f / (LOG2E * __builtin_ldexpf(1.f, -(h + 1)))); const int d = 128 * qt - Wk; return d > 0 ? (d >> 6) : 0; }

__device__ __forceinline__ void p0_prologue(Frame& F, const float* const* in) {
    LAS float* scr = (LAS float*)(F.lds + RING_OFF + F.wave * 16384);
    const int gw = F.vcu * NWAVES + F.wave, NGW = F.G * NWAVES;
    constexpr int I1 = (D / 64) * (4096 / 32), I2 = (D / 64) * (D / 32), I3 = (D / 64) * (2 * FF / 32), I4 = (FF / 64) * (D / 32), I5 = (D / 64) * (3 * D / 32), I6 = I2;
    constexpr int I7 = (D / 64) * (2 * EF / 32), I8 = (EF / 64) * (D / 32);
    constexpr int NITEMS = I1 + I2 + I3 + I4 + I5 + I6 + NE * I7 + NE * I8;
    unsigned char* ws = F.ws;
    for (int it = gw; it < NITEMS; it += NGW) {
        int r = it;
        if (r < I1) { tr_item<0>(in[3], D, 4096, (bf16*)(ws + WS_W1), 0, in[2], 1023, 1.f, scr, r, F.lane); continue; } r -= I1;
        if (r < I2) { tr_item<0>(in[5], D, D, (bf16*)(ws + WS_W2), 0, in[4], 1023, 1.f, scr, r, F.lane); continue; } r -= I2;
        if (r < I3) { tr_item<1>(in[7], D, 2 * FF, (bf16*)(ws + WS_W3), FF, in[6], 1023, 1.f, scr, r, F.lane); continue; } r -= I3;
        if (r < I4) { tr_item<0>(in[8], FF, D, (bf16*)(ws + WS_W4), 0, nullptr, 0, 1.f, scr, r, F.lane); continue; } r -= I4;
        if (r < I5) { tr_item<2>(in[10], D, 3 * D, (bf16*)(ws + WS_W5), 0, in[9], 1023, 1.f, scr, r, F.lane); continue; } r -= I5;
        if (r < I6) { tr_item<0>(in[18], D, D, (bf16*)(ws + WS_W6), 0, in[17], 127, 1.f - LAMBDA_INIT, scr, r, F.lane); continue; } r -= I6;
        if (r < NE * I7) { const int e = r / I7; tr_item<1>(in[21] + (size_t)e * D * 2 * EF, D, 2 * EF, (bf16*)(ws + WS_W7) + (size_t)e * 2 * EF * D, EF, in[19], 1023, 1.f, scr, r % I7, F.lane); continue; } r -= NE * I7;
        { const int e = r / I8; tr_item<0>(in[22] + (size_t)e * EF * D, EF, D, (bf16*)(ws + WS_W8) + (size_t)e * D * EF, 0, nullptr, 0, 1.f, scr, r % I8, F.lane); }
    }
    const float* x = in[0]; bf16* xb = (bf16*)(ws + WS_ACT0); float* st0 = (float*)(ws + WS_ST0);
    for (int m = gw; m < M; m += NGW) {
        const GAS f32x4* xr = (const GAS f32x4*)(x + (size_t)m * D) + F.lane; GAS unsigned long long* o8 = (GAS unsigned long long*)(xb + (size_t)m * D) + F.lane;
        float s = 0.f;
#pragma unroll
        for (int j = 0; j < 4; ++j) { const f32x4 v = xr[64 * j]; s += (v.x * v.x + v.y * v.y) + (v.z * v.z + v.w * v.w); o8[64 * j] = (unsigned long long)cvtpk(v.x, v.y) | ((unsigned long long)cvtpk(v.z, v.w) << 32); }
        s = wave_sum(s); if (F.lane == 0) st0[m] = s;
    }
    if (blockIdx.x == 0) {
        const float* lbp = in[1]; float* LB = (float*)(ws + WS_LB);
        for (int c = F.tid; c < D; c += NWAVES * 64) { const float a0 = lbp[c], a1 = lbp[D + c], a2 = lbp[2 * D + c]; const float mx = fmaxf(a0, fmaxf(a1, a2));
            const float e0 = __expf(a0 - mx), e1 = __expf(a1 - mx), e2 = __expf(a2 - mx); LB[c] = e0 / (e0 + e1 + e2); }
    }
    if (blockIdx.x == 1) {
        const float* rp = in[20]; const float* gp = in[19]; float* R = (float*)(ws + WS_ROUTER);
        for (int i = F.tid; i < D * NE; i += NWAVES * 64) R[i] = rp[i] * gp[i >> 3];
    }
    if (blockIdx.x == 2) {
        LAS int* cst = (LAS int*)(F.lds + RING_OFF + 8 * 16384 - 4096);
        __syncthreads();
        const int i = F.tid; const int h = i >> 6, qt = i & 63; const int c = 2 * qt + 2 - attn_jlo(h, qt);
        cst[i] = c; __syncthreads();
        int rank = 0;
        for (int j = 0; j < 512; ++j) { const int cj = cst[j]; rank += (cj > c || (cj == c && j < i)) ? 1 : 0; }
        ((int*)(ws + WS_UORDER))[rank] = i;
    }
}

namespace scan {
constexpr int QS = 136, SS = 72;
constexpr int L_QT = 0, L_KT = L_QT + 64 * QS * 2, L_KTT = L_KT + 64 * QS * 2, L_VT = L_KTT + 128 * SS * 2, L_PT = L_VT + 32 * SS * 2, L_ST = L_PT + 64 * SS * 2, L_SEG = L_ST + 2 * 32 * QS * 2, L_DEND = L_SEG + 8 * 128 * 4, L_END = L_DEND + 512;
static_assert(L_END <= RING_BYTES, "scan LDS");
typedef float f32x4 __attribute__((ext_vector_type(4)));
}
__device__ __forceinline__ void scan_phase(Frame& F) {
    using namespace scan;
    if (F.vcu >= BATCH * NH * 4) return;
    const int tid = F.tid, lane = F.lane, wid = F.wave, fr = lane & 15, fq = lane >> 4;
    const int b = F.vcu >> 5, h = (F.vcu >> 2) & 7, vs = F.vcu & 3;
    LAS unsigned char* L = F.lds + RING_OFF;
    LAS bf16* QT = (LAS bf16*)(L + L_QT); LAS bf16* KT = (LAS bf16*)(L + L_KT); LAS bf16* KTT = (LAS bf16*)(L + L_KTT); LAS bf16* VT = (LAS bf16*)(L + L_VT);
    LAS bf16* PT = (LAS bf16*)(L + L_PT); LAS bf16* ST = (LAS bf16*)(L + L_ST); LAS float* SEG = (LAS float*)(L + L_SEG); LAS float* DEND = (LAS float*)(L + L_DEND);
    const bf16* qfvg = (const bf16*)(F.ws + WS_BIG); bf16* obuf = (bf16*)(F.ws + WS_ACT1);
    const int kp = tid & 63, part = tid >> 6;
    const bf16* gq = qfvg + (size_t)(b * T + 8 * part) * 4096 + h * 128 + 2 * kp;
    const bf16* gl = gq + 1024;
    const int vsr = tid >> 3, v4 = (tid & 7) * 4;
    const bf16* gv = qfvg + (size_t)(b * T + vsr) * 4096 + 2048 + h * 128 + vs * 32 + v4;
    for (int i = tid; i < 2 * 32 * QS / 2; i += NWAVES * 64) ((LAS unsigned*)ST)[i] = 0u;
    f32x4 sacc[2]; sacc[0] = (f32x4){0.f, 0.f, 0.f, 0.f}; sacc[1] = sacc[0];
    unsigned lfp[8], qp[8]; unsigned long long vp;
#pragma unroll
    for (int i = 0; i < 8; ++i) { lfp[i] = *(const unsigned*)(gl + (size_t)i * 4096); qp[i] = *(const unsigned*)(gq + (size_t)i * 4096); }
    vp = *(const unsigned long long*)gv;
    const int ti = wid >> 1, vi = wid & 1;
    for (int c = 0; c < T / 64; ++c) {
        const int cur = c & 1, nxt = cur ^ 1;
        float lf0[8], lf1[8], cs0[8], cs1[8]; float run0 = 0.f, run1 = 0.f;
#pragma unroll
        for (int i = 0; i < 8; ++i) { lf0[i] = bflo(lfp[i]); lf1[i] = bfhi(lfp[i]); run0 += lf0[i]; run1 += lf1[i]; cs0[i] = run0; cs1[i] = run1; }
        *(LAS f32x2*)(SEG + part * 128 + 2 * kp) = (f32x2){run0, run1};
        float q0[8], q1[8];
#pragma unroll
        for (int i = 0; i < 8; ++i) { q0[i] = bflo(qp[i]); q1[i] = bfhi(qp[i]); }
        const unsigned long long vcur = vp;
        if (c + 1 < T / 64) {
            const size_t adv = (size_t)(c + 1) * 64 * 4096;
#pragma unroll
            for (int i = 0; i < 8; ++i) { lfp[i] = *(const unsigned*)(gl + adv + (size_t)i * 4096); qp[i] = *(const unsigned*)(gq + adv + (size_t)i * 4096); }
            vp = *(const unsigned long long*)(gv + adv);
        }
        __syncthreads();
        float off0 = 0.f, off1 = 0.f;
#pragma unroll
        for (int p = 0; p < 7; ++p) { const f32x2 s = *(LAS f32x2*)(SEG + p * 128 + 2 * kp); if (p < part) { off0 += s.x; off1 += s.y; } }
        if (part == 7) *(LAS f32x2*)(DEND + 2 * kp) = (f32x2){pg8::fast_exp2(off0 + run0), pg8::fast_exp2(off1 + run1)};
        unsigned kt0[4], kt1[4];
#pragma unroll
        for (int i = 0; i < 8; ++i) {
            const float b0 = off0 + cs0[i], b1 = off1 + cs1[i];
            const float qa = q0[i] * pg8::fast_exp2(b0), qb = q1[i] * pg8::fast_exp2(b1);
            const float ka = (1.f - pg8::fast_exp2(lf0[i])) * pg8::fast_exp2(-b0), kb = (1.f - pg8::fast_exp2(lf1[i])) * pg8::fast_exp2(-b1);
            const int t = 8 * part + i;
            *(LAS unsigned*)(QT + t * QS + 2 * kp) = cvtpk(qa, qb);
            const unsigned kk = cvtpk(ka, kb);
            *(LAS unsigned*)(KT + t * QS + 2 * kp) = kk;
            if (i & 1) { kt0[i >> 1] |= kk << 16; kt1[i >> 1] |= kk & 0xffff0000u; } else { kt0[i >> 1] = kk & 0xffffu; kt1[i >> 1] = kk >> 16; }
        }
        *(LAS v4u*)(KTT + (2 * kp) * SS + 8 * part) = (v4u){kt0[0], kt0[1], kt0[2], kt0[3]};
        *(LAS v4u*)(KTT + (2 * kp + 1) * SS + 8 * part) = (v4u){kt1[0], kt1[1], kt1[2], kt1[3]};
        VT[(v4 + 0) * SS + vsr] = (bf16)(vcur & 0xffffu); VT[(v4 + 1) * SS + vsr] = (bf16)((vcur >> 16) & 0xffffu); VT[(v4 + 2) * SS + vsr] = (bf16)((vcur >> 32) & 0xffffu); VT[(v4 + 3) * SS + vsr] = (bf16)(vcur >> 48);
        __syncthreads();
        {
#pragma unroll
            for (int s2 = 0; s2 < 2; ++s2) {
                const int si = 2 * (wid & 1) + s2;
                f32x4 p = (f32x4){0.f, 0.f, 0.f, 0.f};
                if (si <= ti) {
#pragma unroll
                    for (int kk = 0; kk < 4; ++kk) {
                        const bf16x8 a = *(const LAS bf16x8*)(QT + (16 * ti + fr) * QS + 32 * kk + 8 * fq);
                        const bf16x8 bb = *(const LAS bf16x8*)(KT + (16 * si + fr) * QS + 32 * kk + 8 * fq);
                        p = __builtin_amdgcn_mfma_f32_16x16x32_bf16(a, bb, p, 0, 0, 0);
                    }
                    if (si == ti) {
#pragma unroll
                        for (int j = 0; j < 4; ++j) if (fr > 4 * fq + j) p[j] = 0.f;
                    }
                }
#pragma unroll
                for (int j = 0; j < 4; ++j) PT[(16 * ti + 4 * fq + j) * SS + 16 * si + fr] = (bf16)(cvtpk(p[j], 0.f) & 0xffffu);
            }
        }
#pragma unroll
        for (int s2 = 0; s2 < 2; ++s2) {
            const int ki = (wid >> 1) + 4 * s2;
#pragma unroll
            for (int ss = 0; ss < 2; ++ss) {
                const bf16x8 a = *(const LAS bf16x8*)(KTT + (16 * ki + fr) * SS + 32 * ss + 8 * fq);
                const bf16x8 bb = *(const LAS bf16x8*)(VT + (16 * vi + fr) * SS + 32 * ss + 8 * fq);
                sacc[s2] = __builtin_amdgcn_mfma_f32_16x16x32_bf16(a, bb, sacc[s2], 0, 0, 0);
            }
            const f32x4 de = *(const LAS f32x4*)(DEND + 16 * ki + 4 * fq);
            sacc[s2] = sacc[s2] * de;
            *(LAS u32x2*)(ST + nxt * 32 * QS + (16 * vi + fr) * QS + 16 * ki + 4 * fq) = (u32x2){cvtpk(sacc[s2][0], sacc[s2][1]), cvtpk(sacc[s2][2], sacc[s2][3])};
        }
        f32x4 oacc = (f32x4){0.f, 0.f, 0.f, 0.f};
#pragma unroll
        for (int kk = 0; kk < 4; ++kk) {
            const bf16x8 a = *(const LAS bf16x8*)(QT + (16 * ti + fr) * QS + 32 * kk + 8 * fq);
            const bf16x8 bb = *(const LAS bf16x8*)(ST + cur * 32 * QS + (16 * vi + fr) * QS + 32 * kk + 8 * fq);
            oacc = __builtin_amdgcn_mfma_f32_16x16x32_bf16(a, bb, oacc, 0, 0, 0);
        }
        __syncthreads();
#pragma unroll
        for (int ss = 0; ss < 2; ++ss) {
            const bf16x8 a = *(const LAS bf16x8*)(PT + (16 * ti + fr) * SS + 32 * ss + 8 * fq);
            const bf16x8 bb = *(const LAS bf16x8*)(VT + (16 * vi + fr) * SS + 32 * ss + 8 * fq);
            oacc = __builtin_amdgcn_mfma_f32_16x16x32_bf16(a, bb, oacc, 0, 0, 0);
        }
        bf16* op = obuf + (size_t)(b * T + c * 64 + 16 * ti + 4 * fq) * D + h * 128 + vs * 32 + 16 * vi + fr;
#pragma unroll
        for (int j = 0; j < 4; ++j) op[(size_t)j * D] = (bf16)(cvtpk(oacc[j], 0.f) & 0xffffu);
    }
}

__device__ __forceinline__ void hgrn_gate_phase(Frame& F) {
    const int gw = F.vcu * NWAVES + F.wave, NGW = F.G * NWAVES;
    bf16* obuf = (bf16*)(F.ws + WS_ACT1); const bf16* qfvg = (const bf16*)(F.ws + WS_BIG);
    for (int m = gw; m < M; m += NGW) {
        v4u o[2], g[2];
        GAS v4u* op = (GAS v4u*)(obuf + (size_t)m * D + 16 * F.lane); const GAS v4u* gp = (const GAS v4u*)(qfvg + (size_t)m * 4096 + 3072 + 16 * F.lane);
        o[0] = op[0]; o[1] = op[1]; g[0] = gp[0]; g[1] = gp[1];
        float v[16]; float ss = 0.f;
#pragma unroll
        for (int i = 0; i < 8; ++i) { const unsigned w = o[i >> 2][i & 3]; v[2 * i] = bflo(w); v[2 * i + 1] = bfhi(w); ss += v[2 * i] * v[2 * i] + v[2 * i + 1] * v[2 * i + 1]; }
        ss += __shfl_xor(ss, 1); ss += __shfl_xor(ss, 2); ss += __shfl_xor(ss, 4);
        const float r = pg8::fast_rsq(ss * (1.f / 128.f) + EPS);
        v4u w[2];
#pragma unroll
        for (int i = 0; i < 8; ++i) { const unsigned gw2 = g[i >> 2][i & 3]; w[i >> 2][i & 3] = cvtpk(v[2 * i] * r * bflo(gw2), v[2 * i + 1] * r * bfhi(gw2)); }
        op[0] = w[0]; op[1] = w[1];
    }
}

namespace att {
using f32x16 = __attribute__((ext_vector_type(16))) float;
using s16x4 = __attribute__((ext_vector_type(4))) short;
typedef short v4i16_t __attribute__((ext_vector_type(4)));
typedef __attribute__((address_space(3))) const char* lds_cptr;
constexpr int SLOT = 32768, NSLOT = 3, L_K0 = 0, L_K1 = 8192, L_V = 16384, L_WS = NSLOT * SLOT, L_XO = 0, XOS = 132, PITCH = 3072;
static_assert(L_WS + NWAVES * 256 <= RING_BYTES && 128 * XOS * 4 <= L_WS, "attention LDS");
__device__ __forceinline__ int crow(int r, int hi) { return (r & 3) + 8 * (r >> 2) + 4 * hi; }
__device__ __forceinline__ void glds16(const void* gsrc, unsigned lds_dst) { unsigned keep;
    asm volatile("s_mov_b32 %0, m0\n\ts_mov_b32 m0, %2\n\ts_nop 0\n\tglobal_load_lds_dwordx4 %1, off\n\ts_mov_b32 m0, %0" : "=&s"(keep) : "v"(gsrc), "s"(lds_dst) : "memory"); }
__device__ __forceinline__ void qkt(f32x16& p0, f32x16& p1, lds_cptr Kslot, const bf16x8* qr, const f32x16& cin, int r32, int hi) {
    lds_cptr kb = Kslot + hi * 1024 + r32 * 16;
#pragma unroll
    for (int d0 = 0; d0 < 4; ++d0) {
        const bf16x8 b0 = *(const LAS bf16x8*)(kb + d0 * 2048);
        const bf16x8 b1 = *(const LAS bf16x8*)(kb + d0 * 2048 + 512);
        if (d0 == 0) { p0 = __builtin_amdgcn_mfma_f32_32x32x16_bf16(b0, qr[0], cin, 0, 0, 0); p1 = __builtin_amdgcn_mfma_f32_32x32x16_bf16(b1, qr[0], cin, 0, 0, 0); }
        else { p0 = __builtin_amdgcn_mfma_f32_32x32x16_bf16(b0, qr[d0], p0, 0, 0, 0); p1 = __builtin_amdgcn_mfma_f32_32x32x16_bf16(b1, qr[d0], p1, 0, 0, 0); }
    }
}
__device__ __forceinline__ void pv(f32x16* o, unsigned vb, bf16x8 pa0, bf16x8 pa1, bf16x8 pa2, bf16x8 pa3) {
#pragma unroll
    for (int d0 = 0; d0 < 4; ++d0) { s16x4 lo[4], hi[4];
#pragma unroll
        for (int ks = 0; ks < 4; ++ks) {
            asm volatile("ds_read_b64_tr_b16 %0,%1 offset:%c2" : "=&v"(lo[ks]) : "v"(vb), "i"(d0 * 4096 + ks * 1024) : "memory");
            asm volatile("ds_read_b64_tr_b16 %0,%1 offset:%c2" : "=&v"(hi[ks]) : "v"(vb), "i"(d0 * 4096 + ks * 1024 + 512) : "memory"); }
        asm volatile("s_waitcnt lgkmcnt(0)" ::: "memory"); __builtin_amdgcn_sched_barrier(0);
#define PK(k) (bf16x8){lo[k][0], lo[k][1], lo[k][2], lo[k][3], hi[k][0], hi[k][1], hi[k][2], hi[k][3]}
        o[d0] = __builtin_amdgcn_mfma_f32_32x32x16_bf16(pa0, PK(0), o[d0], 0, 0, 0);
        o[d0] = __builtin_amdgcn_mfma_f32_32x32x16_bf16(pa1, PK(1), o[d0], 0, 0, 0);
        o[d0] = __builtin_amdgcn_mfma_f32_32x32x16_bf16(pa2, PK(2), o[d0], 0, 0, 0);
        o[d0] = __builtin_amdgcn_mfma_f32_32x32x16_bf16(pa3, PK(3), o[d0], 0, 0, 0);
#undef PK
    }
}
__device__ __forceinline__ void attn_unit(int b, int h, int qt, const bf16* QKV, bf16* Out, LAS unsigned char* shm, float lam, float slope2, float B2) {
    const int tid = threadIdx.x, lane = tid & 63, r32 = lane & 31, hi = lane >> 5; const int wid = __builtin_amdgcn_readfirstlane(tid >> 6);
    const int comp = wid >> 2, wq = wid & 3;
    const long rowbase = (long)b * T; const int q0 = qt * 128; const int myq = q0 + 32 * wq + r32;
    const bf16* Qw = QKV + (rowbase + q0 + 32 * wq) * PITCH + h * 128 + comp * 64;
    const bf16* Kh = QKV + rowbase * PITCH + 1024 + h * 128; const bf16* Vh = QKV + rowbase * PITCH + 2048 + h * 128;
    const unsigned lds0 = (unsigned)(uintptr_t)shm;
    const bf16* k0src = Kh + (long)lane * PITCH + wid * 8; const bf16* k1src = k0src + 64;
    const int pz0 = 2 * wid, pz1 = 2 * wid + 1;
    const bf16* v0src = Vh + (long)(16 * (pz0 & 3) + (lane >> 2)) * PITCH + 32 * (pz0 >> 2) + (lane & 3) * 8;
    const bf16* v1src = Vh + (long)(16 * (pz1 & 3) + (lane >> 2)) * PITCH + 32 * (pz1 >> 2) + (lane & 3) * 8;
#define DMA_TILE(t, slotoff) do { const long ro_ = (long)(t) * 64 * PITCH; const unsigned sb_ = lds0 + (unsigned)(slotoff); \
        glds16(k0src + ro_, (unsigned)__builtin_amdgcn_readfirstlane(sb_ + L_K0 + wid * 1024)); glds16(k1src + ro_, (unsigned)__builtin_amdgcn_readfirstlane(sb_ + L_K1 + wid * 1024)); \
        glds16(v0src + ro_, (unsigned)__builtin_amdgcn_readfirstlane(sb_ + L_V + pz0 * 1024)); glds16(v1src + ro_, (unsigned)__builtin_amdgcn_readfirstlane(sb_ + L_V + pz1 * 1024)); } while (0)
    const int jlo = attn_jlo(h, qt), jhi = 2 * qt + 1, nt = jhi - jlo + 1;
    bf16x8 qr[4];
#pragma unroll
    for (int d0 = 0; d0 < 4; ++d0) qr[d0] = *reinterpret_cast<const bf16x8*>(&Qw[(long)r32 * PITCH + d0 * 16 + hi * 8]);
    DMA_TILE(jlo, 0);
    if (nt > 1) DMA_TILE(jlo + 1, SLOT);
    f32x16 cin;
#pragma unroll
    for (int r = 0; r < 16; ++r) cin[r] = slope2 * (float)(64 * jlo + crow(r, hi) - myq) - B2;
    const float d32 = 32.f * slope2, d64 = 64.f * slope2;
    f32x16 o[4]; o[0] = f32x16{}; o[1] = f32x16{}; o[2] = f32x16{}; o[3] = f32x16{};
    float l_reg = 0.f;
    const unsigned vbl = lds0 + L_V + ((lane >> 4) & 1) * 32 + (lane & 3) * 8 + (4 * hi + ((lane & 15) >> 2)) * 64;
    int slot = 0, slot2 = 2 * SLOT;
    for (int it = 0; it < nt; ++it) {
        const int j = jlo + it;
        if (it + 1 < nt) asm volatile("s_waitcnt vmcnt(4) lgkmcnt(0)\n\ts_barrier" ::: "memory"); else asm volatile("s_waitcnt vmcnt(0) lgkmcnt(0)\n\ts_barrier" ::: "memory");
        if (it + 2 < nt) DMA_TILE(j + 2, slot2);
        f32x16 p0, p1;
        qkt(p0, p1, (lds_cptr)(shm + slot + comp * 8192), qr, cin, r32, hi);
        if (64 * j + 63 > q0 + 32 * wq) {
            const int kb = 64 * j + 4 * hi;
#pragma unroll
            for (int r = 0; r < 16; ++r) { const int kv = kb + (r & 3) + 8 * (r >> 2); if (kv > myq) p0[r] = -INFINITY; if (kv + 32 > myq) p1[r] = -INFINITY; }
        }
        float sacc = 0.f;
#pragma unroll
        for (int r = 0; r < 16; ++r) { p0[r] = __builtin_amdgcn_exp2f(p0[r]); p1[r] = __builtin_amdgcn_exp2f(p1[r] + d32); sacc += p0[r] + p1[r]; }
        l_reg += sacc;
        v4u w0, w1, w2, w3;
        w0 = (v4u){cvtpk(p0[0], p0[1]), cvtpk(p0[2], p0[3]), cvtpk(p0[4], p0[5]), cvtpk(p0[6], p0[7])};
        w1 = (v4u){cvtpk(p0[8], p0[9]), cvtpk(p0[10], p0[11]), cvtpk(p0[12], p0[13]), cvtpk(p0[14], p0[15])};
        w2 = (v4u){cvtpk(p1[0], p1[1]), cvtpk(p1[2], p1[3]), cvtpk(p1[4], p1[5]), cvtpk(p1[6], p1[7])};
        w3 = (v4u){cvtpk(p1[8], p1[9]), cvtpk(p1[10], p1[11]), cvtpk(p1[12], p1[13]), cvtpk(p1[14], p1[15])};
        pv(o, vbl + (unsigned)slot, __builtin_bit_cast(bf16x8, w0), __builtin_bit_cast(bf16x8, w1), __builtin_bit_cast(bf16x8, w2), __builtin_bit_cast(bf16x8, w3));
#pragma unroll
        for (int r = 0; r < 16; ++r) cin[r] += d64;
        slot2 = slot; slot = (slot == 2 * SLOT) ? 0 : slot + SLOT;
    }
#undef DMA_TILE
    { auto rr = __builtin_amdgcn_permlane32_swap(__float_as_uint(l_reg), __float_as_uint(l_reg), false, false); l_reg = __uint_as_float(rr[0]) + __uint_as_float(rr[1]); }
    LAS float* wsf = (LAS float*)(shm + L_WS) + wid * 64;
    if (hi == 0) wsf[r32] = l_reg;
    asm volatile("s_waitcnt lgkmcnt(0)" ::: "memory");
    float rli[16];
#pragma unroll
    for (int r = 0; r < 16; ++r) rli[r] = __builtin_amdgcn_rcpf(wsf[crow(r, hi)]) * (comp ? lam : 1.f);
    asm volatile("s_waitcnt lgkmcnt(0)\n\ts_barrier" ::: "memory");
    LAS float* XO = (LAS float*)(shm + L_XO) + (32 * wq) * XOS;
    if (comp == 1) {
#pragma unroll
        for (int d0 = 0; d0 < 4; ++d0)
#pragma unroll
            for (int r = 0; r < 16; ++r) XO[crow(r, hi) * XOS + 32 * d0 + r32] = o[d0][r] * rli[r];
    }
    asm volatile("s_waitcnt lgkmcnt(0)\n\ts_barrier" ::: "memory");
    if (comp == 0) {
#pragma unroll
        for (int d0 = 0; d0 < 4; ++d0)
#pragma unroll
            for (int r = 0; r < 16; ++r) { LAS float* p = XO + crow(r, hi) * XOS + 32 * d0 + r32; *p = o[d0][r] * rli[r] - *p; }
        asm volatile("s_waitcnt lgkmcnt(0)" ::: "memory");
        const int row = lane >> 1, half = lane & 1;
        const LAS f32x4* rp = (const LAS f32x4*)(XO + row * XOS + 64 * half);
        f32x4 v[16]; float ss = 0.f;
#pragma unroll
        for (int i = 0; i < 16; ++i) { v[i] = rp[i]; ss += (v[i][0] * v[i][0] + v[i][1] * v[i][1]) + (v[i][2] * v[i][2] + v[i][3] * v[i][3]); }
        ss += __shfl_xor(ss, 1);
        const float rn = pg8::fast_rsq(ss * (1.f / 128.f) + EPS);
        bf16* op = Out + (rowbase + q0 + 32 * wq + row) * D + h * 128 + 64 * half;
#pragma unroll
        for (int i = 0; i < 8; ++i) { const f32x4 a = v[2 * i] * rn, c = v[2 * i + 1] * rn; *(v4u*)(op + 8 * i) = (v4u){cvtpk(a[0], a[1]), cvtpk(a[2], a[3]), cvtpk(c[0], c[1]), cvtpk(c[2], c[3])}; }
    }
    asm volatile("s_waitcnt lgkmcnt(0)\n\ts_barrier" ::: "memory");
}
}

__device__ __forceinline__ void attn_phase(Frame& F, const float* const* in) {
    const float a1 = wave_sum(in[13][F.lane] * in[14][F.lane]), a2 = wave_sum(in[15][F.lane] * in[16][F.lane]);
    const float lam = __expf(a1) - __expf(a2) + LAMBDA_INIT;
    float gq = fabsf(in[11][F.lane]), gk = fabsf(in[12][F.lane]);
#pragma unroll
    for (int o = 1; o < 64; o <<= 1) { gq = fmaxf(gq, __shfl_xor(gq, o)); gk = fmaxf(gk, __shfl_xor(gk, o)); }
    const float B2 = 8.f * gq * gk * LOG2E * 1.0001f + 0.01f;
    const int b = F.vcu >> 5, jj = F.vcu & 31;
    const int* uo = (const int*)(F.ws + WS_UORDER);
    const bf16* QKV = (const bf16*)(F.ws + WS_BIG); bf16* Out = (bf16*)(F.ws + WS_ACT1);
    if (F.vcu >= 256) return;
    for (int i = 0; i < 16; ++i) {
        const int rank = 32 * i + ((i & 1) ? 31 - jj : jj);
        const int un = __builtin_amdgcn_readfirstlane(uo[rank]); const int h = un >> 6, qt = un & 63;
        const float slope2 = LOG2E * __builtin_ldexpf(1.f, -(h + 1));
        att::attn_unit(b, h, qt, QKV, Out, F.lds + RING_OFF, lam, slope2, B2);
    }
}

__device__ __forceinline__ void router_phase(Frame& F, const float* h3) {
    LAS float* R = (LAS float*)(F.lds + RING_OFF);
    LAS unsigned* cnt = (LAS unsigned*)(F.lds + RING_OFF + 32768);
    const float* Rg = (const float*)(F.ws + WS_ROUTER);
    for (int i = F.tid; i < D * NE / 4; i += NWAVES * 64) ((LAS f32x4*)R)[i] = ((const f32x4*)Rg)[i];
    if (F.tid < 16) cnt[F.tid] = 0u;
    __syncthreads();
    const unsigned long long* st3 = (const unsigned long long*)(F.ws + WS_ST3); int* toke = (int*)(F.ws + WS_TOKE); float* tokg = (float*)(F.ws + WS_TOKG);
    const int wg = blockIdx.x;
    for (int i = 0; i < 32; ++i) {
        const int m = wg * 256 + F.wave * 32 + i;
        const GAS f32x4* xr = (const GAS f32x4*)(h3 + (size_t)m * D) + F.lane;
        float lg[8];
#pragma unroll
        for (int e = 0; e < 8; ++e) lg[e] = 0.f;
#pragma unroll
        for (int j = 0; j < 4; ++j) { const f32x4 v = xr[64 * j]; const int k0 = 4 * (F.lane + 64 * j);
#pragma unroll
            for (int c = 0; c < 4; ++c) { const f32x4 ra = *(const LAS f32x4*)(R + (k0 + c) * 8), rb = *(const LAS f32x4*)(R + (k0 + c) * 8 + 4);
                lg[0] += v[c] * ra[0]; lg[1] += v[c] * ra[1]; lg[2] += v[c] * ra[2]; lg[3] += v[c] * ra[3]; lg[4] += v[c] * rb[0]; lg[5] += v[c] * rb[1]; lg[6] += v[c] * rb[2]; lg[7] += v[c] * rb[3]; } }
        const float r = pg8::st_rscale(st3, m);
#pragma unroll
        for (int e = 0; e < 8; ++e) lg[e] = wave_sum(lg[e]) * r;
        int i1 = 0; float v1 = lg[0];
#pragma unroll
        for (int e = 1; e < 8; ++e) if (lg[e] > v1) { v1 = lg[e]; i1 = e; }
        int i2 = -1; float v2 = -INFINITY;
#pragma unroll
        for (int e = 0; e < 8; ++e) if (e != i1 && lg[e] > v2) { v2 = lg[e]; i2 = e; }
        if (i2 < 0) { i2 = (i1 + 1) & 7; v2 = v1; }
        const float g1 = 1.f / (1.f + __expf(v2 - v1)), g2 = 1.f - g1;
        if (F.lane == 0) { toke[2 * m] = i1; toke[2 * m + 1] = i2; tokg[2 * m] = g1; tokg[2 * m + 1] = g2; lds_inc(cnt + i1); lds_inc(cnt + 8 + i2); }
    }
    __syncthreads();
    if (F.tid < 16) ((unsigned*)(F.ws + WS_WGCNT))[wg * 16 + F.tid] = cnt[F.tid];
}

__device__ __forceinline__ void gather_rows(Frame& F, int rank) {
    const bf16* hb = (const bf16*)(F.ws + WS_ACT0); bf16* Xs = (bf16*)(F.ws + WS_ACT1); const int* toks = (const int*)(F.ws + WS_TOKS);
    const int wg = blockIdx.x;
    for (int i = 0; i < 32; ++i) {
        const int m = wg * 256 + F.wave * 32 + i; const int slot = toks[2 * m + rank];
        const GAS v4u* s = (const GAS v4u*)(hb + (size_t)m * D) + F.lane; GAS v4u* d = (GAS v4u*)(Xs + (size_t)slot * D) + F.lane;
        d[0] = s[0]; d[64] = s[64];
    }
}

__device__ __forceinline__ void assign_phase(Frame& F) {
    LAS unsigned* tot = (LAS unsigned*)(F.lds + RING_OFF);
    LAS unsigned* pre = tot + 16; LAS unsigned* base = tot + 32; LAS unsigned* cur = tot + 48; LAS unsigned* start = tot + 64;
    const int wg = blockIdx.x;
    if (F.tid < 128) tot[F.tid] = 0u;
    __syncthreads();
    const unsigned* wgcnt = (const unsigned*)(F.ws + WS_WGCNT);
    for (int idx = F.tid; idx < 256 * 16; idx += NWAVES * 64) { const unsigned v = wgcnt[idx]; const int w = idx >> 4, i = idx & 15; lds_add(tot + i, v); if (w < wg) lds_add(pre + i, v); }
    __syncthreads();
    if (F.tid < 2) { unsigned s = 0; for (int e = 0; e < 8; ++e) { start[F.tid * 9 + e] = s; s += (tot[F.tid * 8 + e] + 255u) & ~255u; } start[F.tid * 9 + 8] = s; }
    __syncthreads();
    if (F.tid < 16) { base[F.tid] = start[(F.tid >> 3) * 9 + (F.tid & 7)] + pre[F.tid]; }
    if (wg == 0 && F.tid < 18) ((int*)(F.ws + WS_RTS))[(F.tid / 9) * 16 + (F.tid % 9)] = (int)(start[F.tid] >> 8);
    __syncthreads();
    int* s2t = (int*)(F.ws + WS_S2T); float* sg = (float*)(F.ws + WS_SG); float* sr = (float*)(F.ws + WS_SR); int* toks = (int*)(F.ws + WS_TOKS);
    const int* toke = (const int*)(F.ws + WS_TOKE); const float* tokg = (const float*)(F.ws + WS_TOKG); const unsigned long long* st3 = (const unsigned long long*)(F.ws + WS_ST3);
    if (F.tid < 256) {
        const int m = wg * 256 + F.tid; const float r = pg8::st_rscale(st3, m);
#pragma unroll
        for (int rk = 0; rk < 2; ++rk) { const int e = toke[2 * m + rk]; const unsigned pos = lds_add(cur + rk * 8 + e, 1u); const int slot = (int)(base[rk * 8 + e] + pos);
            s2t[rk * SLOTS_MAX + slot] = m; sg[rk * SLOTS_MAX + slot] = tokg[2 * m + rk]; sr[rk * SLOTS_MAX + slot] = r; toks[2 * m + rk] = slot; }
    }
    if (wg < 16) {
        const int rk = wg >> 3, e = wg & 7; const unsigned lo = start[rk * 9 + e] + tot[wg], hi = start[rk * 9 + e + 1];
        for (unsigned s = lo + F.tid; s < hi; s += NWAVES * 64) { s2t[rk * SLOTS_MAX + s] = -1; sg[rk * SLOTS_MAX + s] = 0.f; sr[rk * SLOTS_MAX + s] = 0.f; }
    }
    __syncthreads();
    __threadfence_block();
    gather_rows(F, 0);
}

struct Args { const float* in[23]; float* out; unsigned char* ws; int ph_lo, ph_hi; };
static_assert(sizeof(Args) == 25 * 8 + 8, "no padding in Args");
__global__ void __launch_bounds__(NWAVES * 64, 2) fwd_kernel(Args args) {
    extern __shared__ __attribute__((aligned(16))) unsigned char lds[];
    Frame F;
    F.lds = (LAS unsigned char*)lds;
    F.MISC = (volatile LAS unsigned*)(F.lds + MISC_OFF);
    F.tid = threadIdx.x; F.lane = F.tid & 63; F.wave = __builtin_amdgcn_readfirstlane(F.tid >> 6);
    F.G = gridDim.x; { const int bx = blockIdx.x; F.vcu = (F.G % 8 == 0) ? (bx % 8) * (F.G / 8) + bx / 8 : bx; }
    F.ws = args.ws; F.ctl = (gu32*)(args.ws + WS_CTL);
    unsigned char* ws = args.ws;
    for (int u = F.tid; u < (LDS_BYTES - LDSCTL_OFF) / 4; u += NWAVES * 64) ((LAS unsigned*)(F.lds + LDSCTL_OFF))[u] = 0u;
    __syncthreads();
    XcdBarrier bar; bar.bar = (unsigned*)(F.ctl + CW_BAR); bar.x = 0; bar.st = nullptr;
    if (N_LAUNCHES == 1) bar = xcd_barrier_post((unsigned*)(F.ctl + CW_BAR), F.MISC + 8);
#define GRID_BAR() do { if (N_LAUNCHES == 1) xcd_barrier(bar); } while (0)
    const int lo = args.ph_lo, hi = args.ph_hi;
#define IN(k) (lo <= (k) && (k) < hi)
#define BOTH(k) (IN(k) && IN((k) + 1))
    bf16* ACT0 = (bf16*)(ws + WS_ACT0); bf16* ACT1 = (bf16*)(ws + WS_ACT1); bf16* BIG = (bf16*)(ws + WS_BIG);
    float* ST0 = (float*)(ws + WS_ST0); unsigned long long* ST1 = (unsigned long long*)(ws + WS_ST1); unsigned long long* ST2 = (unsigned long long*)(ws + WS_ST2); unsigned long long* ST3 = (unsigned long long*)(ws + WS_ST3);

    if (IN(0)) { p0_prologue(F, args.in); if (BOTH(0)) GRID_BAR(); }
    if (IN(1)) {
        pg8::Gemm g{ACT0, (const bf16*)(ws + WS_W1), M, 4096, D}; pg8::StaticOrder S; S.init(M, 4096, F.G, (int)blockIdx.x);
        pg8::EpiHgrnIn E{BIG, ST0, (const float*)(ws + WS_LB)};
        pg8::gemm_phase<pg8::EpiHgrnIn, pg8::StaticOrder, true, true>(F.lds + RING_OFF, g, S, E);
        if (BOTH(1)) GRID_BAR();
    }
    if (IN(2)) { scan_phase(F); if (BOTH(2)) GRID_BAR(); }
    if (IN(3)) { hgrn_gate_phase(F); if (BOTH(3)) GRID_BAR(); }
    if (IN(4)) {
        pg8::Gemm g{ACT1, (const bf16*)(ws + WS_W2), M, D, D}; pg8::StaticOrder S; S.init(M, D, F.G, (int)blockIdx.x);
        pg8::EpiRes E{args.in[0], args.out, ACT0, ST1};
        pg8::gemm_phase<pg8::EpiRes, pg8::StaticOrder, true, true>(F.lds + RING_OFF, g, S, E);
        if (BOTH(4)) GRID_BAR();
    }
    if (IN(5)) {
        pg8::Gemm g{ACT0, (const bf16*)(ws + WS_W3), M, 2 * FF, D}; pg8::StaticOrder S; S.init(M, 2 * FF, F.G, (int)blockIdx.x);
        pg8::EpiSwiGLU E{BIG, FF, ST1, nullptr, 2 * FF / 256};
        pg8::gemm_phase<pg8::EpiSwiGLU, pg8::StaticOrder, true, true>(F.lds + RING_OFF, g, S, E);
        if (BOTH(5)) GRID_BAR();
    }
    if (IN(6)) {
        pg8::Gemm g{BIG, (const bf16*)(ws + WS_W4), M, D, FF}; pg8::StaticOrder S; S.init(M, D, F.G, (int)blockIdx.x);
        pg8::EpiRes E{args.out, args.out, ACT0, ST2};
        pg8::gemm_phase<pg8::EpiRes, pg8::StaticOrder, true, true>(F.lds + RING_OFF, g, S, E);
        if (BOTH(6)) GRID_BAR();
    }
    if (IN(7)) {
        pg8::Gemm g{ACT0, (const bf16*)(ws + WS_W5), M, 3 * D, D}; pg8::StaticOrder S; S.init(M, 3 * D, F.G, (int)blockIdx.x);
        pg8::EpiQKV E{BIG, ST2, args.in[11], args.in[12]};
        pg8::gemm_phase<pg8::EpiQKV, pg8::StaticOrder, true, true>(F.lds + RING_OFF, g, S, E);
        if (BOTH(7)) GRID_BAR();
    }
    if (IN(8)) { attn_phase(F, args.in); if (BOTH(8)) GRID_BAR(); }
    if (IN(9)) {
        pg8::Gemm g{ACT1, (const bf16*)(ws + WS_W6), M, D, D}; pg8::StaticOrder S; S.init(M, D, F.G, (int)blockIdx.x);
        pg8::EpiRes E{args.out, args.out, ACT0, ST3};
        pg8::gemm_phase<pg8::EpiRes, pg8::StaticOrder, true, true>(F.lds + RING_OFF, g, S, E);
        if (BOTH(9)) GRID_BAR();
    }
    if (IN(10)) { router_phase(F, args.out); if (BOTH(10)) GRID_BAR(); }
    if (IN(11)) { assign_phase(F); if (BOTH(11)) GRID_BAR(); }
#define MOE_UP(rk) do { pg8::Gemm g{ACT1, (const bf16*)(ws + WS_W7), 0, 0, D}; pg8::GroupedOrder S; S.init((const int*)(ws + WS_RTS) + 16 * (rk), 2 * EF / 256, F.G, (int)blockIdx.x); \
        pg8::EpiSwiGLU E{BIG, EF, nullptr, (const float*)(ws + WS_SR) + (rk) * SLOTS_MAX, 2 * EF / 256}; \
        pg8::gemm_phase<pg8::EpiSwiGLU, pg8::GroupedOrder, true, true>(F.lds + RING_OFF, g, S, E); } while (0)
#define MOE_DOWN(rk) do { pg8::Gemm g{BIG, (const bf16*)(ws + WS_W8), 0, 0, EF}; pg8::GroupedOrder S; S.init((const int*)(ws + WS_RTS) + 16 * (rk), D / 256, F.G, (int)blockIdx.x); \
        pg8::EpiMoeDown E{args.out, (const int*)(ws + WS_S2T) + (rk) * SLOTS_MAX, (const float*)(ws + WS_SG) + (rk) * SLOTS_MAX, D / 256}; \
        pg8::gemm_phase<pg8::EpiMoeDown, pg8::GroupedOrder, true, true>(F.lds + RING_OFF, g, S, E); } while (0)
    if (IN(12)) { MOE_UP(0); if (BOTH(12)) GRID_BAR(); }
    if (IN(13)) { gather_rows(F, 1); __syncthreads(); MOE_DOWN(0); if (BOTH(13)) GRID_BAR(); }
    if (IN(14)) { MOE_UP(1); if (BOTH(14)) GRID_BAR(); }
    if (IN(15)) { MOE_DOWN(1); }
#undef IN
#undef BOTH
}

#ifdef MK_DEBUG_NAN
__global__ void chk_kernel(const unsigned* buf, size_t nwords, int is_f32, unsigned* flag, unsigned bit) {
    bool bad = false;
    for (size_t i = blockIdx.x * (size_t)blockDim.x + threadIdx.x; i < nwords; i += (size_t)gridDim.x * blockDim.x) { const unsigned w = buf[i];
        if (is_f32) bad |= (w & 0x7f800000u) == 0x7f800000u; else bad |= ((w & 0x7f80u) == 0x7f80u) || ((w & 0x7f800000u) == 0x7f800000u); }
    if (bad) atomicOr(flag, bit);
}
__global__ void cnt_kernel(const unsigned short* buf, size_t n, unsigned* cnt) {
    unsigned c = 0;
    for (size_t i = blockIdx.x * (size_t)blockDim.x + threadIdx.x; i < n; i += (size_t)gridDim.x * blockDim.x) c += ((buf[i] & 0x7f80u) == 0x7f80u) ? 1u : 0u;
    if (c) atomicAdd(cnt, c);
}
__global__ void minlf_kernel(const unsigned short* qfvg, unsigned* mx) {
    unsigned m = 0;
    for (size_t i = blockIdx.x * (size_t)blockDim.x + threadIdx.x; i < (size_t)M * 1024; i += (size_t)gridDim.x * blockDim.x) {
        const size_t row = i >> 10, c = i & 1023; const float v = __builtin_bit_cast(float, (unsigned)qfvg[row * 4096 + 1024 + c] << 16);
        const float q = fminf(fmaxf(-v * 2.f + 0.5f, 0.f), 15.f); m = max(m, (unsigned)q); }
    atomicMax(mx, m);
}
__global__ void maxabs_kernel(const unsigned short* qfvg, unsigned* mx) {
    unsigned m = 0;
    for (size_t i = blockIdx.x * (size_t)blockDim.x + threadIdx.x; i < (size_t)M * 4096; i += (size_t)gridDim.x * blockDim.x) {
        const size_t c = i & 4095; if (c >= 1024 && c < 2048) continue; m = max(m, ((unsigned)qfvg[i] << 16) & 0x7fffffffu); }
    atomicMax(mx, m);
}
__global__ void firstnan_kernel(const unsigned short* buf, size_t n, unsigned* mn) {
    unsigned m = 0xffffffffu;
    for (size_t i = blockIdx.x * (size_t)blockDim.x + threadIdx.x; i < n; i += (size_t)gridDim.x * blockDim.x) if ((buf[i] & 0x7f80u) == 0x7f80u) m = min(m, (unsigned)i);
    atomicMax(mn, ~m);
}
__global__ void report3_kernel(float* out, size_t n, const unsigned* w) {
    for (size_t i = blockIdx.x * (size_t)blockDim.x + threadIdx.x; i < n; i += (size_t)gridDim.x * blockDim.x) out[i] = 0.f;
    __syncthreads();
    if (blockIdx.x == 0 && threadIdx.x == 0) { const float mxv = __builtin_bit_cast(float, w[0]); int A = 0; while (A < 60 && __builtin_ldexpf(1.f, A) < mxv) ++A;
        const unsigned idx = ~w[1];    const unsigned row = idx >> 10; const unsigned B = (row & 8191u) >> 9;
        out[0] = 8192.f * (1.f + (float)B / 16.f) * __builtin_ldexpf(1.f, A); }
}
__global__ void report2_kernel(float* out, size_t n, const unsigned* w) {
    for (size_t i = blockIdx.x * (size_t)blockDim.x + threadIdx.x; i < n; i += (size_t)gridDim.x * blockDim.x) out[i] = 0.f;
    __syncthreads();
    if (blockIdx.x == 0 && threadIdx.x == 0) { const unsigned cnt = w[0], B = w[1]; int A = 0; while ((1ull << A) < (unsigned long long)cnt + 1ull) ++A; out[0] = 8192.f * (1.f + (float)B / 16.f) * __builtin_ldexpf(1.f, A); }
}
__global__ void report_kernel(float* out, size_t n, const unsigned* flag) {
    for (size_t i = blockIdx.x * (size_t)blockDim.x + threadIdx.x; i < n; i += (size_t)gridDim.x * blockDim.x) out[i] = 0.f;
    __syncthreads();
    if (blockIdx.x == 0 && threadIdx.x == 0) out[0] = 8192.f * __builtin_ldexpf(1.f, 2 * (int)(*flag & 15u));
}
#endif
extern "C" void kernel_launch(void* const* d_in, const int* in_sizes, int n_in, void* d_out, int out_size, void* d_ws, size_t ws_size, hipStream_t stream) {
    static int grid = 0;
    if (grid == 0) {
        if (n_in != 23 || in_sizes[0] != M * D || out_size != M * D || ws_size < WS_END) { fprintf(stderr, "kernel_launch: unexpected shapes (n_in %d, in0 %d, out %d, ws %zu); nothing launched\n", n_in, n_in > 0 ? in_sizes[0] : -1, out_size, ws_size); grid = -1; return; }
        int dev = 0, cus = 0, per_cu = 0;
        if (hipGetDevice(&dev) != hipSuccess || hipDeviceGetAttribute(&cus, hipDeviceAttributeMultiprocessorCount, dev) != hipSuccess) { grid = -1; return; }
        if (hipFuncSetAttribute((const void*)fwd_kernel, hipFuncAttributeMaxDynamicSharedMemorySize, LDS_BYTES) != hipSuccess) { fprintf(stderr, "kernel_launch: hipFuncSetAttribute failed\n"); grid = -1; return; }
        if (hipOccupancyMaxActiveBlocksPerMultiprocessor(&per_cu, (const void*)fwd_kernel, NWAVES * 64, LDS_BYTES) != hipSuccess || per_cu < 1) fprintf(stderr, "kernel_launch: occupancy query reports %d\n", per_cu);
        (void)hipGetLastError();
        grid = cus;
        if (grid != 256) fprintf(stderr, "kernel_launch: %d CUs; this kernel is built for 256\n", grid);
    }
    if (grid < 0) return;
    if (hipMemsetAsync((char*)d_ws + WS_CTL, 0, CTL_ZERO_BYTES, stream) != hipSuccess) return;
    Args a{};
    for (int i = 0; i < 23; ++i) a.in[i] = (const float*)d_in[i];
    a.out = (float*)d_out; a.ws = (unsigned char*)d_ws;
#ifndef MK_CUT
#define MK_CUT N_PHASES
#endif
    for (int li = 0; li < N_LAUNCHES; ++li) {
        a.ph_lo = (N_LAUNCHES == 1) ? 0 : li; a.ph_hi = (N_LAUNCHES == 1) ? MK_CUT : li + 1;
        if (a.ph_lo >= MK_CUT) break;
        hipLaunchKernelGGL(fwd_kernel, dim3(grid), dim3(NWAVES * 64), LDS_BYTES, stream, a);
        if (hipPeekAtLastError() != hipSuccess) break;
#ifdef MK_DEBUG_NAN
        { unsigned* flag = (unsigned*)d_ws + 2; unsigned char* w = (unsigned char*)d_ws;
          MK_DEBUG_CHECKS }
#endif
    }
#ifdef MK_DEBUG_NAN
    MK_DEBUG_REPORT
#endif
}
```

```cpp
#include <hip/hip_runtime.h>
#include <cstdio>
#include <cstdint>
#include <cmath>
namespace pg8 {
#define PG8_LAS __attribute__((address_space(3)))
typedef unsigned short bf16_t;
typedef short bf16x8 __attribute__((ext_vector_type(8)));
typedef float f32x4 __attribute__((ext_vector_type(4)));
typedef unsigned u32x4 __attribute__((ext_vector_type(4)));
constexpr int PG8_XROW_OFF = 135168;
constexpr int BM = 256, BK = 64, HALF = 128, HTB = HALF * BK * 2  , STAGE_BYTES = 8 * HTB, NXCD = 8, WGM = 8;

__host__ __device__ __forceinline__ int lds_byte(int r, int c) { const int st = (r >> 4) * 2 + (c >> 5), rr = r & 15, cc = c & 31, ob = rr * 64 + cc * 2; return st * 1024 + (ob ^ (((ob >> 9) & 1) << 5)); }
__host__ __device__ __forceinline__ void stage_rc(int b, int& R, int& C) { const int st = b / 1024, sb = b % 1024, swz = sb ^ (((sb >> 9) & 1) << 5); R = (st >> 1) * 16 + swz / 64; C = (st & 1) * 32 + (swz % 64) / 2; }
__host__ __device__ __forceinline__ int perm32(int rho) { const int n = rho >> 4, i = rho & 15; return 8 * (i >> 2) + 4 * n + (i & 3); }

struct Unit { int pm, pn; };
struct Gemm { const bf16_t* A; const bf16_t* Bt; int M, N, K; int ld; };

struct StaticOrder {
    int nM, nN, nwg, G, c, nx, sk, lim;
    __host__ __device__ void init(int M, int N, int G_, int c_) { nM = M / BM; nN = N / BM; nwg = nM * nN; G = G_; c = c_; nx = 0; sk = 0; lim = 0x7fffffff; }
    __host__ __device__ bool next(int i, Unit& u) const {
        const int ii = i + (c < nx ? sk : 0);
        const long L = ii < sk ? (long)ii * (G - nx) + (c - nx) : (long)sk * (G - nx) + (long)(ii - sk) * G + c; if (L >= nwg || L >= lim) return false;
        unit_at(L, u); return true;
    }
    __host__ __device__ void unit_at(long L, Unit& u) const {
        int wgid = (int)L; { const int q = nwg / NXCD, r = nwg % NXCD, xcd = wgid % NXCD, off = wgid / NXCD; wgid = (xcd < r ? xcd * (q + 1) : r * (q + 1) + (xcd - r) * q) + off; }
        const int nig = WGM * nN, gid = wgid / nig, fm = gid * WGM, gsz = (nM - fm) < WGM ? (nM - fm) : WGM;
        const int rem = wgid - gid * nig;
        if (gsz == WGM) { u.pm = fm + (int)((unsigned)rem & (unsigned)(WGM - 1)); u.pn = (int)((unsigned)rem >> 3); static_assert(WGM == 8, "shift"); }
        else { u.pm = fm + (rem % gsz); u.pn = rem / gsz; }
    }
    __device__ __forceinline__ void a_ready(const Unit&) const {}
    __device__ __forceinline__ void done(const Unit&) const {}
};

__device__ __forceinline__ unsigned cvt_pk_bf16(float lo, float hi) { unsigned r; asm volatile("v_cvt_pk_bf16_f32 %0, %1, %2" : "=v"(r) : "v"(lo), "v"(hi)); return r; }
typedef float f32x2 __attribute__((ext_vector_type(2)));

typedef int v8i_t __attribute__((ext_vector_type(8))); typedef int v4i_t __attribute__((ext_vector_type(4)));
template <class Epi, class Sched, bool ALIGN_EPI = false, bool SP2 = false, bool F8 = false>
__device__ __forceinline__ void gemm_phase(PG8_LAS unsigned char* lds, const Gemm g, const Sched& S, const Epi& E) {
    const int tid = threadIdx.x, wid = __builtin_amdgcn_readfirstlane(tid >> 6), lane = tid & 63, wr = wid >> 2, wc = wid & 3, fr = lane & 15, fq = lane >> 4;
    const int Kp_ = g.ld ? g.ld : g.K; const int K = F8 ? Kp_ / 2 : Kp_, nt = (F8 ? g.K / 2 : g.K) / BK;
    constexpr int NVO = F8 ? 1 : 2;
    unsigned voffA[NVO], voffB[NVO];
#pragma unroll
    for (int i = 0; i < NVO; ++i) { int R, C; stage_rc(tid * 16 + i * 8192, R, C); const int Rb = Epi::PERM ? ((R & ~31) + perm32(R & 31)) : R;
        voffA[i] = (unsigned)(R * K + C) * 2u; voffB[i] = (unsigned)(Rb * K + C) * 2u; }
    const size_t pstep = (size_t)64 * K * 2;
    const size_t kstep = (size_t)(BK * 2);
    const size_t hstep = (size_t)HALF * K * 2;
    const size_t tstep = 2 * hstep;
    const unsigned ldsbase = (unsigned)(uintptr_t)lds;
    const unsigned ldsw = (unsigned)wid * 1024u;
    const unsigned ldsw_s = (unsigned)__builtin_amdgcn_readfirstlane((int)(ldsbase + ldsw));
    const int aoff = lds_byte(wr * 64 + fr, fq * 8), boff = lds_byte(wc * 32 + fr, fq * 8);
#define PG8_SA(b, h) (((b) * 2 + (h)) * HTB)
#define PG8_SB(b, h) ((4 + (b) * 2 + (h)) * HTB)
#define PG8_STAGE(bufoff, gbase, voff) do { _Pragma("unroll") for (int _i = 0; _i < 2; ++_i) { \
        const unsigned long long gb_ = (unsigned long long)(gbase) + (unsigned long long)((F8 && _i) ? pstep : (size_t)0); const unsigned long long ub_ = ((unsigned long long)(unsigned)__builtin_amdgcn_readfirstlane((int)(gb_ >> 32)) << 32) | (unsigned)__builtin_amdgcn_readfirstlane((int)gb_); \
        asm volatile("s_add_i32 m0, %2, %3\n\ts_nop 0\n\tglobal_load_lds_dwordx4 %0, %1" : : "v"((voff)[F8 ? 0 : _i]), "s"(ub_), "s"(ldsw_s), "i"((int)(bufoff) + _i * 8192) : "memory", "scc"); } } while (0)
#define PG8_LDA(dst, b, h) do { _Pragma("unroll") for (int m = 0; m < 4; ++m) _Pragma("unroll") for (int k = 0; k < 2; ++k) dst[m][k] = *(const PG8_LAS bf16x8*)(lds + PG8_SA(b, h) + aoff + m * 2048 + k * 1024); } while (0)
#define PG8_LDB(dst, b, h) do { _Pragma("unroll") for (int n = 0; n < 2; ++n) _Pragma("unroll") for (int k = 0; k < 2; ++k) dst[n][k] = *(const PG8_LAS bf16x8*)(lds + PG8_SB(b, h) + boff + n * 2048 + k * 1024); } while (0)
#define PG8_MMA(ai, bj, At, Bt) do { __builtin_amdgcn_s_setprio(1); _Pragma("unroll") for (int m = 0; m < 4; ++m) _Pragma("unroll") for (int n = 0; n < 2; ++n) _Pragma("unroll") for (int k = 0; k < 2; ++k) \
        acc[ai][bj][m][n] = __builtin_amdgcn_mfma_f32_16x16x32_bf16(Bt[n][k], At[m][k], acc[ai][bj][m][n], 0, 0, 0); __builtin_amdgcn_s_setprio(0); } while (0)
#define PG8_MMA8(ai, bj, At, Bt) do { __builtin_amdgcn_s_setprio(1); _Pragma("unroll") for (int m = 0; m < 4; ++m) _Pragma("unroll") for (int n = 0; n < 2; ++n) \
        acc[ai][bj][m][n] = __builtin_amdgcn_mfma_scale_f32_16x16x128_f8f6f4(__builtin_shufflevector(__builtin_bit_cast(v4i_t, Bt[n][0]), __builtin_bit_cast(v4i_t, Bt[n][1]), 0, 1, 2, 3, 4, 5, 6, 7), \
            __builtin_shufflevector(__builtin_bit_cast(v4i_t, At[m][0]), __builtin_bit_cast(v4i_t, At[m][1]), 0, 1, 2, 3, 4, 5, 6, 7), acc[ai][bj][m][n], 0, 0, 0, 0, 0, 0); __builtin_amdgcn_s_setprio(0); } while (0)
#define PG8_MM(ai, bj, At, Bt) do { if constexpr (F8) PG8_MMA8(ai, bj, At, Bt); else PG8_MMA(ai, bj, At, Bt); } while (0)
#define PG8_WAIT_V(n) asm volatile("s_waitcnt vmcnt(" #n ")" ::: "memory")
#define PG8_WAIT_L(n) asm volatile("s_waitcnt lgkmcnt(" #n ")" ::: "memory")
#define PG8_BAR __builtin_amdgcn_s_barrier()
#define PG8_SCHED __builtin_amdgcn_sched_barrier(0)
#ifdef MK_GEMM_PROF
    unsigned long long gprof_[3] = {0, 0, 0}, gprev_ = 0;
#endif
    Unit cur, nxt; int ui = 0;
    if (!S.next(0, cur)) return;
    f32x4 acc[2][2][4][2];
#pragma unroll
    for (int a = 0; a < 2; ++a)
#pragma unroll
        for (int b = 0; b < 2; ++b)
#pragma unroll
            for (int m = 0; m < 4; ++m)
#pragma unroll
                for (int n = 0; n < 2; ++n) { acc[a][b][m][n] = (f32x4){0.f, 0.f, 0.f, 0.f}; if constexpr (F8) asm volatile("" : "+v"(acc[a][b][m][n])); }
    bf16x8 At[4][2], B0[2][2], B1[2][2];
    const char* cA = (const char*)g.A + (size_t)cur.pm * tstep; const char* cB = (const char*)g.Bt + (size_t)cur.pn * tstep;
    S.a_ready(cur);
    if constexpr (SP2) {
        PG8_STAGE(PG8_SB(0, 0), cB, voffB); PG8_STAGE(PG8_SB(0, 1), cB + hstep, voffB); PG8_STAGE(PG8_SA(0, 0), cA, voffA); PG8_STAGE(PG8_SA(0, 1), cA + hstep, voffA);
        if (wr == 1) PG8_BAR;
        PG8_WAIT_V(2); PG8_BAR;
        PG8_STAGE(PG8_SB(1, 0), cB + kstep, voffB); PG8_STAGE(PG8_SA(1, 0), cA + kstep, voffA); PG8_STAGE(PG8_SB(1, 1), cB + hstep + kstep, voffB);
        PG8_WAIT_V(6); PG8_BAR;
    } else {
        PG8_STAGE(PG8_SB(0, 0), cB, voffB); PG8_STAGE(PG8_SA(0, 0), cA, voffA); PG8_STAGE(PG8_SB(0, 1), cB + hstep, voffB); PG8_STAGE(PG8_SA(0, 1), cA + hstep, voffA);
        if (wr == 1) PG8_BAR;
        PG8_WAIT_V(4); PG8_BAR;
        PG8_STAGE(PG8_SB(1, 0), cB + kstep, voffB); PG8_STAGE(PG8_SA(1, 0), cA + kstep, voffA); PG8_STAGE(PG8_SB(1, 1), cB + hstep + kstep, voffB);
        PG8_WAIT_V(6); PG8_BAR;
    }
    for (;;) {
        const bool has_next = S.next(ui + 1, nxt);
#ifdef MK_GEMM_PROF
        unsigned long long gt0_ = 0; if constexpr (Epi::PROF) { gt0_ = __builtin_amdgcn_s_memtime(); if (gprev_) gprof_[2] += gt0_ - gprev_; }
#endif
        typename Epi::Pre pre; E.prefetch(pre, cur, wr, fr);
        if constexpr (Epi::NROWDMA > 0) { if (wid < 4 * Epi::NROWDMA) { unsigned keep_; const unsigned long long gb_ = (unsigned long long)E.row_src(wid >> 2, cur);
            const unsigned long long ub_ = ((unsigned long long)(unsigned)__builtin_amdgcn_readfirstlane((int)(gb_ >> 32)) << 32) | (unsigned)__builtin_amdgcn_readfirstlane((int)gb_);
            asm volatile("s_mov_b32 %0, m0\n\ts_mov_b32 m0, %3\n\ts_nop 0\n\tglobal_load_lds_dword %1, %2\n\ts_mov_b32 m0, %0" : "=&s"(keep_) : "v"((unsigned)((tid & 255) * 4)), "s"(ub_),
                "s"((unsigned)__builtin_amdgcn_readfirstlane((int)(ldsbase + PG8_XROW_OFF + (unsigned)(ui & 1) * 2048u + (unsigned)wid * 256u))) : "memory"); } }
        const char* nA = has_next ? (const char*)g.A + (size_t)nxt.pm * tstep : cA; const char* nB = has_next ? (const char*)g.Bt + (size_t)nxt.pn * tstep : cB;
        for (int t = 0; t < nt; t += 2) {
            const bool last = (t == nt - 2);
            const char* a1 = cA + (size_t)(t + 1) * kstep;
            const char* a2 = last ? nA : cA + (size_t)(t + 2) * kstep; const char* b2 = last ? nB : cB + (size_t)(t + 2) * kstep;
            const char* a3 = a2 + kstep; const char* b3 = b2 + kstep;
            if (last && has_next) S.a_ready(nxt);
            if constexpr (SP2) {
            PG8_LDB(B0, 0, 0); PG8_LDB(B1, 0, 1); PG8_SCHED; PG8_LDA(At, 0, 0); PG8_STAGE(PG8_SA(1, 1), a1 + hstep, voffA);
            PG8_WAIT_V(8); PG8_WAIT_L(0); PG8_BAR; PG8_MM(0, 0, At, B0); PG8_MM(0, 1, At, B1); PG8_BAR; PG8_SCHED;
            PG8_LDA(At, 0, 1); PG8_STAGE(PG8_SB(0, 0), b2, voffB); PG8_STAGE(PG8_SB(0, 1), b2 + hstep, voffB); PG8_STAGE(PG8_SA(0, 0), a2, voffA);
            PG8_WAIT_V(8); PG8_WAIT_L(0); PG8_BAR; PG8_MM(1, 0, At, B0); PG8_MM(1, 1, At, B1); PG8_BAR; PG8_SCHED;
            PG8_LDB(B0, 1, 0); PG8_LDB(B1, 1, 1); PG8_SCHED; PG8_LDA(At, 1, 0); PG8_STAGE(PG8_SA(0, 1), a2 + hstep, voffA);
            PG8_WAIT_V(8); PG8_WAIT_L(0); PG8_BAR; PG8_MM(0, 0, At, B0); PG8_MM(0, 1, At, B1); PG8_BAR; PG8_SCHED;
            PG8_LDA(At, 1, 1); PG8_STAGE(PG8_SB(1, 0), b3, voffB); PG8_STAGE(PG8_SB(1, 1), b3 + hstep, voffB); PG8_STAGE(PG8_SA(1, 0), a3, voffA);
            PG8_WAIT_V(8); PG8_WAIT_L(0); PG8_BAR; PG8_MM(1, 0, At, B0); PG8_MM(1, 1, At, B1); PG8_BAR; PG8_SCHED;
            } else {
            PG8_LDB(B0, 0, 0); PG8_SCHED; PG8_LDA(At, 0, 0); PG8_STAGE(PG8_SA(1, 1), a1 + hstep, voffA);
            PG8_WAIT_L(8); PG8_BAR; PG8_WAIT_L(0); PG8_MM(0, 0, At, B0); PG8_BAR; PG8_SCHED;
            PG8_LDB(B1, 0, 1); PG8_STAGE(PG8_SB(0, 0), b2, voffB);
            PG8_BAR; PG8_WAIT_L(0); PG8_MM(0, 1, At, B1); PG8_BAR;
            PG8_LDA(At, 0, 1); PG8_STAGE(PG8_SA(0, 0), a2, voffA);
            PG8_BAR; PG8_WAIT_L(0); PG8_MM(1, 0, At, B0); PG8_BAR; PG8_SCHED;
            PG8_STAGE(PG8_SB(0, 1), b2 + hstep, voffB);
            PG8_WAIT_V(6); PG8_BAR; PG8_MM(1, 1, At, B1); PG8_BAR;
            PG8_LDB(B0, 1, 0); PG8_SCHED; PG8_LDA(At, 1, 0); PG8_STAGE(PG8_SA(0, 1), a2 + hstep, voffA);
            PG8_WAIT_L(8); PG8_BAR; PG8_WAIT_L(0); PG8_MM(0, 0, At, B0); PG8_BAR; PG8_SCHED;
            PG8_LDB(B1, 1, 1); PG8_STAGE(PG8_SB(1, 0), b3, voffB);
            PG8_BAR; PG8_WAIT_L(0); PG8_MM(0, 1, At, B1); PG8_BAR;
            PG8_LDA(At, 1, 1); PG8_STAGE(PG8_SA(1, 0), a3, voffA);
            PG8_BAR; PG8_WAIT_L(0); PG8_MM(1, 0, At, B0); PG8_BAR; PG8_SCHED;
            PG8_STAGE(PG8_SB(1, 1), b3 + hstep, voffB);
            PG8_WAIT_V(6); PG8_BAR; PG8_MM(1, 1, At, B1); PG8_BAR;
            }
        }
#ifdef MK_GEMM_PROF
        unsigned long long gt1_ = 0; if constexpr (Epi::PROF) { gt1_ = __builtin_amdgcn_s_memtime(); gprof_[0] += gt1_ - gt0_; }
#endif
        if constexpr (ALIGN_EPI) { if (wr == 0) PG8_BAR; }
        if constexpr (!Epi::AFTER_DRAIN) { E(acc, cur, wr, wc, fr, fq, pre, (const PG8_LAS unsigned*)(lds + PG8_XROW_OFF + (ui & 1) * 2048)); S.done(cur); }
#ifdef MK_GEMM_PROF
        if constexpr (Epi::PROF) { gprev_ = __builtin_amdgcn_s_memtime(); gprof_[1] += gprev_ - gt1_; }
#endif
        if (!has_next) break;
#pragma unroll
        for (int a = 0; a < 2; ++a)
#pragma unroll
            for (int b = 0; b < 2; ++b)
#pragma unroll
                for (int m = 0; m < 4; ++m)
#pragma unroll
                    for (int n = 0; n < 2; ++n) { acc[a][b][m][n] = (f32x4){0.f, 0.f, 0.f, 0.f}; if constexpr (F8) asm volatile("" : "+v"(acc[a][b][m][n])); }
        cur = nxt; cA = nA; cB = nB; ++ui;
        if constexpr (ALIGN_EPI) { if (wr == 1) PG8_BAR; }
    }
#ifdef MK_GEMM_PROF
    if constexpr (Epi::PROF) { if (threadIdx.x == 0) { unsigned long long* g_ = (unsigned long long*)E.profbuf(); atomicAdd(g_ + 0, gprof_[0]); atomicAdd(g_ + 1, gprof_[1]); atomicAdd(g_ + 2, gprof_[2]); } }
#endif
    PG8_WAIT_V(0);
    if constexpr (!ALIGN_EPI) { if (wr == 0) PG8_BAR; }
    PG8_BAR;
    if constexpr (Epi::AFTER_DRAIN) { E.fused(acc, cur, wr, wc, fr, fq, lds, wid, lane); S.done(cur); }
#undef PG8_SA
#undef PG8_SB
#undef PG8_STAGE
#undef PG8_LDA
#undef PG8_LDB
#undef PG8_MMA
#undef PG8_MMA8
#undef PG8_MM
#undef PG8_WAIT_V
#undef PG8_WAIT_L
#undef PG8_BAR
#undef PG8_SCHED
}
}
namespace pg8 {
constexpr float LOG2E = 1.4426950408889634f;
constexpr float NORM_EPS = 1e-6f;
__device__ __forceinline__ float fast_exp2(float x) { return __builtin_amdgcn_exp2f(x); }
__device__ __forceinline__ float fast_rcp(float x) { return __builtin_amdgcn_rcpf(x); }
__device__ __forceinline__ float fast_rsq(float x) { return __builtin_amdgcn_rsqf(x); }
__device__ __forceinline__ float silu_f(float v) { return v * fast_rcp(1.f + fast_exp2(-LOG2E * v)); }
__device__ __forceinline__ float sigm_f(float v) { return fast_rcp(1.f + fast_exp2(-LOG2E * v)); }
__device__ __forceinline__ float st_rscale(const unsigned long long* st, int row) { return fast_rsq((float)st[row] * (1.f / (16777216.f * 1024.f)) + NORM_EPS); }
typedef float f32x2e __attribute__((ext_vector_type(2))); typedef __bf16 bf16x2e __attribute__((ext_vector_type(2)));
__device__ __forceinline__ unsigned cvt2(float lo, float hi) { f32x2e v = {lo, hi}; bf16x2e b = __builtin_convertvector(v, bf16x2e); return __builtin_bit_cast(unsigned, b); }
constexpr float A8S = 8.f, W8S = 256.f, ACC8 = 1.f / (A8S * W8S);
__device__ __forceinline__ float clamp8(float v) { return __builtin_amdgcn_fmed3f(v, -448.f, 448.f); }
__device__ __forceinline__ unsigned pk_fp8x4(float a, float b, float c, float d) { int w = __builtin_amdgcn_cvt_pk_fp8_f32(clamp8(a), clamp8(b), 0, false); w = __builtin_amdgcn_cvt_pk_fp8_f32(clamp8(c), clamp8(d), w, true); return (unsigned)w; }
typedef unsigned u32x2e __attribute__((ext_vector_type(2)));
__device__ __forceinline__ u32x2e pack8_fp8(const f32x4& a, const f32x4& b, float s) { u32x2e w; w.x = pk_fp8x4(a[0] * s, a[1] * s, a[2] * s, a[3] * s); w.y = pk_fp8x4(b[0] * s, b[1] * s, b[2] * s, b[3] * s); return w; }
__device__ __forceinline__ u32x4 pack8(const f32x4& a, const f32x4& b) { u32x4 w; w.x = cvt2(a[0], a[1]); w.y = cvt2(a[2], a[3]); w.z = cvt2(b[0], b[1]); w.w = cvt2(b[2], b[3]); return w; }

#define PG8_DPP_SHR1(x, n) __builtin_bit_cast(float, __builtin_amdgcn_update_dpp(0x3f800000, __builtin_bit_cast(int, (x)), 0x110 + (n), 0xf, 0xf, false))
#define PG8_DPP_SHR(x, n) __builtin_bit_cast(float, __builtin_amdgcn_update_dpp(0, __builtin_bit_cast(int, (x)), 0x110 + (n), 0xf, 0xf, true))
struct EpiHgrnIn {
    static constexpr bool PERM = true, AFTER_DRAIN = false, PROF = false; static constexpr int NROWDMA = 0;
    bf16_t* O; const float* st; const float* lb; float* dend;
    struct Pre { float s[2][4]; };
    __device__ __forceinline__ void prefetch(Pre& p, const Unit& u, int wr, int fr) const {
        const int row0 = u.pm * BM + wr * 64 + fr;
#pragma unroll
        for (int ai = 0; ai < 2; ++ai)
#pragma unroll
            for (int m = 0; m < 4; ++m) p.s[ai][m] = st[row0 + ai * HALF + m * 16];
    }
    __device__ __forceinline__ void operator()(const f32x4 (&acc)[2][2][4][2], const Unit& u, int wr, int wc, int fr, int fq, const Pre& pre, const PG8_LAS unsigned* xrow) const {
        const int row0 = u.pm * BM + wr * 64 + fr;
        float rsc[2][4];
#pragma unroll
        for (int ai = 0; ai < 2; ++ai)
#pragma unroll
            for (int m = 0; m < 4; ++m) rsc[ai][m] = fast_rsq(pre.s[ai][m] * (1.f / 1024.f) + NORM_EPS);
        if (u.pn < 8) {
            const int cq = 128 * u.pn + wc * 32 + 8 * fq;
            const int lane15 = ((int)(threadIdx.x & 48u)) | 15;
#pragma unroll
            for (int n = 0; n < 2; ++n) {
                const f32x4 lbv = *(const f32x4*)(lb + cq + 4 * n);
#pragma unroll
                for (int ai = 0; ai < 2; ++ai) {
                    f32x4 qv[4], kv[4]; f32x4 tot4;
#pragma unroll
                    for (int jp = 0; jp < 2; ++jp) {
                        const f32x2e l = {lbv[2 * jp], lbv[2 * jp + 1]}, oml = 1.f - l; f32x2e pf[4], om[4];
#pragma unroll
                        for (int m = 0; m < 4; ++m) {
                            const f32x2e fa = {acc[ai][1][m][n][2 * jp], acc[ai][1][m][n][2 * jp + 1]};
                            const f32x2e t = fa * (rsc[ai][m] * -LOG2E);
                            const f32x2e ex = {fminf(fast_exp2(t.x), 1e30f), fminf(fast_exp2(t.y), 1e30f)};
                            const f32x2e d = ex + 1.f;
                            const f32x2e sg = {fast_rcp(d.x), fast_rcp(d.y)};
                            om[m] = (oml * ex) * sg;
                            pf[m] = l + oml * sg;
                        }
#define PG8_PPSTEP(N) "v_mul_f32_dpp %0, %0, %0 row_shr:" #N " row_mask:0xf bank_mask:0xf\n v_mul_f32_dpp %1, %1, %1 row_shr:" #N " row_mask:0xf bank_mask:0xf\n v_mul_f32_dpp %2, %2, %2 row_shr:" #N " row_mask:0xf bank_mask:0xf\n v_mul_f32_dpp %3, %3, %3 row_shr:" #N " row_mask:0xf bank_mask:0xf\n" \
                      "v_mul_f32_dpp %4, %4, %4 row_shr:" #N " row_mask:0xf bank_mask:0xf\n v_mul_f32_dpp %5, %5, %5 row_shr:" #N " row_mask:0xf bank_mask:0xf\n v_mul_f32_dpp %6, %6, %6 row_shr:" #N " row_mask:0xf bank_mask:0xf\n v_mul_f32_dpp %7, %7, %7 row_shr:" #N " row_mask:0xf bank_mask:0xf\n"
                        { float p0 = pf[0].x, p1 = pf[0].y, p2 = pf[1].x, p3 = pf[1].y, p4 = pf[2].x, p5 = pf[2].y, p6 = pf[3].x, p7 = pf[3].y;
                          asm("s_nop 1\n" PG8_PPSTEP(1) PG8_PPSTEP(2) PG8_PPSTEP(4) PG8_PPSTEP(8) "s_nop 1\n" : "+v"(p0), "+v"(p1), "+v"(p2), "+v"(p3), "+v"(p4), "+v"(p5), "+v"(p6), "+v"(p7));
                          pf[0] = (f32x2e){p0, p1}; pf[1] = (f32x2e){p2, p3}; pf[2] = (f32x2e){p4, p5}; pf[3] = (f32x2e){p6, p7}; }
#undef PG8_PPSTEP
                        f32x2e off = {1.f, 1.f};
#pragma unroll
                        for (int m = 0; m < 4; ++m) {
                            const f32x2e t = {__shfl(pf[m].x, lane15), __shfl(pf[m].y, lane15)};
                            f32x2e F = pf[m] * off; off = off * t; F.x = fmaxf(F.x, 1e-36f); F.y = fmaxf(F.y, 1e-36f);
                            const f32x2e qa = {acc[ai][0][m][n][2 * jp], acc[ai][0][m][n][2 * jp + 1]};
                            const f32x2e tq = qa * (rsc[ai][m] * -LOG2E);
                            const f32x2e dq = (f32x2e){fast_exp2(tq.x), fast_exp2(tq.y)} + 1.f;
                            const f32x2e rq = {fast_rcp(dq.x), fast_rcp(dq.y)}, rF = {fast_rcp(F.x), fast_rcp(F.y)};
                            const f32x2e qo = ((qa * rsc[ai][m]) * F) * rq, ko = om[m] * rF;
                            qv[m][2 * jp] = qo.x; qv[m][2 * jp + 1] = qo.y; kv[m][2 * jp] = ko.x; kv[m][2 * jp + 1] = ko.y;
                        }
                        tot4[2 * jp] = fmaxf(off.x, 1e-36f); tot4[2 * jp + 1] = fmaxf(off.y, 1e-36f);
                    }
#pragma unroll
                    for (int m = 0; m < 4; ++m) {
                        bf16_t* rowp = O + (size_t)(row0 + ai * HALF + m * 16) * 4096 + cq + 4 * n;
                        u32x2e wq, wk; wq.x = cvt2(qv[m][0], qv[m][1]); wq.y = cvt2(qv[m][2], qv[m][3]); wk.x = cvt2(kv[m][0], kv[m][1]); wk.y = cvt2(kv[m][2], kv[m][3]);
                        *(u32x2e*)rowp = wq; *(u32x2e*)(rowp + 1024) = wk;
                    }
                    if (fr == 15) *(f32x4*)(dend + (size_t)(u.pm * 4 + ai * 2 + wr) * 1024 + cq + 4 * n) = tot4;
                }
            }
        } else {
            const int type = u.pn >> 2, col0 = u.pn * BM + wc * 32 + 8 * fq;
#pragma unroll
            for (int ai = 0; ai < 2; ++ai)
#pragma unroll
                for (int m = 0; m < 4; ++m) {
                    const int row = row0 + ai * HALF + m * 16; const float r = rsc[ai][m];
                    bf16_t* rowp = O + (size_t)row * 4096 + col0;
#pragma unroll
                    for (int bj = 0; bj < 2; ++bj) {
                        f32x4 v[2];
#pragma unroll
                        for (int n = 0; n < 2; ++n) {
                            v[n] = acc[ai][bj][m][n] * r;
                            if (type == 3) {
#pragma unroll
                                for (int jp = 0; jp < 2; ++jp) { const f32x2e x = {v[n][2 * jp], v[n][2 * jp + 1]}; const f32x2e t = x * -LOG2E;
                                    const f32x2e d = (f32x2e){fast_exp2(t.x), fast_exp2(t.y)} + 1.f; const f32x2e y = x * (f32x2e){fast_rcp(d.x), fast_rcp(d.y)}; v[n][2 * jp] = y.x; v[n][2 * jp + 1] = y.y; }
                            }
                        }
                        *(u32x4*)(rowp + bj * HALF) = pack8(v[0], v[1]);
                    }
                }
        }
    }
};

template <bool RES32> struct EpiRes {
    static constexpr bool PERM = true, AFTER_DRAIN = false, PROF = false; static constexpr int NROWDMA = 0;
    const float* res; bf16_t* ob; unsigned long long* st; float asc;
    struct Pre {}; __device__ __forceinline__ void prefetch(Pre&, const Unit&, int, int) const {}
    __device__ __forceinline__ void operator()(const f32x4 (&acc)[2][2][4][2], const Unit& u, int wr, int wc, int fr, int fq, const Pre&, const PG8_LAS unsigned* xrow) const {
        const int row0 = u.pm * BM + wr * 64 + fr, col0 = u.pn * BM + wc * 32 + 8 * fq;
#pragma unroll
        for (int ai = 0; ai < 2; ++ai)
#pragma unroll
            for (int m = 0; m < 4; ++m) {
                const int row = row0 + ai * HALF + m * 16; const size_t off = (size_t)row * 1024 + col0;
                float ss = 0.f;
#pragma unroll
                for (int bj = 0; bj < 2; ++bj) {
                    f32x4 r0, r1;
                    if constexpr (RES32) { r0 = *(const f32x4*)(res + off + bj * HALF); r1 = *(const f32x4*)(res + off + bj * HALF + 4); }
                    else { const u32x4 w = *(const u32x4*)(ob + off + bj * HALF);
                        r0 = (f32x4){__builtin_bit_cast(float, w.x << 16), __builtin_bit_cast(float, w.x & 0xffff0000u), __builtin_bit_cast(float, w.y << 16), __builtin_bit_cast(float, w.y & 0xffff0000u)};
                        r1 = (f32x4){__builtin_bit_cast(float, w.z << 16), __builtin_bit_cast(float, w.z & 0xffff0000u), __builtin_bit_cast(float, w.w << 16), __builtin_bit_cast(float, w.w & 0xffff0000u)}; }
                    const f32x4 v0 = acc[ai][bj][m][0] * asc + r0, v1 = acc[ai][bj][m][1] * asc + r1;
                    *(u32x4*)(ob + off + bj * HALF) = pack8(v0, v1);
                    ss += (v0[0] * v0[0] + v0[1] * v0[1]) + (v0[2] * v0[2] + v0[3] * v0[3]) + (v1[0] * v1[0] + v1[1] * v1[1]) + (v1[2] * v1[2] + v1[3] * v1[3]);
                }
                ss += __shfl_xor(ss, 16); ss += __shfl_xor(ss, 32);
                if (fq == 0) __hip_atomic_fetch_add(st + row, (unsigned long long)(ss * 16777216.f + 0.5f), __ATOMIC_RELAXED, __HIP_MEMORY_SCOPE_AGENT);
            }
    }
};

template <bool OUT8, bool PREF = true> struct EpiSwiGLU {
    static constexpr bool PERM = true, AFTER_DRAIN = false, PROF = !PREF; static constexpr int NROWDMA = PREF ? 0 : 1; void* pb; __device__ __forceinline__ void* profbuf() const { return pb; }
    __device__ __forceinline__ const void* row_src(int, const Unit& u) const { return sc + (size_t)u.pm * BM; }
    bf16_t* O; int ldc; const unsigned long long* st; const float* sc; int nNloc; float rs;
    struct Pre { float s[2][4]; };
    __device__ __forceinline__ void prefetch(Pre& p, const Unit& u, int wr, int fr) const {
        const int row0 = u.pm * BM + wr * 64 + fr;
#pragma unroll
        for (int ai = 0; ai < 2; ++ai)
#pragma unroll
            for (int m = 0; m < 4; ++m) { const int row = row0 + ai * HALF + m * 16; p.s[ai][m] = PREF ? (sc ? sc[row] : (float)st[row]) : 0.f; }
    }
    __device__ __forceinline__ void operator()(const f32x4 (&acc)[2][2][4][2], const Unit& u, int wr, int wc, int fr, int fq, const Pre& pre, const PG8_LAS unsigned* xrow) const {
        const int row0 = u.pm * BM + wr * 64 + fr, col0 = (u.pn % nNloc) * HALF + wc * 32 + 8 * fq;
        float rsc[2][4];
#pragma unroll
        for (int ai = 0; ai < 2; ++ai)
#pragma unroll
            for (int m = 0; m < 4; ++m) { const int row = row0 + ai * HALF + m * 16; rsc[ai][m] = PREF ? pre.s[ai][m] : __builtin_bit_cast(float, xrow[row - u.pm * BM]); }
#pragma unroll
        for (int ai = 0; ai < 2; ++ai)
#pragma unroll
            for (int m = 0; m < 4; ++m) {
                const int row = row0 + ai * HALF + m * 16;
                const float r = (sc ? rsc[ai][m] : fast_rsq(rsc[ai][m] * (1.f / (16777216.f * 1024.f)) + NORM_EPS)) * rs;
                const float rn = -LOG2E * r, cinv = fast_rcp(r * r * (OUT8 ? A8S : 1.f));
                f32x4 h[2];
#pragma unroll
                for (int n = 0; n < 2; ++n)
#pragma unroll
                    for (int jp = 0; jp < 2; ++jp) {
                        const f32x2e g = {acc[ai][0][m][n][2 * jp], acc[ai][0][m][n][2 * jp + 1]}, uu = {acc[ai][1][m][n][2 * jp], acc[ai][1][m][n][2 * jp + 1]};
                        const f32x2e t = g * rn;
                        const f32x2e d = (f32x2e){fast_exp2(t.x), fast_exp2(t.y)} * cinv + cinv;
                        const f32x2e q = {fast_rcp(d.x), fast_rcp(d.y)};
                        const f32x2e hv = (g * uu) * q;
                        h[n][2 * jp] = hv.x; h[n][2 * jp + 1] = hv.y; }
                if constexpr (OUT8) { u32x2e w; w.x = pk_fp8x4(h[0][0], h[0][1], h[0][2], h[0][3]); w.y = pk_fp8x4(h[1][0], h[1][1], h[1][2], h[1][3]); *(u32x2e*)((unsigned char*)O + (size_t)row * ldc + col0) = w; }
                else *(u32x4*)(O + (size_t)row * ldc + col0) = pack8(h[0], h[1]);
            }
    }
};

struct EpiQKV {
    static constexpr bool PERM = true, AFTER_DRAIN = false, PROF = false; static constexpr int NROWDMA = 0;
    bf16_t* O; const unsigned long long* st; const float* qg; const float* kg;
    struct Pre { float s[2][4]; };
    __device__ __forceinline__ void prefetch(Pre& p, const Unit& u, int wr, int fr) const {
        const int row0 = u.pm * BM + wr * 64 + fr;
#pragma unroll
        for (int ai = 0; ai < 2; ++ai)
#pragma unroll
            for (int m = 0; m < 4; ++m) p.s[ai][m] = (float)st[row0 + ai * HALF + m * 16];
    }
    __device__ __forceinline__ void operator()(const f32x4 (&acc)[2][2][4][2], const Unit& u, int wr, int wc, int fr, int fq, const Pre& pre, const PG8_LAS unsigned* xrow) const {
        const int row0 = u.pm * BM + wr * 64 + fr, type = u.pn >> 2, lc0 = u.pn * BM + 64 * wc + 8 * fq;
        const float* gp = (type == 0) ? qg : kg;
        f32x4 gv[2][2];
#pragma unroll
        for (int bj = 0; bj < 2; ++bj)
#pragma unroll
            for (int n = 0; n < 2; ++n) gv[bj][n] = (type < 2) ? *(const f32x4*)(gp + 32 * bj + 8 * fq + 4 * n) : (f32x4){1.f, 1.f, 1.f, 1.f};
        const float qs = (type == 0) ? 0.125f * LOG2E : 1.f;
        float rsc[2][4];
#pragma unroll
        for (int ai = 0; ai < 2; ++ai)
#pragma unroll
            for (int m = 0; m < 4; ++m) rsc[ai][m] = pre.s[ai][m];
#pragma unroll
        for (int ai = 0; ai < 2; ++ai)
#pragma unroll
            for (int m = 0; m < 4; ++m) {
                const int row = row0 + ai * HALF + m * 16;
                const float r = fast_rsq(rsc[ai][m] * (1.f / (16777216.f * 1024.f)) + NORM_EPS);
                f32x4 v[2][2]; float ss = 0.f;
#pragma unroll
                for (int bj = 0; bj < 2; ++bj)
#pragma unroll
                    for (int n = 0; n < 2; ++n) { v[bj][n] = acc[ai][bj][m][n] * r; const f32x4 x = v[bj][n]; ss += (x[0] * x[0] + x[1] * x[1]) + (x[2] * x[2] + x[3] * x[3]); }
                if (type < 2) {
                    ss += __shfl_xor(ss, 16); ss += __shfl_xor(ss, 32);
                    const float rr = fast_rsq(ss * (1.f / 64.f) + NORM_EPS) * qs;
#pragma unroll
                    for (int bj = 0; bj < 2; ++bj)
#pragma unroll
                        for (int n = 0; n < 2; ++n) v[bj][n] = v[bj][n] * gv[bj][n] * rr;
                }
#pragma unroll
                for (int bj = 0; bj < 2; ++bj) *(u32x4*)(O + (size_t)row * 3072 + lc0 + 32 * bj) = pack8(v[bj][0], v[bj][1]);
            }
    }
};

template <bool FINAL> struct EpiMoeDown {
    static constexpr bool PERM = true, AFTER_DRAIN = false, PROF = false; static constexpr int NROWDMA = 2;
    __device__ __forceinline__ const void* row_src(int k, const Unit& u) const { return k == 0 ? (const void*)(s2t + (size_t)u.pm * BM) : (const void*)(sg + (size_t)u.pm * BM); }
    float* out; bf16_t* hb; const int* s2t; const float* sg; int nNloc;
    struct Pre {}; __device__ __forceinline__ void prefetch(Pre&, const Unit&, int, int) const {}
    __device__ __forceinline__ void operator()(const f32x4 (&acc)[2][2][4][2], const Unit& u, int wr, int wc, int fr, int fq, const Pre&, const PG8_LAS unsigned* xrow) const {
        const int row0 = u.pm * BM + wr * 64 + fr, col0 = (u.pn % nNloc) * BM + wc * 32 + 8 * fq;
#pragma unroll
        for (int ai = 0; ai < 2; ++ai) {
            int tk[4]; float gt[4];
#pragma unroll
            for (int m = 0; m < 4; ++m) { const int r = wr * 64 + fr + ai * HALF + m * 16; tk[m] = (int)xrow[r]; gt[m] = __builtin_bit_cast(float, xrow[256 + r]); }
#pragma unroll
            for (int m = 0; m < 4; ++m) {
                const int tok = tk[m];
                if (tok >= 0) {
                    const float g = gt[m] * ACC8; const size_t off = (size_t)tok * 1024 + col0;
#pragma unroll
                    for (int bj = 0; bj < 2; ++bj) {
                        const u32x4 w = *(const u32x4*)(hb + off + bj * HALF);
                        const f32x4 r0 = (f32x4){__builtin_bit_cast(float, w.x << 16), __builtin_bit_cast(float, w.x & 0xffff0000u), __builtin_bit_cast(float, w.y << 16), __builtin_bit_cast(float, w.y & 0xffff0000u)};
                        const f32x4 r1 = (f32x4){__builtin_bit_cast(float, w.z << 16), __builtin_bit_cast(float, w.z & 0xffff0000u), __builtin_bit_cast(float, w.w << 16), __builtin_bit_cast(float, w.w & 0xffff0000u)};
                        const f32x4 v0 = acc[ai][bj][m][0] * g + r0, v1 = acc[ai][bj][m][1] * g + r1;
                        if constexpr (FINAL) { *(f32x4*)(out + off + bj * HALF) = v0; *(f32x4*)(out + off + bj * HALF + 4) = v1; }
                        else *(u32x4*)(hb + off + bj * HALF) = pack8(v0, v1);
                    }
                }
            }
        }
    }
};

struct GroupedOrder {
    StaticOrder so; int r1, r2, r3, r4, r5, r6, r7; int nNloc;
    __device__ __forceinline__ void init(const int* rts_, int nNloc_, int G, int c) { nNloc = nNloc_;
        r1 = __builtin_amdgcn_readfirstlane(rts_[1]); r2 = __builtin_amdgcn_readfirstlane(rts_[2]); r3 = __builtin_amdgcn_readfirstlane(rts_[3]); r4 = __builtin_amdgcn_readfirstlane(rts_[4]);
        r5 = __builtin_amdgcn_readfirstlane(rts_[5]); r6 = __builtin_amdgcn_readfirstlane(rts_[6]); r7 = __builtin_amdgcn_readfirstlane(rts_[7]);
        so.init(__builtin_amdgcn_readfirstlane(rts_[8]) * BM, nNloc_ * BM, G, c); }
    __device__ __forceinline__ void unit_at_v(long L, Unit& u) const { so.unit_at(L, u); const int pm = u.pm;
        const int e = (pm >= r1) + (pm >= r2) + (pm >= r3) + (pm >= r4) + (pm >= r5) + (pm >= r6) + (pm >= r7); u.pn += e * nNloc; }
    __device__ __forceinline__ void unit_at(long L, Unit& u) const { so.unit_at(L, u); const int pm = u.pm;
        const int e = (pm >= r1) + (pm >= r2) + (pm >= r3) + (pm >= r4) + (pm >= r5) + (pm >= r6) + (pm >= r7); u.pn = __builtin_amdgcn_readfirstlane(u.pn + e * nNloc); u.pm = __builtin_amdgcn_readfirstlane(pm); }
    __device__ __forceinline__ bool next(int i, Unit& u) const {
        if (!so.next(i, u)) return false;
        const int pm = u.pm;
        const int e = (pm >= r1) + (pm >= r2) + (pm >= r3) + (pm >= r4) + (pm >= r5) + (pm >= r6) + (pm >= r7);
        u.pn = __builtin_amdgcn_readfirstlane(u.pn + e * nNloc); u.pm = __builtin_amdgcn_readfirstlane(pm); return true;
    }
    __device__ __forceinline__ void a_ready(const Unit&) const {}
    __device__ __forceinline__ void done(const Unit&) const {}
};
struct EpiPartial {
    static constexpr bool PERM = true, AFTER_DRAIN = false, PROF = false; static constexpr int NROWDMA = 0;
    float* P;
    struct Pre {}; __device__ __forceinline__ void prefetch(Pre&, const Unit&, int, int) const {}
    __device__ __forceinline__ void operator()(const f32x4 (&acc)[2][2][4][2], const Unit&, int, int, int, int, const Pre&, const PG8_LAS unsigned*) const {
        int t_ = (int)threadIdx.x; asm volatile("" : "+v"(t_));
        const int wid = t_ >> 6, wr = wid >> 2, wc = wid & 3, fr = t_ & 15, fq = (t_ >> 4) & 3;
#pragma unroll
        for (int ai = 0; ai < 2; ++ai)
#pragma unroll
            for (int m = 0; m < 4; ++m) { float* rp = P + (size_t)(wr * 64 + fr + ai * HALF + m * 16) * BM + wc * 32 + 8 * fq;
#pragma unroll
                for (int bj = 0; bj < 2; ++bj) { *(f32x4*)(rp + bj * HALF) = acc[ai][bj][m][0]; *(f32x4*)(rp + bj * HALF + 4) = acc[ai][bj][m][1]; } }
    }
};
struct PieceOrder {
    Unit u; int has;
    __device__ __forceinline__ bool next(int i, Unit& uu) const { if (i != 0 || !has) return false; uu = u; return true; }
    __device__ __forceinline__ void a_ready(const Unit&) const {}
    __device__ __forceinline__ void done(const Unit&) const {}
};
}
#define GAS __attribute__((address_space(1)))
#define LAS __attribute__((address_space(3)))
typedef unsigned short bf16;
typedef unsigned v4u __attribute__((ext_vector_type(4)));
typedef float f32x4 __attribute__((ext_vector_type(4)));
typedef short bf16x8 __attribute__((ext_vector_type(8)));
typedef GAS unsigned gu32;
typedef GAS unsigned long long gu64;
#define RLX_AGENT __ATOMIC_RELAXED, __HIP_MEMORY_SCOPE_AGENT
#define LDS_WAIT() asm volatile("s_waitcnt lgkmcnt(0)" ::: "memory")
#define VM_WAIT() asm volatile("s_waitcnt vmcnt(0)" ::: "memory")
__device__ __forceinline__ unsigned long long rt() { return __builtin_amdgcn_s_memrealtime(); }
__device__ __forceinline__ unsigned f2bf(float f) { unsigned u = __builtin_bit_cast(unsigned, f); return (u + 0x7fffu + ((u >> 16) & 1u)) >> 16; }
__device__ __forceinline__ unsigned pk2(float lo, float hi) { return f2bf(lo) | (f2bf(hi) << 16); }
#define XB_TMO      128
#define XB_XCNT(j)  (256  + 64 * (j))
#define XB_XSUB(j)  (1280 + 64 * (j))
#define XB_XGEN(j)  (2304 + 64 * (j))
#define XB_TOP      3328
#define XB_TOPGEN   3392
#define XCD_BAR_WORDS 3456
#define XB_SPIN_CAP (1u << 18)

__device__ __forceinline__ unsigned xb_ld(unsigned* p)              { return __hip_atomic_load(p, __ATOMIC_RELAXED, __HIP_MEMORY_SCOPE_AGENT); }
__device__ __forceinline__ unsigned xb_add(unsigned* p, unsigned v) { return __hip_atomic_fetch_add(p, v, __ATOMIC_RELAXED, __HIP_MEMORY_SCOPE_AGENT); }
__device__ __forceinline__ unsigned xb_xcc_id() { return (unsigned)__builtin_amdgcn_s_getreg((3 << 11) | 20) & 0xFu; }
#define XB_SPIN(cond, bar) do { unsigned _sp = 0; while (cond) { __builtin_amdgcn_s_sleep(1); \
    if ((++_sp & 255u) == 0u) { if (xb_ld(&(bar)[XB_TMO])) break; if (_sp > XB_SPIN_CAP) { atomicAdd(&(bar)[XB_TMO], 1u); break; } } } } while (0)

struct XcdBarrier {
    unsigned* bar; unsigned x;
    volatile LAS unsigned* st;
};

__device__ __forceinline__ XcdBarrier xcd_barrier_post(unsigned* bar, volatile LAS unsigned* st) {
    XcdBarrier b; b.bar = bar; b.x = xb_xcc_id(); b.st = st;
    if (threadIdx.x == 0) (void)xb_add(&bar[XB_XCNT(b.x)], 1u);
    return b;
}
__device__ __forceinline__ void xcd_barrier_complete(unsigned* bar, unsigned x, unsigned& nloc, unsigned& nx) {
    const unsigned G = gridDim.x * gridDim.y * gridDim.z;
    unsigned sum, cnt, mine, sp = 0u;
    for (;;) {
        sum = 0u; cnt = 0u; mine = 0u;
#pragma unroll
        for (unsigned j = 0; j < 16; ++j) { const unsigned c = xb_ld(&bar[XB_XCNT(j)]); sum += c; cnt += (c > 0u) ? 1u : 0u; mine = (j == x) ? c : mine; }
        if (sum == G) break;
        __builtin_amdgcn_s_sleep(1);
        if ((++sp & 255u) == 0u) { if (xb_ld(&bar[XB_TMO])) break; if (sp > XB_SPIN_CAP) { atomicAdd(&bar[XB_TMO], 1u); break; } }
    }
    nloc = mine > 0u ? mine : 1u; nx = cnt > 0u ? cnt : 1u;
}

__device__ __forceinline__ void xcd_barrier(const XcdBarrier& b) {
    asm volatile("s_waitcnt vmcnt(0)" ::: "memory");
    __syncthreads();
    if (threadIdx.x == 0) {
        unsigned* bar = b.bar;
        __builtin_amdgcn_s_waitcnt(0);
        unsigned nloc = b.st[0], nx = b.st[1];
        if (nloc == 0u) { xcd_barrier_complete(bar, b.x, nloc, nx); b.st[0] = nloc; b.st[1] = nx; }
        const unsigned old = xb_add(&bar[XB_XSUB(b.x)], 1u);
        const unsigned gen = old / nloc;
        if (old + 1u == (gen + 1u) * nloc) {
            __builtin_amdgcn_fence(__ATOMIC_RELEASE, "agent");
            asm volatile("s_waitcnt vmcnt(0)" ::: "memory");
            const unsigned og = xb_add(&bar[XB_TOP], 1u);
            const unsigned tg = og / nx;
            if (og + 1u == (tg + 1u) * nx) xb_add(&bar[XB_TOPGEN], 1u);
            else XB_SPIN(xb_ld(&bar[XB_TOPGEN]) == tg, bar);
            __builtin_amdgcn_fence(__ATOMIC_ACQUIRE, "agent");
            xb_add(&bar[XB_XGEN(b.x)], 1u);
            asm volatile("s_waitcnt vmcnt(0)" ::: "memory");
        } else {
            XB_SPIN(xb_ld(&bar[XB_XGEN(b.x)]) == gen, bar);
            __builtin_amdgcn_fence(__ATOMIC_ACQUIRE, "agent");
            asm volatile("s_waitcnt vmcnt(0)" ::: "memory");
        }
    }
    __syncthreads();
}
constexpr int NWAVES = 8;
constexpr int BATCH = 8, T = 8192, D = 1024, M = BATCH * T;
constexpr int NH = 8, HDK = 128;
constexpr int FF = 2816, NE = 8, EF = 3584;
constexpr int SLOTS_MAX = M + NE * 256;
constexpr float LAMBDA_INIT = 0.35550906759f;
constexpr float EPS = 1e-6f;
constexpr float LOG2E = 1.4426950408889634f;
#ifndef MK_N_LAUNCHES
#define MK_N_LAUNCHES 1
#endif
constexpr int N_PHASES = 17;
constexpr int N_LAUNCHES = MK_N_LAUNCHES;

constexpr size_t MiB = 1u << 20, KiB = 1u << 10;
constexpr size_t WS_CTL = 0, CTL_ZERO_BYTES = 2 * MiB;
constexpr size_t WS_ST1 = 512 * KiB, WS_ST2 = 1 * MiB, WS_ST3 = 1 * MiB + 512 * KiB;
constexpr size_t WS_ST0 = 2 * MiB;
constexpr size_t WS_WGCNT = 2 * MiB + 256 * KiB;
constexpr size_t WS_RTS = WS_WGCNT + 16 * KiB;
constexpr size_t WS_UORDER = WS_RTS + 1 * KiB;
constexpr size_t WS_LB = WS_UORDER + 2 * KiB;
constexpr size_t WS_ROUTER = 2 * MiB + 512 * KiB;
constexpr size_t WS_TOKE = 3 * MiB, WS_TOKG = 3 * MiB + 512 * KiB;
constexpr size_t WS_TOKS = 4 * MiB;
constexpr size_t WS_S2T = 5 * MiB, WS_SG = 6 * MiB, WS_SR = 7 * MiB;
constexpr size_t WS_W1 = 8 * MiB, WS_W2 = 16 * MiB, WS_W3 = 18 * MiB, WS_W4 = 29 * MiB, WS_W5 = 35 * MiB, WS_W6 = 41 * MiB, WS_W7 = 43 * MiB, WS_W8 = 155 * MiB;
constexpr size_t WS_ACT0 = 212 * MiB, WS_ACT1 = 340 * MiB, WS_BIG = 474 * MiB, WS_DEND = 986 * MiB, WS_END = 1024 * MiB;
static_assert(WS_W4 + (size_t)FF * D * 2 <= WS_W5 && WS_W8 + (size_t)NE * D * EF * 2 <= WS_ACT0 && WS_ACT1 + (size_t)2 * SLOTS_MAX * D <= WS_BIG, "d_ws map");
static_assert(WS_BIG + (size_t)M * 4096 * 2 <= WS_END && WS_BIG + (size_t)SLOTS_MAX * EF * 2 <= WS_END && 2 * SLOTS_MAX * 4 <= (int)MiB, "d_ws map");
constexpr int CW_TMO = 0, CW_CODE = 1, CW_BAR = 4096, CW_ATTQ = 8192;

constexpr int RING_OFF = 0, RING_BYTES = 131072;
constexpr int LDSCTL_OFF = RING_BYTES, MISC_OFF = LDSCTL_OFF + 320;
constexpr int LDS_BYTES = 147456;

struct Frame {
    LAS unsigned char* lds;
    volatile LAS unsigned* MISC;
    gu32* ctl;
    unsigned char* ws;
    int tid, lane, wave, vcu, G;
};

__device__ __forceinline__ float wave_sum(float v) {
#pragma unroll
    for (int o = 1; o < 64; o <<= 1) v += __shfl_xor(v, o);
    return v;
}
typedef float f32x2 __attribute__((ext_vector_type(2)));
typedef unsigned u32x2 __attribute__((ext_vector_type(2)));
__device__ __forceinline__ unsigned lds_add(LAS unsigned* p, unsigned v) { return __hip_atomic_fetch_add(p, v, __ATOMIC_RELAXED, __HIP_MEMORY_SCOPE_WORKGROUP); }
__device__ __forceinline__ void lds_inc(LAS unsigned* p) { (void)lds_add(p, 1u); }
__device__ __forceinline__ float bf2f(unsigned short b) { return __builtin_bit_cast(float, (unsigned)b << 16); }
__device__ __forceinline__ float bflo(unsigned u) { return __builtin_bit_cast(float, u << 16); }
__device__ __forceinline__ float bfhi(unsigned u) { return __builtin_bit_cast(float, u & 0xffff0000u); }
typedef float f32x2_t __attribute__((ext_vector_type(2))); typedef __bf16 bf16x2_t __attribute__((ext_vector_type(2)));
__device__ __forceinline__ unsigned cvtpk(float lo, float hi) { f32x2_t v = {lo, hi}; bf16x2_t b = __builtin_convertvector(v, bf16x2_t); return __builtin_bit_cast(unsigned, b); }

template <int MODE>
__device__ __forceinline__ void tr_item(const float* W, int K, int N, bf16* WT, int FFD, const float* gain, int gmask, float gscale, LAS float* scr, int item, int lane) {
    const int nblk = N / 32, kb = item / nblk, nb = item % nblk, k0 = 64 * kb, n0 = 32 * nb;
    int src = n0;
    if (MODE != 0) { const int pn = n0 >> 8, rem = n0 & 255, bj = rem >> 7, wc = (rem >> 5) & 3; src = (MODE == 1) ? bj * FFD + 128 * pn + 32 * wc : (MODE == 2) ? 256 * pn + 64 * wc + 32 * bj : (pn < 8 ? bj * 1024 + 128 * pn + 32 * wc : n0); }
    { f32x4 v[8];
#pragma unroll
        for (int i = 0; i < 8; ++i) v[i] = *(const GAS f32x4*)(W + (size_t)(k0 + 8 * i + (lane >> 3)) * N + src + 4 * (lane & 7));
#pragma unroll
        for (int i = 0; i < 8; ++i) { LAS float* d = scr + (8 * i + (lane >> 3)) * 33 + 4 * (lane & 7); d[0] = v[i].x; d[1] = v[i].y; d[2] = v[i].z; d[3] = v[i].w; } }
    LDS_WAIT(); asm volatile("" ::: "memory");
    const int c = lane & 7;
    float g[8];
#pragma unroll
    for (int i = 0; i < 8; ++i) g[i] = gain ? gain[(k0 + 8 * c + i) & gmask] * gscale : 1.f;
#pragma unroll
    for (int j = 0; j < 4; ++j) { const int n = (lane >> 3) + 8 * j; const LAS float* s = scr + (8 * c) * 33 + n;
        v4u o; o.x = cvtpk(s[0 * 33] * g[0], s[1 * 33] * g[1]); o.y = cvtpk(s[2 * 33] * g[2], s[3 * 33] * g[3]); o.z = cvtpk(s[4 * 33] * g[4], s[5 * 33] * g[5]); o.w = cvtpk(s[6 * 33] * g[6], s[7 * 33] * g[7]);
        *(GAS v4u*)(WT + (size_t)(n0 + n) * K + k0 + 8 * c) = o; }
    LDS_WAIT(); asm volatile("" ::: "memory");
}

template <int MODE>
__device__ __forceinline__ void tr_item8(const float* W, int K, int N, unsigned char* WT, int FFD, const float* gain, int gmask, LAS float* scr, int item, int lane) {
    const int nblk = N / 32, kb = item / nblk, nb = item % nblk, k0 = 64 * kb, n0 = 32 * nb;
    int src = n0;
    if (MODE != 0) { const int pn = n0 >> 8, rem = n0 & 255, bj = rem >> 7, wc = (rem >> 5) & 3; src = (MODE == 1) ? bj * FFD + 128 * pn + 32 * wc : (MODE == 2) ? 256 * pn + 64 * wc + 32 * bj : (pn < 8 ? bj * 1024 + 128 * pn + 32 * wc : n0); }
    { f32x4 v[8];
#pragma unroll
        for (int i = 0; i < 8; ++i) v[i] = *(const GAS f32x4*)(W + (size_t)(k0 + 8 * i + (lane >> 3)) * N + src + 4 * (lane & 7));
#pragma unroll
        for (int i = 0; i < 8; ++i) { LAS float* d = scr + (8 * i + (lane >> 3)) * 33 + 4 * (lane & 7); d[0] = v[i].x; d[1] = v[i].y; d[2] = v[i].z; d[3] = v[i].w; } }
    LDS_WAIT(); asm volatile("" ::: "memory");
    const int c = lane & 7;
    float g[8];
#pragma unroll
    for (int i = 0; i < 8; ++i) g[i] = (gain ? gain[(k0 + 8 * c + i) & gmask] : 1.f) * pg8::W8S;
#pragma unroll
    for (int j = 0; j < 4; ++j) { const int n = (lane >> 3) + 8 * j; const LAS float* s = scr + (8 * c) * 33 + n;
        u32x2 o; o.x = pg8::pk_fp8x4(s[0 * 33] * g[0], s[1 * 33] * g[1], s[2 * 33] * g[2], s[3 * 33] * g[3]); o.y = pg8::pk_fp8x4(s[4 * 33] * g[4], s[5 * 33] * g[5], s[6 * 33] * g[6], s[7 * 33] * g[7]);
        *(GAS u32x2*)(WT + (size_t)(n0 + n) * K + k0 + 8 * c) = o; }
    LDS_WAIT(); asm volatile("" ::: "memory");
}

__device__ __forceinline__ int attn_jlo(int h, int qt, float XB) {
    const float sl = LOG2E * __builtin_ldexpf(1.f, -(h + 1)); const float XT = XB + 25.1f;
    const int Wk = (int)(XT / sl) + 1; const int d = 128 * qt - Wk; return d > 0 ? (d >> 6) : 0; }
__device__ __forceinline__ float attn_b2(const float* qg, const float* kg, int lane) {
    float gm = fabsf(qg[lane] * kg[lane]);
#pragma unroll
    for (int o = 1; o < 64; o <<= 1) gm = fmaxf(gm, __shfl_xor(gm, o));
    return 8.f * gm * LOG2E * 1.02f + 0.05f;
}

__device__ __forceinline__ void p0_prologue(Frame& F, const float* const* in) {
    LAS float* scr = (LAS float*)(F.lds + RING_OFF + F.wave * 16384);
    const int gw = F.vcu * NWAVES + F.wave, NGW = F.G * NWAVES;
    constexpr int I1 = (D / 64) * (4096 / 32), I2 = (D / 64) * (D / 32), I3 = (D / 64) * (2 * FF / 32), I4 = (FF / 64) * (D / 32), I5 = (D / 64) * (3 * D / 32), I6 = I2;
    constexpr int I7 = (D / 64) * (2 * EF / 32), I8 = (EF / 64) * (D / 32);
    constexpr int NITEMS = I1 + I2 + I3 + I4 + I5 + I6 + NE * I7 + NE * I8;
    unsigned char* ws = F.ws;
    auto do_item = [&](int it) {
        int r = it;
        if (r < I1) { tr_item<3>(in[3], D, 4096, (bf16*)(ws + WS_W1), 0, in[2], 1023, 1.f, scr, r, F.lane); return; } r -= I1;
        if (r < I2) { tr_item<0>(in[5], D, D, (bf16*)(ws + WS_W2), 0, in[4], 1023, 1.f, scr, r, F.lane); return; } r -= I2;
        if (r < I3) { tr_item<1>(in[7], D, 2 * FF, (bf16*)(ws + WS_W3), FF, in[6], 1023, 1.f, scr, r, F.lane); return; } r -= I3;
        if (r < I4) { tr_item8<0>(in[8], FF, D, ws + WS_W4, 0, nullptr, 0, scr, r, F.lane); return; } r -= I4;
        if (r < I5) { tr_item<2>(in[10], D, 3 * D, (bf16*)(ws + WS_W5), 0, in[9], 1023, 1.f, scr, r, F.lane); return; } r -= I5;
        if (r < I6) { tr_item<0>(in[18], D, D, (bf16*)(ws + WS_W6), 0, in[17], 127, 1.f - LAMBDA_INIT, scr, r, F.lane); return; } r -= I6;
        if (r < NE * I7) { const int e = r / I7; tr_item8<1>(in[21] + (size_t)e * D * 2 * EF, D, 2 * EF, ws + WS_W7 + (size_t)e * 2 * EF * D, EF, in[19], 1023, scr, r % I7, F.lane); return; } r -= NE * I7;
        { const int e = r / I8; tr_item8<0>(in[22] + (size_t)e * EF * D, EF, D, ws + WS_W8 + (size_t)e * D * EF, 0, nullptr, 0, scr, r % I8, F.lane); }
    };
    const float* x = in[0]; bf16* xb = (bf16*)(ws + WS_ACT0); float* st0 = (float*)(ws + WS_ST0);
    static_assert((M / (256 * NWAVES)) % 4 == 0, "four rows per trip");
    int it = gw;
    for (int m = gw; m < M; m += 4 * NGW) {
        f32x4 v[4][4];
#pragma unroll
        for (int q = 0; q < 4; ++q) { const GAS f32x4* xr = (const GAS f32x4*)(x + (size_t)(m + q * NGW) * D) + F.lane;
#pragma unroll
            for (int j = 0; j < 4; ++j) v[q][j] = xr[64 * j]; }
        for (int r4 = 0; r4 < 4 && it < NITEMS; ++r4, it += NGW) do_item(it);
#pragma unroll
        for (int q = 0; q < 4; ++q) { GAS unsigned long long* o8 = (GAS unsigned long long*)(xb + (size_t)(m + q * NGW) * D) + F.lane;
            float s = 0.f;
#pragma unroll
            for (int j = 0; j < 4; ++j) { const f32x4 t = v[q][j]; s += (t.x * t.x + t.y * t.y) + (t.z * t.z + t.w * t.w); o8[64 * j] = (unsigned long long)cvtpk(t.x, t.y) | ((unsigned long long)cvtpk(t.z, t.w) << 32); }
            s = wave_sum(s); if (F.lane == 0) st0[m + q * NGW] = s; }
    }
    for (; it < NITEMS; it += NGW) do_item(it);
    if (blockIdx.x == 0) {
        const float* lbp = in[1]; float* LB = (float*)(ws + WS_LB);
        for (int c = F.tid; c < D; c += NWAVES * 64) { const float a0 = lbp[c], a1 = lbp[D + c], a2 = lbp[2 * D + c]; const float mx = fmaxf(a0, fmaxf(a1, a2));
            const float e0 = __expf(a0 - mx), e1 = __expf(a1 - mx), e2 = __expf(a2 - mx); LB[c] = e0 / (e0 + e1 + e2); }
    }
    if (blockIdx.x == 1) {
        const float* rp = in[20]; const float* gp = in[19]; float* R = (float*)(ws + WS_ROUTER);
        for (int i = F.tid; i < D * NE; i += NWAVES * 64) R[i] = rp[i] * gp[i >> 3];
    }
    {
        if (F.wave < 2) {
            const float XT = 2.f * attn_b2(in[11], in[12], F.lane);
            const int i = 2 * (int)blockIdx.x + F.wave; const int c = 2 * (i & 63) + 2 - attn_jlo(i >> 6, i & 63, XT);
            int rank = 0;
#pragma unroll
            for (int k = 0; k < 8; ++k) { const int j = F.lane + 64 * k; const int cj = 2 * (j & 63) + 2 - attn_jlo(j >> 6, j & 63, XT); rank += (cj > c || (cj == c && j < i)) ? 1 : 0; }
#pragma unroll
            for (int o = 1; o < 64; o <<= 1) rank += __shfl_xor(rank, o);
            if (F.lane == 0) ((int*)(ws + WS_UORDER))[rank] = i;
        }
    }
}

namespace scan {
constexpr int QS = 136, SS = 72;
constexpr int SG_Q = 0, SG_K = 16384, SG_V = 32768, SG_DEND = 36864, SG_BYTES = 37888;
constexpr int NSTG = 3, L_ST = NSTG * SG_BYTES, L_END = L_ST + 2 * 32 * QS * 2;
static_assert(L_END <= RING_BYTES, "scan LDS");
typedef float f32x4 __attribute__((ext_vector_type(4)));
}
__device__ __forceinline__ void scan_glds16(const void* gsrc, unsigned lds_dst) { unsigned keep;
    asm volatile("s_mov_b32 %0, m0\n\ts_mov_b32 m0, %2\n\ts_nop 0\n\tglobal_load_lds_dwordx4 %1, off\n\ts_mov_b32 m0, %0" : "=&s"(keep) : "v"(gsrc), "s"(lds_dst) : "memory"); }
typedef short scan_s16x4 __attribute__((ext_vector_type(4)));
__device__ __forceinline__ scan_s16x4 scan_tr8(unsigned addr) { scan_s16x4 r; asm volatile("ds_read_b64_tr_b16 %0, %1" : "=&v"(r) : "v"(addr) : "memory"); return r; }
#define SCAN_CAT(lo, hi) ((bf16x8){lo[0], lo[1], lo[2], lo[3], hi[0], hi[1], hi[2], hi[3]})
__device__ __forceinline__ void scan_phase(Frame& F) {
    using namespace scan;
    if (F.vcu >= BATCH * NH * 4) return;
    const int lane = F.lane, wid = F.wave, fr = lane & 15, fq = lane >> 4;
    const int b = F.vcu >> 5, h = (F.vcu >> 2) & 7, vs = F.vcu & 3;
    LAS unsigned char* L = F.lds + RING_OFF; LAS bf16* ST = (LAS bf16*)(L + L_ST);
    const bf16* qfvg = (const bf16*)(F.ws + WS_BIG); bf16* obuf = (bf16*)(F.ws + WS_ACT1); const float* dendg = (const float*)(F.ws + WS_DEND);
    const unsigned lds0 = (unsigned)(uintptr_t)L;
    const bf16* src[5]; unsigned dst[5];
#pragma unroll
    for (int j = 0; j < 4; ++j) { const int pc = 4 * wid + j, isK = pc >> 4, R = 4 * (pc & 15) + (lane >> 4), pp = lane & 15;
        src[j] = qfvg + (size_t)(b * T + R) * 4096 + isK * 1024 + h * 128 + ((pp ^ (R & 15)) * 8); dst[j] = (unsigned)(pc * 1024); }
    { const int pv = wid & 3, R = 16 * pv + (lane >> 2), pp = lane & 3;
      src[4] = (wid == 4) ? (const bf16*)(dendg + (size_t)(b * (T / 64)) * 1024 + h * 128 + lane * 4) : qfvg + (size_t)(b * T + R) * 4096 + 2048 + h * 128 + vs * 32 + pp * 8;
      dst[4] = (wid == 4) ? (unsigned)SG_DEND : (unsigned)(SG_V + pv * 1024); }
    const size_t adv4 = (wid == 4) ? (size_t)1024 * 2 : (size_t)64 * 4096;
#define SCAN_DMA(cc, stg) do { const int cl_ = (cc) < T / 64 ? (cc) : T / 64 - 1; const unsigned sb_ = lds0 + (unsigned)((stg) * SG_BYTES); \
        _Pragma("unroll") for (int j = 0; j < 4; ++j) scan_glds16(src[j] + (size_t)cl_ * 64 * 4096, (unsigned)__builtin_amdgcn_readfirstlane((int)(sb_ + dst[j]))); \
        scan_glds16(src[4] + (size_t)cl_ * adv4, (unsigned)__builtin_amdgcn_readfirstlane((int)(sb_ + dst[4]))); } while (0)
    for (int i = F.tid; i < 2 * 32 * QS / 2; i += NWAVES * 64) ((LAS unsigned*)ST)[i] = 0u;
    f32x4 sacc[2]; sacc[0] = (f32x4){0.f, 0.f, 0.f, 0.f}; sacc[1] = sacc[0];
    const int ti = wid >> 1, vi = wid & 1, q4 = fr >> 2, p4 = fr & 3;
    SCAN_DMA(0, 0); SCAN_DMA(1, 1);
    int stg = 0, stg2 = 2;
    for (int c = 0; c < T / 64; ++c) {
        const int cur = c & 1, nxt = cur ^ 1;
        if (c == 0) asm volatile("s_waitcnt vmcnt(5)" ::: "memory"); else if (c == 1) asm volatile("s_waitcnt vmcnt(6)" ::: "memory"); else asm volatile("s_waitcnt vmcnt(7)" ::: "memory");
        __syncthreads();
        SCAN_DMA(c + 2, stg2);
        LAS unsigned char* SG = L + stg * SG_BYTES; const unsigned sg0 = lds0 + (unsigned)(stg * SG_BYTES);
        bf16x8 qb[4];
#pragma unroll
        for (int kk = 0; kk < 4; ++kk) qb[kk] = *(const LAS bf16x8*)(SG + SG_Q + (16 * ti + fr) * 256 + (((4 * kk + fq) ^ fr) * 16));
        scan_s16x4 ka[2][2][2], vb[2][2], va[2][2];
#pragma unroll
        for (int ss = 0; ss < 2; ++ss)
#pragma unroll
            for (int hh = 0; hh < 2; ++hh) {
                const int srow = 32 * ss + 8 * fq + 4 * hh + q4;
#pragma unroll
                for (int s2 = 0; s2 < 2; ++s2) { const int ki = (wid >> 1) + 4 * s2; ka[s2][ss][hh] = scan_tr8(sg0 + SG_K + srow * 256 + (((2 * ki + (p4 >> 1)) ^ (srow & 15)) * 16) + (p4 & 1) * 8); }
                vb[ss][hh] = scan_tr8(sg0 + SG_V + srow * 64 + 32 * vi + p4 * 8);
            }
#pragma unroll
        for (int m = 0; m < 2; ++m)
#pragma unroll
            for (int hh = 0; hh < 2; ++hh) va[m][hh] = scan_tr8(sg0 + SG_V + (32 * m + 16 * hh + 4 * fq + q4) * 64 + 32 * vi + p4 * 8);
        asm volatile("s_waitcnt lgkmcnt(0)" ::: "memory"); __builtin_amdgcn_sched_barrier(0);
#pragma unroll
        for (int s2 = 0; s2 < 2; ++s2) {
            const int ki = (wid >> 1) + 4 * s2;
#pragma unroll
            for (int ss = 0; ss < 2; ++ss) sacc[s2] = __builtin_amdgcn_mfma_f32_16x16x32_bf16(SCAN_CAT(ka[s2][ss][0], ka[s2][ss][1]), SCAN_CAT(vb[ss][0], vb[ss][1]), sacc[s2], 0, 0, 0);
            sacc[s2] = sacc[s2] * *(const LAS f32x4*)(SG + SG_DEND + (16 * ki + 4 * fq) * 4);
            *(LAS u32x2*)(ST + nxt * 32 * QS + (16 * vi + fr) * QS + 16 * ki + 4 * fq) = (u32x2){cvtpk(sacc[s2][0], sacc[s2][1]), cvtpk(sacc[s2][2], sacc[s2][3])};
        }
        f32x4 oacc = (f32x4){0.f, 0.f, 0.f, 0.f};
        { bf16x8 sr[4];
#pragma unroll
          for (int kk = 0; kk < 4; ++kk) sr[kk] = *(const LAS bf16x8*)(ST + cur * 32 * QS + (16 * vi + fr) * QS + 32 * kk + 8 * fq);
#pragma unroll
          for (int kk = 0; kk < 4; ++kk) asm volatile("" : "+v"(sr[kk]));
#pragma unroll
          for (int kk = 0; kk < 4; ++kk) oacc = __builtin_amdgcn_mfma_f32_16x16x32_bf16(sr[kk], qb[kk], oacc, 0, 0, 0); }
#define SCAN_KROW(sb, kk) (*(const LAS bf16x8*)(SG + SG_K + (16 * (sb) + fr) * 256 + (((4 * (kk) + fq) ^ fr) * 16)))
#pragma unroll
        for (int m = 0; m < 2; ++m) {
            if (2 * m <= ti) {
                f32x4 pt0 = (f32x4){0.f, 0.f, 0.f, 0.f}, pt1 = pt0;
                if (2 * m + 1 <= ti) {
                    bf16x8 k0[4], k1[4];
#pragma unroll
                    for (int kk = 0; kk < 4; ++kk) { k0[kk] = SCAN_KROW(2 * m, kk); k1[kk] = SCAN_KROW(2 * m + 1, kk); }
#pragma unroll
                    for (int kk = 0; kk < 4; ++kk) { asm volatile("" : "+v"(k0[kk])); asm volatile("" : "+v"(k1[kk])); }
#pragma unroll
                    for (int kk = 0; kk < 4; ++kk) { pt0 = __builtin_amdgcn_mfma_f32_16x16x32_bf16(k0[kk], qb[kk], pt0, 0, 0, 0); pt1 = __builtin_amdgcn_mfma_f32_16x16x32_bf16(k1[kk], qb[kk], pt1, 0, 0, 0); }
                    if (2 * m + 1 == ti) {
#pragma unroll
                        for (int j = 0; j < 4; ++j) if (4 * fq + j > fr) pt1[j] = 0.f;
                    }
                } else {
                    bf16x8 k0[4];
#pragma unroll
                    for (int kk = 0; kk < 4; ++kk) k0[kk] = SCAN_KROW(2 * m, kk);
#pragma unroll
                    for (int kk = 0; kk < 4; ++kk) asm volatile("" : "+v"(k0[kk]));
#pragma unroll
                    for (int kk = 0; kk < 4; ++kk) pt0 = __builtin_amdgcn_mfma_f32_16x16x32_bf16(k0[kk], qb[kk], pt0, 0, 0, 0);
#pragma unroll
                    for (int j = 0; j < 4; ++j) if (4 * fq + j > fr) pt0[j] = 0.f;
                }
                const v4u pw = (v4u){cvtpk(pt0[0], pt0[1]), cvtpk(pt0[2], pt0[3]), cvtpk(pt1[0], pt1[1]), cvtpk(pt1[2], pt1[3])};
                oacc = __builtin_amdgcn_mfma_f32_16x16x32_bf16(SCAN_CAT(va[m][0], va[m][1]), __builtin_bit_cast(bf16x8, pw), oacc, 0, 0, 0);
            }
        }
#undef SCAN_KROW
        *(u32x2*)(obuf + (size_t)(b * T + c * 64 + 16 * ti + fr) * D + h * 128 + vs * 32 + 16 * vi + 4 * fq) = (u32x2){cvtpk(oacc[0], oacc[1]), cvtpk(oacc[2], oacc[3])};
        stg2 = stg; stg = (stg == 2) ? 0 : stg + 1;
    }
    asm volatile("s_waitcnt vmcnt(0)" ::: "memory");
    __syncthreads();
#undef SCAN_DMA
}
#undef SCAN_CAT

__device__ __forceinline__ void hgrn_gate_phase(Frame& F) {
    const int gw = F.vcu * NWAVES + F.wave, NGW = F.G * NWAVES;
    bf16* obuf = (bf16*)(F.ws + WS_ACT1); const bf16* qfvg = (const bf16*)(F.ws + WS_BIG);
    for (int m = gw; m < M; m += NGW) {
        v4u o[2], g[2];
        GAS v4u* op = (GAS v4u*)(obuf + (size_t)m * D + 16 * F.lane); const GAS v4u* gp = (const GAS v4u*)(qfvg + (size_t)m * 4096 + 3072 + 16 * F.lane);
        o[0] = op[0]; o[1] = op[1]; g[0] = gp[0]; g[1] = gp[1];
        float v[16]; float ss = 0.f;
#pragma unroll
        for (int i = 0; i < 8; ++i) { const unsigned w = o[i >> 2][i & 3]; v[2 * i] = bflo(w); v[2 * i + 1] = bfhi(w); ss += v[2 * i] * v[2 * i] + v[2 * i + 1] * v[2 * i + 1]; }
        ss += __shfl_xor(ss, 1); ss += __shfl_xor(ss, 2); ss += __shfl_xor(ss, 4);
        const float r = pg8::fast_rsq(ss * (1.f / 128.f) + EPS);
        v4u w[2];
#pragma unroll
        for (int i = 0; i < 8; ++i) { const unsigned gw2 = g[i >> 2][i & 3]; w[i >> 2][i & 3] = cvtpk(v[2 * i] * r * bflo(gw2), v[2 * i + 1] * r * bfhi(gw2)); }
        op[0] = w[0]; op[1] = w[1];
    }
}

namespace att {
using f32x16 = __attribute__((ext_vector_type(16))) float;
using s16x4 = __attribute__((ext_vector_type(4))) short;
typedef __bf16 bf2_t __attribute__((ext_vector_type(2)));
typedef short v4i16_t __attribute__((ext_vector_type(4)));
typedef __attribute__((address_space(3))) const char* lds_cptr;
constexpr int KSLOT = 16384, NKS = 3, VSLOT = 16384, NVS = 4, L_K0 = 0, L_K1 = 8192, L_V = NKS * KSLOT, L_WS = L_V + NVS * VSLOT, L_XO = 0, XOS = 132, PITCH = 3072;
static_assert(L_WS + NWAVES * 256 <= RING_BYTES && 128 * XOS * 4 <= L_WS, "attention LDS");
__device__ __forceinline__ int crow(int r, int hi) { return (r & 3) + 8 * (r >> 2) + 4 * hi; }
__device__ __forceinline__ void glds16(const void* gsrc, unsigned lds_dst) { unsigned keep;
    asm volatile("s_mov_b32 %0, m0\n\ts_mov_b32 m0, %2\n\ts_nop 0\n\tglobal_load_lds_dwordx4 %1, off\n\ts_mov_b32 m0, %0" : "=&s"(keep) : "v"(gsrc), "s"(lds_dst) : "memory"); }
__device__ __forceinline__ void qkt(f32x16& p0, f32x16& p1, lds_cptr Kslot, const bf16x8* qr, f32x16& cin, bf16x8 ones, bf16x8 b32, bf16x8 b64, int r32, int hi) {
    lds_cptr kb = Kslot + hi * 1024 + r32 * 16;
    bf16x8 kf[8];
#pragma unroll
    for (int d0 = 0; d0 < 4; ++d0) { kf[2 * d0] = *(const LAS bf16x8*)(kb + d0 * 2048); kf[2 * d0 + 1] = *(const LAS bf16x8*)(kb + d0 * 2048 + 512); }
#pragma unroll
    for (int i = 0; i < 8; ++i) asm volatile("" : "+v"(kf[i]));
    p0 = __builtin_amdgcn_mfma_f32_32x32x16_bf16(kf[0], qr[0], cin, 0, 0, 0); p1 = __builtin_amdgcn_mfma_f32_32x32x16_bf16(kf[1], qr[0], cin, 0, 0, 0);
    __builtin_amdgcn_sched_barrier(0);
#pragma unroll
    for (int d0 = 1; d0 < 4; ++d0) {
        p0 = __builtin_amdgcn_mfma_f32_32x32x16_bf16(kf[2 * d0], qr[d0], p0, 0, 0, 0);
        p1 = __builtin_amdgcn_mfma_f32_32x32x16_bf16(kf[2 * d0 + 1], qr[d0], p1, 0, 0, 0);
    }
    cin = __builtin_amdgcn_mfma_f32_32x32x16_bf16(ones, b64, cin, 0, 0, 0);
    p1 = __builtin_amdgcn_mfma_f32_32x32x16_bf16(ones, b32, p1, 0, 0, 0);
    __builtin_amdgcn_sched_barrier(0);
}
__device__ __forceinline__ void pv(f32x16* o, unsigned vb, bf16x8 pa0, bf16x8 pa1, bf16x8 pa2, bf16x8 pa3) {
#pragma unroll
    for (int d0 = 0; d0 < 4; ++d0) { s16x4 lo[4], hi[4];
#pragma unroll
        for (int ks = 0; ks < 4; ++ks) {
            asm volatile("ds_read_b64_tr_b16 %0,%1 offset:%c2" : "=&v"(lo[ks]) : "v"(vb), "i"(d0 * 4096 + ks * 1024) : "memory");
            asm volatile("ds_read_b64_tr_b16 %0,%1 offset:%c2" : "=&v"(hi[ks]) : "v"(vb), "i"(d0 * 4096 + ks * 1024 + 512) : "memory"); }
        asm volatile("s_waitcnt lgkmcnt(0)" ::: "memory"); __builtin_amdgcn_sched_barrier(0);
#define PK(k) (bf16x8){lo[k][0], lo[k][1], lo[k][2], lo[k][3], hi[k][0], hi[k][1], hi[k][2], hi[k][3]}
        o[d0] = __builtin_amdgcn_mfma_f32_32x32x16_bf16(pa0, PK(0), o[d0], 0, 0, 0);
        o[d0] = __builtin_amdgcn_mfma_f32_32x32x16_bf16(pa1, PK(1), o[d0], 0, 0, 0);
        o[d0] = __builtin_amdgcn_mfma_f32_32x32x16_bf16(pa2, PK(2), o[d0], 0, 0, 0);
        o[d0] = __builtin_amdgcn_mfma_f32_32x32x16_bf16(pa3, PK(3), o[d0], 0, 0, 0);
#undef PK
    }
}
struct VFrag { s16x4 lo[4], hi[4]; };
template <int KS> __device__ __forceinline__ void vrd4(VFrag& f, unsigned vb) {
#pragma unroll
    for (int d0 = 0; d0 < 4; ++d0) {
        asm volatile("ds_read_b64_tr_b16 %0,%1 offset:%c2" : "=&v"(f.lo[d0]) : "v"(vb), "i"(d0 * 4096 + KS * 1024) : "memory");
        asm volatile("ds_read_b64_tr_b16 %0,%1 offset:%c2" : "=&v"(f.hi[d0]) : "v"(vb), "i"(d0 * 4096 + KS * 1024 + 512) : "memory"); }
}
__device__ __forceinline__ void pv4(f32x16* o, const VFrag& f, bf16x8 pa) {
#pragma unroll
    for (int d0 = 0; d0 < 4; ++d0) {
        const bf16x8 vf = (bf16x8){f.lo[d0][0], f.lo[d0][1], f.lo[d0][2], f.lo[d0][3], f.hi[d0][0], f.hi[d0][1], f.hi[d0][2], f.hi[d0][3]};
        o[d0] = __builtin_amdgcn_mfma_f32_32x32x16_bf16(pa, vf, o[d0], 0, 0, 0); }
}
#ifdef MK_ATT_PROF
#define APROF(idx) do { const unsigned long long t_ = __builtin_amdgcn_s_memtime(); prof[idx] += t_ - tprev; tprev = t_; } while (0)
#else
#define APROF(idx) do {} while (0)
#endif
__device__ __forceinline__ void attn_unit(int b, int h, int qt, const bf16* QKV, bf16* Out, LAS unsigned char* shm, float lam, float slope2, float B2, unsigned long long* prof) {
#ifdef MK_ATT_PROF
    unsigned long long tprev = __builtin_amdgcn_s_memtime();
#endif
    const int tid = threadIdx.x, lane = tid & 63, r32 = lane & 31, hi = lane >> 5; const int wid = __builtin_amdgcn_readfirstlane(tid >> 6);
    const int comp = wid >> 2, wq = wid & 3;
    const long rowbase = (long)b * T; const int q0 = qt * 128; const int myq = q0 + 32 * wq + r32;
    const bf16* Qw = QKV + (rowbase + q0 + 32 * wq) * PITCH + h * 128 + comp * 64;
    const bf16* Kh = QKV + rowbase * PITCH + 1024 + h * 128; const bf16* Vh = QKV + rowbase * PITCH + 2048 + h * 128;
    const unsigned lds0 = (unsigned)(uintptr_t)shm;
    const int pz0 = 2 * wid;
    const unsigned kvo = (unsigned)((lane * PITCH + wid * 8) * 2);
    const unsigned kvo1 = kvo + 128u;
    const unsigned vvo0 = (unsigned)(((16 * (pz0 & 3) + (lane >> 2)) * PITCH + 32 * (pz0 >> 2) + (lane & 3) * 8) * 2);
    const unsigned vvo1 = (unsigned)(((16 * ((pz0 + 1) & 3) + (lane >> 2)) * PITCH + 32 * ((pz0 + 1) >> 2) + (lane & 3) * 8) * 2);
    const unsigned kls = (unsigned)__builtin_amdgcn_readfirstlane((int)(lds0 + L_K0 + wid * 1024)), vls = (unsigned)__builtin_amdgcn_readfirstlane((int)(lds0 + L_V + pz0 * 1024));
#define ATT_SB64(p_) (((unsigned long long)(unsigned)__builtin_amdgcn_readfirstlane((int)((unsigned long long)(p_) >> 32)) << 32) | (unsigned)__builtin_amdgcn_readfirstlane((int)(unsigned long long)(p_)))
#define ATT_GLDS(voff_, sbase_, mbase_, mimm_, ioff_) asm volatile("s_add_i32 m0, %2, %3\n\ts_nop 0\n\tglobal_load_lds_dwordx4 %0, %1 offset:" #ioff_ : : "v"(voff_), "s"(sbase_), "s"(mbase_), "i"(mimm_) : "memory", "scc")
#define DMA_TILE(t, koff, voff) do { const unsigned long long kb64_ = kb0_ + (unsigned long long)(unsigned)((t) - jlo) * (unsigned long long)(64 * PITCH * 2), vb64_ = vb0_ + (unsigned long long)(unsigned)((t) - jlo) * (unsigned long long)(64 * PITCH * 2); \
        const unsigned km_ = kls + (unsigned)(koff), vm_ = vls + (unsigned)(voff); \
        ATT_GLDS(kvo, kb64_, km_, 0, 0); ATT_GLDS(kvo1, kb64_, km_, L_K1 - L_K0, 0); \
        ATT_GLDS(vvo0, vb64_, vm_, 0, 0); ATT_GLDS(vvo1, vb64_, vm_, 1024, 0); } while (0)
    const int jlo = attn_jlo(h, qt, 2.f * B2), jhi = 2 * qt + 1, nt = jhi - jlo + 1;
    const unsigned long long kb0_ = ATT_SB64((const char*)Kh + (long)jlo * 64 * PITCH * 2), vb0_ = ATT_SB64((const char*)Vh + (long)jlo * 64 * PITCH * 2);
    DMA_TILE(jlo, 0, 0);
    if (nt > 1) DMA_TILE(jlo + 1, KSLOT, VSLOT);
    bf16x8 qr[4];
#pragma unroll
    for (int d0 = 0; d0 < 4; ++d0) qr[d0] = *reinterpret_cast<const bf16x8*>(&Qw[(long)r32 * PITCH + d0 * 16 + hi * 8]);
#pragma unroll
    for (int d0 = 0; d0 < 4; ++d0) asm volatile("" : "+v"(qr[d0]));
    f32x16 cin;
#pragma unroll
    for (int r = 0; r < 16; ++r) cin[r] = slope2 * (float)(64 * jlo + crow(r, hi) - myq) - B2;
    const float d32 = 32.f * slope2, d64 = 64.f * slope2;
    bf16x8 onesf, b32f, b64f;
    { const unsigned one2 = 0x3f803f80u; onesf = __builtin_bit_cast(bf16x8, (v4u){one2, one2, one2, one2});
      auto split = [&](float c) { const unsigned u0 = __builtin_bit_cast(unsigned, c) & 0xffff0000u; const float r1 = c - __builtin_bit_cast(float, u0);
          const unsigned u1 = __builtin_bit_cast(unsigned, r1) & 0xffff0000u; const float r2 = r1 - __builtin_bit_cast(float, u1); const unsigned u2 = __builtin_bit_cast(unsigned, r2) & 0xffff0000u;
          return (v4u){hi ? 0u : ((u0 >> 16) | u1), hi ? 0u : (u2 >> 16), 0u, 0u}; };
      b32f = __builtin_bit_cast(bf16x8, split(d32)); b64f = __builtin_bit_cast(bf16x8, split(d64)); }
    f32x16 o[4]; o[0] = f32x16{}; o[1] = f32x16{}; o[2] = f32x16{}; o[3] = f32x16{};
    float l_reg = 0.f;
    const unsigned vbl = lds0 + L_V + ((lane >> 4) & 1) * 32 + (lane & 3) * 8 + (4 * hi + ((lane & 15) >> 2)) * 64;
#define SB() __builtin_amdgcn_sched_barrier(0)
#define MASK_TILE(j) do { if (64 * (j) + 63 > q0 + 32 * wq) { const int kb_ = 64 * (j) + 4 * hi; \
        _Pragma("unroll") for (int r = 0; r < 16; ++r) { const int kv = kb_ + (r & 3) + 8 * (r >> 2); if (kv > myq) p0[r] = -INFINITY; if (kv + 32 > myq) p1[r] = -INFINITY; } } } while (0)
#define EXP2(e) do { if ((e) < 16) { p0[(e)] = __builtin_amdgcn_exp2f(p0[(e)]); p0[(e) + 1] = __builtin_amdgcn_exp2f(p0[(e) + 1]); } \
        else { p1[(e) - 16] = __builtin_amdgcn_exp2f(p1[(e) - 16]); p1[(e) - 15] = __builtin_amdgcn_exp2f(p1[(e) - 15]); } } while (0)
#define PSUM(w) sacc = __builtin_amdgcn_fdot2_f32_bf16(__builtin_bit_cast(att::bf2_t, (unsigned)(w)), (att::bf2_t){(__bf16)1.0f, (__bf16)1.0f}, sacc, false)
#define PSUM4(W) do { PSUM((W)[0]); PSUM((W)[1]); PSUM((W)[2]); PSUM((W)[3]); } while (0)
#define PACK_P() do { pw0 = (v4u){cvtpk(p0[0], p0[1]), cvtpk(p0[2], p0[3]), cvtpk(p0[4], p0[5]), cvtpk(p0[6], p0[7])}; pw1 = (v4u){cvtpk(p0[8], p0[9]), cvtpk(p0[10], p0[11]), cvtpk(p0[12], p0[13]), cvtpk(p0[14], p0[15])}; \
        pw2 = (v4u){cvtpk(p1[0], p1[1]), cvtpk(p1[2], p1[3]), cvtpk(p1[4], p1[5]), cvtpk(p1[6], p1[7])}; pw3 = (v4u){cvtpk(p1[8], p1[9]), cvtpk(p1[10], p1[11]), cvtpk(p1[12], p1[13]), cvtpk(p1[14], p1[15])}; \
        PSUM4(pw0); PSUM4(pw1); PSUM4(pw2); PSUM4(pw3); } while (0)
#define PV_STEP(VF, W, e0, EXTRA) do { const bf16x8 pa_ = __builtin_bit_cast(bf16x8, W); \
        _Pragma("unroll") for (int d0 = 0; d0 < 4; ++d0) { const bf16x8 vf_ = (bf16x8){VF.lo[d0][0], VF.lo[d0][1], VF.lo[d0][2], VF.lo[d0][3], VF.hi[d0][0], VF.hi[d0][1], VF.hi[d0][2], VF.hi[d0][3]}; \
            o[d0] = __builtin_amdgcn_mfma_f32_32x32x16_bf16(pa_, vf_, o[d0], 0, 0, 0); EXP2((e0) + 2 * d0); EXTRA; SB(); } } while (0)
#define CIN4(d0) do { cin[4 * (d0)] += d64; cin[4 * (d0) + 1] += d64; cin[4 * (d0) + 2] += d64; cin[4 * (d0) + 3] += d64; } while (0)
#define PV_ONLY(VF, W) do { const bf16x8 pa_ = __builtin_bit_cast(bf16x8, W); \
        _Pragma("unroll") for (int d0 = 0; d0 < 4; ++d0) { const bf16x8 vf_ = (bf16x8){VF.lo[d0][0], VF.lo[d0][1], VF.lo[d0][2], VF.lo[d0][3], VF.hi[d0][0], VF.hi[d0][1], VF.hi[d0][2], VF.hi[d0][3]}; \
            o[d0] = __builtin_amdgcn_mfma_f32_32x32x16_bf16(pa_, vf_, o[d0], 0, 0, 0); } SB(); } while (0)
    v4u pw0, pw1, pw2, pw3;
    int kslot = 0, kslot2 = 2 * KSLOT;
    {
        if (nt > 1) asm volatile("s_waitcnt vmcnt(4) lgkmcnt(0)\n\ts_barrier" ::: "memory"); else asm volatile("s_waitcnt vmcnt(0) lgkmcnt(0)\n\ts_barrier" ::: "memory");
        if (nt > 2) DMA_TILE(jlo + 2, kslot2, 2 * VSLOT);
        f32x16 p0, p1;
        qkt(p0, p1, (lds_cptr)(shm + kslot + comp * 8192), qr, cin, onesf, b32f, b64f, r32, hi); SB();
        MASK_TILE(jlo);
        float sacc = 0.f;
#pragma unroll
        for (int e = 0; e < 32; e += 2) EXP2(e);
        PACK_P(); l_reg += sacc;
        kslot2 = kslot; kslot = KSLOT;
    }
    for (int it = 1; it < nt; ++it) {
        const int j = jlo + it;
        if (it + 1 < nt) asm volatile("s_waitcnt vmcnt(4) lgkmcnt(0)\n\ts_barrier" ::: "memory"); else asm volatile("s_waitcnt vmcnt(0) lgkmcnt(0)\n\ts_barrier" ::: "memory");
        APROF(0);
        if (it + 2 < nt) DMA_TILE(j + 2, kslot2, ((it + 2) & 3) * VSLOT);
        f32x16 p0, p1;
        qkt(p0, p1, (lds_cptr)(shm + kslot + comp * 8192), qr, cin, onesf, b32f, b64f, r32, hi); SB();
        APROF(1);
        MASK_TILE(j);
        float sacc = 0.f;
        { VFrag vA, vB; const unsigned vb = vbl + (unsigned)(((it - 1) & 3) * VSLOT); SB();
          vrd4<0>(vA, vb); vrd4<1>(vB, vb); asm volatile("s_waitcnt lgkmcnt(8)" ::: "memory"); SB();
          PV_STEP(vA, pw0, 0, (void)0);
          vrd4<2>(vA, vb); asm volatile("s_waitcnt lgkmcnt(8)" ::: "memory"); SB();
          PV_STEP(vB, pw1, 8, { pw0[d0] = cvtpk(p0[2 * d0], p0[2 * d0 + 1]); PSUM(pw0[d0]); });
          vrd4<3>(vB, vb); asm volatile("s_waitcnt lgkmcnt(8)" ::: "memory"); SB();
          PV_STEP(vA, pw2, 16, { pw1[d0] = cvtpk(p0[8 + 2 * d0], p0[9 + 2 * d0]); PSUM(pw1[d0]); });
          asm volatile("s_waitcnt lgkmcnt(0)" ::: "memory"); SB();
          PV_STEP(vB, pw3, 24, { pw2[d0] = cvtpk(p1[2 * d0], p1[2 * d0 + 1]); PSUM(pw2[d0]); }); }
        pw3 = (v4u){cvtpk(p1[8], p1[9]), cvtpk(p1[10], p1[11]), cvtpk(p1[12], p1[13]), cvtpk(p1[14], p1[15])}; PSUM4(pw3); l_reg += sacc;
        APROF(3);
        kslot2 = kslot; kslot = (kslot == 2 * KSLOT) ? 0 : kslot + KSLOT;
    }
    {
        VFrag vA, vB; const unsigned vb = vbl + (unsigned)(((nt - 1) & 3) * VSLOT); SB();
        vrd4<0>(vA, vb); vrd4<1>(vB, vb); asm volatile("s_waitcnt lgkmcnt(8)" ::: "memory"); SB();
        PV_ONLY(vA, pw0);
        vrd4<2>(vA, vb); asm volatile("s_waitcnt lgkmcnt(8)" ::: "memory"); SB();
        PV_ONLY(vB, pw1);
        vrd4<3>(vB, vb); asm volatile("s_waitcnt lgkmcnt(8)" ::: "memory"); SB();
        PV_ONLY(vA, pw2);
        asm volatile("s_waitcnt lgkmcnt(0)" ::: "memory"); SB();
        PV_ONLY(vB, pw3);
    }
#undef SB
#undef MASK_TILE
#undef EXP2
#undef PACK_P
#undef PSUM
#undef PSUM4
#undef PV_STEP
#undef CIN4
#undef PV_ONLY
#undef DMA_TILE
#undef ATT_GLDS
#undef ATT_SB64
    APROF(4);
    { auto rr = __builtin_amdgcn_permlane32_swap(__float_as_uint(l_reg), __float_as_uint(l_reg), false, false); l_reg = __uint_as_float(rr[0]) + __uint_as_float(rr[1]); }
    LAS float* wsf = (LAS float*)(shm + L_WS) + wid * 64;
    if (hi == 0) wsf[r32] = l_reg;
    asm volatile("s_waitcnt lgkmcnt(0)" ::: "memory");
    float rli[16];
#pragma unroll
    for (int r = 0; r < 16; ++r) rli[r] = __builtin_amdgcn_rcpf(wsf[crow(r, hi)]) * (comp ? lam : 1.f);
    asm volatile("s_waitcnt lgkmcnt(0)\n\ts_barrier" ::: "memory");
    LAS float* XO = (LAS float*)(shm + L_XO) + (32 * wq) * XOS;
    if (comp == 1) {
#pragma unroll
        for (int d0 = 0; d0 < 4; ++d0)
#pragma unroll
            for (int r = 0; r < 16; ++r) XO[crow(r, hi) * XOS + 32 * d0 + r32] = o[d0][r] * rli[r];
    }
    asm volatile("s_waitcnt lgkmcnt(0)\n\ts_barrier" ::: "memory");
    if (comp == 0) {
#pragma unroll
        for (int d0 = 0; d0 < 4; ++d0)
#pragma unroll
            for (int r = 0; r < 16; ++r) { LAS float* p = XO + crow(r, hi) * XOS + 32 * d0 + r32; *p = o[d0][r] * rli[r] - *p; }
        asm volatile("s_waitcnt lgkmcnt(0)" ::: "memory");
        const int row = lane >> 1, half = lane & 1;
        const LAS f32x4* rp = (const LAS f32x4*)(XO + row * XOS + 64 * half);
        f32x4 v[16]; float ss = 0.f;
#pragma unroll
        for (int i = 0; i < 16; ++i) { v[i] = rp[i]; ss += (v[i][0] * v[i][0] + v[i][1] * v[i][1]) + (v[i][2] * v[i][2] + v[i][3] * v[i][3]); }
        ss += __shfl_xor(ss, 1);
        const float rn = pg8::fast_rsq(ss * (1.f / 128.f) + EPS);
        bf16* op = Out + (rowbase + q0 + 32 * wq + row) * D + h * 128 + 64 * half;
#pragma unroll
        for (int i = 0; i < 8; ++i) { const f32x4 a = v[2 * i] * rn, c = v[2 * i + 1] * rn; *(v4u*)(op + 8 * i) = (v4u){cvtpk(a[0], a[1]), cvtpk(a[2], a[3]), cvtpk(c[0], c[1]), cvtpk(c[2], c[3])}; }
    }
    asm volatile("s_waitcnt lgkmcnt(0)\n\ts_barrier" ::: "memory");
    APROF(5);
}
}

__device__ __forceinline__ void attn_phase(Frame& F, const float* const* in) {
    const float a1 = wave_sum(in[13][F.lane] * in[14][F.lane]), a2 = wave_sum(in[15][F.lane] * in[16][F.lane]);
    const float lam = __expf(a1) - __expf(a2) + LAMBDA_INIT;
    const float B2 = attn_b2(in[11], in[12], F.lane);
    const int b = F.vcu >> 5, jj = F.vcu & 31;
    const int* uo = (const int*)(F.ws + WS_UORDER);
    const bf16* QKV = (const bf16*)(F.ws + WS_BIG); bf16* Out = (bf16*)(F.ws + WS_ACT1);
    if (F.vcu >= 256) return;
    if (F.wave >= 4) __builtin_amdgcn_s_setprio(1);
    unsigned long long prof[6] = {0, 0, 0, 0, 0, 0};
    gu32* qh = F.ctl + CW_ATTQ + 64 * b; volatile LAS unsigned* nxw = F.MISC + 16; (void)jj;
    if (F.tid == 0) nxw[0] = __hip_atomic_fetch_add(qh, 1u, RLX_AGENT);
    __syncthreads();
    unsigned rank = nxw[0];
    while (rank < 512u) {
        unsigned nx = 0u;
        if (F.tid == 0) nx = __hip_atomic_fetch_add(qh, 1u, RLX_AGENT);
        const int un = __builtin_amdgcn_readfirstlane(uo[rank]); const int h = un >> 6, qt = un & 63;
        const float slope2 = LOG2E * __builtin_ldexpf(1.f, -(h + 1));
        att::attn_unit(b, h, qt, QKV, Out, F.lds + RING_OFF, lam, slope2, B2, prof);
        __syncthreads();
        if (F.tid == 0) nxw[0] = nx;
        __syncthreads();
        rank = (unsigned)__builtin_amdgcn_readfirstlane((int)nxw[0]);
    }
    __builtin_amdgcn_s_setprio(0);
#ifdef MK_ATT_PROF
    if (F.tid == 0) { unsigned long long* g = (unsigned long long*)(F.ws + 65536);
#pragma unroll
        for (int i = 0; i < 6; ++i) atomicAdd(g + i, prof[i]); }
#endif
}

__device__ __forceinline__ void router_phase(Frame& F, const bf16* hb) {
    LAS unsigned* cnt = (LAS unsigned*)(F.lds + RING_OFF + 36864);
    const float* Rg = (const float*)(F.ws + WS_ROUTER);
    f32x4 rwa[16], rwb[16];
#pragma unroll
    for (int c = 0; c < 16; ++c) { rwa[c] = ((const f32x4*)Rg)[(16 * F.lane + c) * 2]; rwb[c] = ((const f32x4*)Rg)[(16 * F.lane + c) * 2 + 1]; }
    if (F.tid < 16) cnt[F.tid] = 0u;
    __syncthreads();
    const unsigned long long* st3 = (const unsigned long long*)(F.ws + WS_ST3); int* toke = (int*)(F.ws + WS_TOKE); float* tokg = (float*)(F.ws + WS_TOKG);
    const int wg = blockIdx.x;
    for (int i = 0; i < 32; ++i) {
        const int m = wg * 256 + F.wave * 32 + i;
        const GAS v4u* xr = (const GAS v4u*)(hb + (size_t)m * D) + 2 * F.lane;
        const v4u xa = xr[0], xb2 = xr[1];
        float lg[8];
#pragma unroll
        for (int e = 0; e < 8; ++e) lg[e] = 0.f;
#pragma unroll
        for (int c = 0; c < 16; ++c) { const unsigned w = (c < 8) ? xa[c >> 1] : xb2[(c - 8) >> 1]; const float v = (c & 1) ? bfhi(w) : bflo(w);
            const f32x4 ra = rwa[c], rb = rwb[c];
            lg[0] += v * ra[0]; lg[1] += v * ra[1]; lg[2] += v * ra[2]; lg[3] += v * ra[3]; lg[4] += v * rb[0]; lg[5] += v * rb[1]; lg[6] += v * rb[2]; lg[7] += v * rb[3]; }
        const float r = pg8::st_rscale(st3, m);
#pragma unroll
        for (int e = 0; e < 8; ++e) lg[e] = wave_sum(lg[e]) * r;
        int i1 = 0; float v1 = lg[0];
#pragma unroll
        for (int e = 1; e < 8; ++e) if (lg[e] > v1) { v1 = lg[e]; i1 = e; }
        int i2 = -1; float v2 = -INFINITY;
#pragma unroll
        for (int e = 0; e < 8; ++e) if (e != i1 && lg[e] > v2) { v2 = lg[e]; i2 = e; }
        if (i2 < 0) { i2 = (i1 + 1) & 7; v2 = v1; }
        const float g1 = 1.f / (1.f + __expf(v2 - v1)), g2 = 1.f - g1;
        if (F.lane == 0) { toke[2 * m] = i1; toke[2 * m + 1] = i2; tokg[2 * m] = g1; tokg[2 * m + 1] = g2; lds_inc(cnt + i1); lds_inc(cnt + 8 + i2); }
    }
    __syncthreads();
    if (F.tid < 16) ((unsigned*)(F.ws + WS_WGCNT))[wg * 16 + F.tid] = cnt[F.tid];
}

__device__ __forceinline__ void gather_rows(Frame& F) {
    const bf16* hb = (const bf16*)(F.ws + WS_ACT0); unsigned char* Xs = F.ws + WS_ACT1; const int* toks = (const int*)(F.ws + WS_TOKS);
    const int wg = blockIdx.x;
    for (int i = 0; i < 32; ++i) {
        const int m = wg * 256 + F.wave * 32 + i; const int slot0 = toks[2 * m], slot1 = toks[2 * m + 1];
        const GAS v4u* s = (const GAS v4u*)(hb + (size_t)m * D) + 2 * F.lane; const v4u a = s[0], b = s[1];
        v4u o;
        o.x = pg8::pk_fp8x4(bflo(a.x) * pg8::A8S, bfhi(a.x) * pg8::A8S, bflo(a.y) * pg8::A8S, bfhi(a.y) * pg8::A8S); o.y = pg8::pk_fp8x4(bflo(a.z) * pg8::A8S, bfhi(a.z) * pg8::A8S, bflo(a.w) * pg8::A8S, bfhi(a.w) * pg8::A8S);
        o.z = pg8::pk_fp8x4(bflo(b.x) * pg8::A8S, bfhi(b.x) * pg8::A8S, bflo(b.y) * pg8::A8S, bfhi(b.y) * pg8::A8S); o.w = pg8::pk_fp8x4(bflo(b.z) * pg8::A8S, bfhi(b.z) * pg8::A8S, bflo(b.w) * pg8::A8S, bfhi(b.w) * pg8::A8S);
        *((GAS v4u*)(Xs + (size_t)slot0 * D) + F.lane) = o;
        *((GAS v4u*)(Xs + ((size_t)SLOTS_MAX + slot1) * D) + F.lane) = o;
    }
}

__device__ __forceinline__ void assign_phase(Frame& F) {
    LAS unsigned* tot = (LAS unsigned*)(F.lds + RING_OFF);
    LAS unsigned* pre = tot + 16; LAS unsigned* base = tot + 32; LAS unsigned* cur = tot + 48; LAS unsigned* start = tot + 64;
    const int wg = blockIdx.x;
    if (F.tid < 128) tot[F.tid] = 0u;
    __syncthreads();
    const unsigned* wgcnt = (const unsigned*)(F.ws + WS_WGCNT);
    for (int idx = F.tid; idx < 256 * 16; idx += NWAVES * 64) { const unsigned v = wgcnt[idx]; const int w = idx >> 4, i = idx & 15; lds_add(tot + i, v); if (w < wg) lds_add(pre + i, v); }
    __syncthreads();
    if (F.tid < 2) { unsigned s = 0; for (int e = 0; e < 8; ++e) { start[F.tid * 9 + e] = s; s += (tot[F.tid * 8 + e] + 255u) & ~255u; } start[F.tid * 9 + 8] = s; }
    __syncthreads();
    if (F.tid < 16) { base[F.tid] = start[(F.tid >> 3) * 9 + (F.tid & 7)] + pre[F.tid]; }
    if (wg == 0 && F.tid < 18) ((int*)(F.ws + WS_RTS))[(F.tid / 9) * 16 + (F.tid % 9)] = (int)(start[F.tid] >> 8);
    __syncthreads();
    int* s2t = (int*)(F.ws + WS_S2T); float* sg = (float*)(F.ws + WS_SG); float* sr = (float*)(F.ws + WS_SR); int* toks = (int*)(F.ws + WS_TOKS);
    const int* toke = (const int*)(F.ws + WS_TOKE); const float* tokg = (const float*)(F.ws + WS_TOKG); const unsigned long long* st3 = (const unsigned long long*)(F.ws + WS_ST3);
    if (F.tid < 256) {
        const int m = wg * 256 + F.tid; const float r = pg8::st_rscale(st3, m);
#pragma unroll
        for (int rk = 0; rk < 2; ++rk) { const int e = toke[2 * m + rk]; const unsigned pos = lds_add(cur + rk * 8 + e, 1u); const int slot = (int)(base[rk * 8 + e] + pos);
            s2t[rk * SLOTS_MAX + slot] = m; sg[rk * SLOTS_MAX + slot] = tokg[2 * m + rk]; sr[rk * SLOTS_MAX + slot] = r; toks[2 * m + rk] = slot; }
    }
    if (wg < 16) {
        const int rk = wg >> 3, e = wg & 7; const unsigned lo = start[rk * 9 + e] + tot[wg], hi = start[rk * 9 + e + 1];
        for (unsigned s = lo + F.tid; s < hi; s += NWAVES * 64) { s2t[rk * SLOTS_MAX + s] = -1; sg[rk * SLOTS_MAX + s] = 0.f; sr[rk * SLOTS_MAX + s] = 0.f; }
    }
    __syncthreads();
    __threadfence_block();
    gather_rows(F);
}

struct Args { const float* in[23]; float* out; unsigned char* ws; int ph_lo, ph_hi; };
static_assert(sizeof(Args) == 25 * 8 + 8, "no padding in Args");
__global__ void __launch_bounds__(NWAVES * 64, 2) fwd_kernel(Args args) {
    extern __shared__ __attribute__((aligned(16))) unsigned char lds[];
    Frame F;
    F.lds = (LAS unsigned char*)lds;
    F.MISC = (volatile LAS unsigned*)(F.lds + MISC_OFF);
    F.tid = threadIdx.x; F.lane = F.tid & 63; F.wave = __builtin_amdgcn_readfirstlane(F.tid >> 6);
    F.G = gridDim.x; { const int bx = blockIdx.x; F.vcu = (F.G % 8 == 0) ? (bx % 8) * (F.G / 8) + bx / 8 : bx; }
    F.ws = args.ws; F.ctl = (gu32*)(args.ws + WS_CTL);
    unsigned char* ws = args.ws;
    for (int u = F.tid; u < (LDS_BYTES - LDSCTL_OFF) / 4; u += NWAVES * 64) ((LAS unsigned*)(F.lds + LDSCTL_OFF))[u] = 0u;
    __syncthreads();
    XcdBarrier bar; bar.bar = (unsigned*)(F.ctl + CW_BAR); bar.x = 0; bar.st = nullptr;
    if (N_LAUNCHES == 1) bar = xcd_barrier_post((unsigned*)(F.ctl + CW_BAR), F.MISC + 8);
#define GRID_BAR() do { if (N_LAUNCHES == 1) xcd_barrier(bar); } while (0)
    const int lo = args.ph_lo, hi = args.ph_hi;
#define IN(k) (lo <= (k) && (k) < hi)
#define BOTH(k) (IN(k) && IN((k) + 1))
    bf16* ACT0 = (bf16*)(ws + WS_ACT0); bf16* ACT1 = (bf16*)(ws + WS_ACT1); bf16* BIG = (bf16*)(ws + WS_BIG);
    float* ST0 = (float*)(ws + WS_ST0); unsigned long long* ST1 = (unsigned long long*)(ws + WS_ST1); unsigned long long* ST2 = (unsigned long long*)(ws + WS_ST2); unsigned long long* ST3 = (unsigned long long*)(ws + WS_ST3);

#if defined(MK_DUP_SMALL) || defined(MK_DUP_P0)
    if (IN(0)) { p0_prologue(F, args.in); GRID_BAR(); }
#endif
    if (IN(0)) { p0_prologue(F, args.in); if (BOTH(0)) GRID_BAR(); }
#ifdef MK_DUP_G1
    if (IN(1)) { pg8::Gemm g{ACT0, (const bf16*)(ws + WS_W1), M, 4096, D}; pg8::StaticOrder S; S.init(M, 4096, F.G, (int)blockIdx.x);
        pg8::EpiHgrnIn E{BIG, ST0, (const float*)(ws + WS_LB), (float*)(ws + WS_DEND)};
        pg8::gemm_phase<pg8::EpiHgrnIn, pg8::StaticOrder, true, true>(F.lds + RING_OFF, g, S, E); GRID_BAR(); }
#endif
    if (IN(1)) {
        pg8::Gemm g{ACT0, (const bf16*)(ws + WS_W1), M, 4096, D}; pg8::StaticOrder S; S.init(M, 4096, F.G, (int)blockIdx.x);
        pg8::EpiHgrnIn E{BIG, ST0, (const float*)(ws + WS_LB), (float*)(ws + WS_DEND)};
        pg8::gemm_phase<pg8::EpiHgrnIn, pg8::StaticOrder, true, true>(F.lds + RING_OFF, g, S, E);
        if (BOTH(1)) GRID_BAR();
    }
#if defined(MK_DUP_SMALL) || defined(MK_DUP_SCAN)
    if (IN(2)) { scan_phase(F); GRID_BAR(); }
#endif
    if (IN(2)) { scan_phase(F); if (BOTH(2)) GRID_BAR(); }
    if (IN(3)) { hgrn_gate_phase(F); if (BOTH(3)) GRID_BAR(); }
    if (IN(4)) {
        pg8::Gemm g{ACT1, (const bf16*)(ws + WS_W2), M, D, D}; pg8::StaticOrder S; S.init(M, D, F.G, (int)blockIdx.x);
        pg8::EpiRes<false> E{nullptr, ACT0, ST1, 1.f};
        pg8::gemm_phase<pg8::EpiRes<false>, pg8::StaticOrder, true, true>(F.lds + RING_OFF, g, S, E);
        if (BOTH(4)) GRID_BAR();
    }
    if (IN(5)) {
        pg8::Gemm g{ACT0, (const bf16*)(ws + WS_W3), M, 2 * FF, D}; pg8::StaticOrder S; S.init(M, 2 * FF, F.G, (int)blockIdx.x);
        pg8::EpiSwiGLU<true> E{nullptr, BIG, FF, ST1, nullptr, 2 * FF / 256, 1.f};
        pg8::gemm_phase<pg8::EpiSwiGLU<true>, pg8::StaticOrder, true, true>(F.lds + RING_OFF, g, S, E);
        if (BOTH(5)) GRID_BAR();
    }
    if (IN(6)) {
        pg8::Gemm g{BIG, (const bf16*)(ws + WS_W4), M, D, FF}; pg8::StaticOrder S; S.init(M, D, F.G, (int)blockIdx.x);
        pg8::EpiRes<false> E{nullptr, ACT0, ST2, pg8::ACC8};
        pg8::gemm_phase<pg8::EpiRes<false>, pg8::StaticOrder, true, true, true>(F.lds + RING_OFF, g, S, E);
        if (BOTH(6)) GRID_BAR();
    }
    if (IN(7)) {
        pg8::Gemm g{ACT0, (const bf16*)(ws + WS_W5), M, 3 * D, D}; pg8::StaticOrder S; S.init(M, 3 * D, F.G, (int)blockIdx.x);
        pg8::EpiQKV E{BIG, ST2, args.in[11], args.in[12]};
        pg8::gemm_phase<pg8::EpiQKV, pg8::StaticOrder, true, true>(F.lds + RING_OFF, g, S, E);
        if (BOTH(7)) GRID_BAR();
    }
#ifdef MK_DUP_ATT
    if (IN(8)) { attn_phase(F, args.in); GRID_BAR(); }
#endif
    if (IN(8)) { attn_phase(F, args.in); if (BOTH(8)) GRID_BAR(); }
    if (IN(9)) {
        pg8::Gemm g{ACT1, (const bf16*)(ws + WS_W6), M, D, D}; pg8::StaticOrder S; S.init(M, D, F.G, (int)blockIdx.x);
        pg8::EpiRes<false> E{nullptr, ACT0, ST3, 1.f};
        pg8::gemm_phase<pg8::EpiRes<false>, pg8::StaticOrder, true, true>(F.lds + RING_OFF, g, S, E);
        if (BOTH(9)) GRID_BAR();
    }
#ifdef MK_DUP_SMALL
    if (IN(10)) { router_phase(F, ACT0); GRID_BAR(); }
    if (IN(11)) { assign_phase(F); GRID_BAR(); }
#endif
    if (IN(10)) { router_phase(F, ACT0); if (BOTH(10)) GRID_BAR(); }
    if (IN(11)) { assign_phase(F); if (BOTH(11)) GRID_BAR(); }
#define MOE_UP(rk, NX) do { pg8::Gemm g{(const bf16*)(ws + WS_ACT1 + (size_t)(rk) * SLOTS_MAX * D), (const bf16*)(ws + WS_W7), 0, 0, D}; pg8::GroupedOrder S; S.init((const int*)(ws + WS_RTS) + 16 * (rk), 2 * EF / 256, F.G, (int)blockIdx.x); \
        S.so.nx = (NX); S.so.sk = 3; \
        pg8::EpiSwiGLU<true, false> E{(void*)(ws + 65536), (bf16*)((unsigned char*)BIG + (size_t)(rk) * SLOTS_MAX * EF), EF, nullptr, (const float*)(ws + WS_SR) + (rk) * SLOTS_MAX, 2 * EF / 256, pg8::ACC8}; \
        pg8::gemm_phase<pg8::EpiSwiGLU<true, false>, pg8::GroupedOrder, true, true, true>(F.lds + RING_OFF, g, S, E); } while (0)
#define MOE_DOWN(rk, FIN) do { pg8::Gemm g{(const bf16*)((const unsigned char*)BIG + (size_t)(rk) * SLOTS_MAX * EF), (const bf16*)(ws + WS_W8), 0, 0, EF}; pg8::GroupedOrder S; S.init((const int*)(ws + WS_RTS) + 16 * (rk), D / 256, F.G, (int)blockIdx.x); \
        pg8::EpiMoeDown<FIN> E{args.out, ACT0, (const int*)(ws + WS_S2T) + (rk) * SLOTS_MAX, (const float*)(ws + WS_SG) + (rk) * SLOTS_MAX, D / 256}; \
        pg8::gemm_phase<pg8::EpiMoeDown<FIN>, pg8::GroupedOrder, true, true, true>(F.lds + RING_OFF, g, S, E); } while (0)
    if (IN(12)) { MOE_UP(0, 0); if (BOTH(12)) GRID_BAR(); }
    if (IN(13)) { MOE_DOWN(0, false); if (BOTH(13)) __syncthreads(); }
    if (IN(14)) { MOE_UP(1, (N_LAUNCHES == 1) ? (__builtin_amdgcn_readfirstlane(((const int*)(ws + WS_RTS))[8]) * (D / 256)) % F.G : 0); if (BOTH(14)) GRID_BAR(); }
    constexpr int TAIL_KS = 7, TAIL_KB = EF / TAIL_KS;
    const unsigned char* Hm1_ = (const unsigned char*)BIG + (size_t)SLOTS_MAX * EF;
    const int* s2t1_ = (const int*)(ws + WS_S2T) + SLOTS_MAX; const float* sg1_ = (const float*)(ws + WS_SG) + SLOTS_MAX;
    if (IN(15)) {
        pg8::GroupedOrder S; S.init((const int*)(ws + WS_RTS) + 16, D / 256, F.G, (int)blockIdx.x); S.so.lim = 4 * F.G;
        { pg8::Gemm g{(const bf16*)Hm1_, (const bf16*)(ws + WS_W8), 0, 0, EF};
          pg8::EpiMoeDown<true> E{args.out, ACT0, s2t1_, sg1_, D / 256};
          pg8::gemm_phase<pg8::EpiMoeDown<true>, pg8::GroupedOrder, true, true, true>(F.lds + RING_OFF, g, S, E); }
        const int ntail = S.so.nwg > 4 * F.G ? (S.so.nwg - 4 * F.G < 36 ? S.so.nwg - 4 * F.G : 36) : 0;
        __syncthreads();
        if ((int)blockIdx.x < ntail * TAIL_KS) {
            const int tu = (int)blockIdx.x / TAIL_KS, ks = (int)blockIdx.x % TAIL_KS;
            pg8::PieceOrder PS; S.unit_at((long)(4 * F.G + tu), PS.u); PS.has = 1;
            int klen_ = TAIL_KB; asm volatile("" : "+s"(klen_));
            pg8::Gemm gp{(const bf16*)(Hm1_ + ks * TAIL_KB), (const bf16*)(ws + WS_W8 + ks * TAIL_KB), 0, 0, klen_, EF};
            pg8::EpiPartial EP{(float*)(ws + WS_ACT1) + (size_t)blockIdx.x * 65536};
            pg8::gemm_phase<pg8::EpiPartial, pg8::PieceOrder, true, true, true>(F.lds + RING_OFF, gp, PS, EP);
        }
        if (BOTH(15)) GRID_BAR();
    }
    if (IN(16)) {
        pg8::GroupedOrder S; S.init((const int*)(ws + WS_RTS) + 16, D / 256, F.G, (int)blockIdx.x);
        const int ntail = S.so.nwg > 4 * F.G ? (S.so.nwg - 4 * F.G < 36 ? S.so.nwg - 4 * F.G : 36) : 0;
        int tid16_ = (int)threadIdx.x; asm volatile("" : "+v"(tid16_));
        for (int idx = (int)blockIdx.x * (NWAVES * 64) + tid16_; idx < ntail * 16384; idx += 256 * (NWAVES * 64)) {
            const int tu = idx >> 14, row = (idx >> 6) & 255, c4 = (idx & 63) * 4;
            pg8::Unit uu; S.unit_at_v((long)(4 * F.G + tu), uu);
            const int slot = uu.pm * 256 + row; const int tok = s2t1_[slot];
            if (tok < 0) continue;
            const float gsc = sg1_[slot] * pg8::ACC8;
            const float* pp = (const float*)(ws + WS_ACT1) + (size_t)(tu * TAIL_KS) * 65536 + row * 256 + c4;
            pg8::f32x4 sum = *(const pg8::f32x4*)pp;
#pragma unroll
            for (int ks = 1; ks < TAIL_KS; ++ks) sum += *(const pg8::f32x4*)(pp + (size_t)ks * 65536);
            const size_t off = (size_t)tok * 1024 + (size_t)(uu.pn & 3) * 256 + c4;
            const pg8::u32x2e wv = *(const pg8::u32x2e*)(ACT0 + off);
            const pg8::f32x4 r = {__builtin_bit_cast(float, wv.x << 16), __builtin_bit_cast(float, wv.x & 0xffff0000u), __builtin_bit_cast(float, wv.y << 16), __builtin_bit_cast(float, wv.y & 0xffff0000u)};
            *(pg8::f32x4*)(args.out + off) = sum * gsc + r;
        }
    }
#undef IN
#undef BOTH
}

#ifdef MK_DEBUG_NAN
__global__ void chk_kernel(const unsigned* buf, size_t nwords, int is_f32, unsigned* flag, unsigned bit) {
    bool bad = false;
    for (size_t i = blockIdx.x * (size_t)blockDim.x + threadIdx.x; i < nwords; i += (size_t)gridDim.x * blockDim.x) { const unsigned w = buf[i];
        if (is_f32) bad |= (w & 0x7f800000u) == 0x7f800000u; else bad |= ((w & 0x7f80u) == 0x7f80u) || ((w & 0x7f800000u) == 0x7f800000u); }
    if (bad) atomicOr(flag, bit);
}
__global__ void cnt_kernel(const unsigned short* buf, size_t n, unsigned* cnt) {
    unsigned c = 0;
    for (size_t i = blockIdx.x * (size_t)blockDim.x + threadIdx.x; i < n; i += (size_t)gridDim.x * blockDim.x) c += ((buf[i] & 0x7f80u) == 0x7f80u) ? 1u : 0u;
    if (c) atomicAdd(cnt, c);
}
__global__ void minlf_kernel(const unsigned short* qfvg, unsigned* mx) {
    unsigned m = 0;
    for (size_t i = blockIdx.x * (size_t)blockDim.x + threadIdx.x; i < (size_t)M * 1024; i += (size_t)gridDim.x * blockDim.x) {
        const size_t row = i >> 10, c = i & 1023; const float v = __builtin_bit_cast(float, (unsigned)qfvg[row * 4096 + 1024 + c] << 16);
        const float q = fminf(fmaxf(-v * 2.f + 0.5f, 0.f), 15.f); m = max(m, (unsigned)q); }
    atomicMax(mx, m);
}
__global__ void maxabs_kernel(const unsigned short* qfvg, unsigned* mx) {
    unsigned m = 0;
    for (size_t i = blockIdx.x * (size_t)blockDim.x + threadIdx.x; i < (size_t)M * 4096; i += (size_t)gridDim.x * blockDim.x) {
        const size_t c = i & 4095; if (c >= 1024 && c < 2048) continue; m = max(m, ((unsigned)qfvg[i] << 16) & 0x7fffffffu); }
    atomicMax(mx, m);
}
__global__ void firstnan_kernel(const unsigned short* buf, size_t n, unsigned* mn) {
    unsigned m = 0xffffffffu;
    for (size_t i = blockIdx.x * (size_t)blockDim.x + threadIdx.x; i < n; i += (size_t)gridDim.x * blockDim.x) if ((buf[i] & 0x7f80u) == 0x7f80u) m = min(m, (unsigned)i);
    atomicMax(mn, ~m);
}
__global__ void report3_kernel(float* out, size_t n, const unsigned* w) {
    for (size_t i = blockIdx.x * (size_t)blockDim.x + threadIdx.x; i < n; i += (size_t)gridDim.x * blockDim.x) out[i] = 0.f;
    __syncthreads();
    if (blockIdx.x == 0 && threadIdx.x == 0) { const float mxv = __builtin_bit_cast(float, w[0]); int A = 0; while (A < 60 && __builtin_ldexpf(1.f, A) < mxv) ++A;
        const unsigned idx = ~w[1];    const unsigned row = idx >> 10; const unsigned B = (row & 8191u) >> 9;
        out[0] = 8192.f * (1.f + (float)B / 16.f) * __builtin_ldexpf(1.f, A); }
}
__global__ void report2_kernel(float* out, size_t n, const unsigned* w) {
    for (size_t i = blockIdx.x * (size_t)blockDim.x + threadIdx.x; i < n; i += (size_t)gridDim.x * blockDim.x) out[i] = 0.f;
    __syncthreads();
    if (blockIdx.x == 0 && threadIdx.x == 0) { const unsigned cnt = w[0], B = w[1]; int A = 0; while ((1ull << A) < (unsigned long long)cnt + 1ull) ++A; out[0] = 8192.f * (1.f + (float)B / 16.f) * __builtin_ldexpf(1.f, A); }
}
__global__ void report_prof_kernel(float* out, size_t n, const unsigned long long* g, int a, int b) {
    for (size_t i = blockIdx.x * (size_t)blockDim.x + threadIdx.x; i < n; i += (size_t)gridDim.x * blockDim.x) out[i] = 0.f;
    __syncthreads();
    if (blockIdx.x == 0 && threadIdx.x == 0) { double tot = 0; for (int i = 0; i < 6; ++i) tot += (double)g[i]; const double fa = (double)g[a] / tot, fb = (double)g[b < 0 ? 0 : b] / tot;
        if (b < 0) out[0] = (float)(1.0e4 * (double)(int)(fa * (double)(-b)) + 1.0e3); else
        out[0] = (float)(1.0e6 * ((double)(int)(fa * 10.0 + 0.5) * 10.0 + (double)(int)(fb * 10.0 + 0.5)) + 1.0e4); }
}
__global__ void report_kernel(float* out, size_t n, const unsigned* flag) {
    for (size_t i = blockIdx.x * (size_t)blockDim.x + threadIdx.x; i < n; i += (size_t)gridDim.x * blockDim.x) out[i] = 0.f;
    __syncthreads();
    if (blockIdx.x == 0 && threadIdx.x == 0) out[0] = 8192.f * __builtin_ldexpf(1.f, 2 * (int)(*flag & 15u));
}
#endif
extern "C" void kernel_launch(void* const* d_in, const int* in_sizes, int n_in, void* d_out, int out_size, void* d_ws, size_t ws_size, hipStream_t stream) {
    static int grid = 0;
    if (grid == 0) {
        if (n_in != 23 || in_sizes[0] != M * D || out_size != M * D || ws_size < WS_END) { fprintf(stderr, "kernel_launch: unexpected shapes (n_in %d, in0 %d, out %d, ws %zu); nothing launched\n", n_in, n_in > 0 ? in_sizes[0] : -1, out_size, ws_size); grid = -1; return; }
        int dev = 0, cus = 0, per_cu = 0;
        if (hipGetDevice(&dev) != hipSuccess || hipDeviceGetAttribute(&cus, hipDeviceAttributeMultiprocessorCount, dev) != hipSuccess) { grid = -1; return; }
        if (hipFuncSetAttribute((const void*)fwd_kernel, hipFuncAttributeMaxDynamicSharedMemorySize, LDS_BYTES) != hipSuccess) { fprintf(stderr, "kernel_launch: hipFuncSetAttribute failed\n"); grid = -1; return; }
        if (hipOccupancyMaxActiveBlocksPerMultiprocessor(&per_cu, (const void*)fwd_kernel, NWAVES * 64, LDS_BYTES) != hipSuccess || per_cu < 1) fprintf(stderr, "kernel_launch: occupancy query reports %d\n", per_cu);
        (void)hipGetLastError();
        grid = cus;
        if (grid != 256) fprintf(stderr, "kernel_launch: %d CUs; this kernel is built for 256\n", grid);
    }
    if (grid < 0) return;
    if (hipMemsetAsync((char*)d_ws + WS_CTL, 0, CTL_ZERO_BYTES, stream) != hipSuccess) return;
    Args a{};
    for (int i = 0; i < 23; ++i) a.in[i] = (const float*)d_in[i];
    a.out = (float*)d_out; a.ws = (unsigned char*)d_ws;
#ifndef MK_CUT
#define MK_CUT N_PHASES
#endif
    for (int li = 0; li < N_LAUNCHES; ++li) {
        a.ph_lo = (N_LAUNCHES == 1) ? 0 : li; a.ph_hi = (N_LAUNCHES == 1) ? MK_CUT : li + 1;
        if (a.ph_lo >= MK_CUT) break;
        hipLaunchKernelGGL(fwd_kernel, dim3(grid), dim3(NWAVES * 64), LDS_BYTES, stream, a);
        if (hipPeekAtLastError() != hipSuccess) break;
#ifdef MK_DEBUG_NAN
        { unsigned* flag = (unsigned*)d_ws + 2; unsigned char* w = (unsigned char*)d_ws;
          MK_DEBUG_CHECKS }
#endif
    }
#ifdef MK_DEBUG_NAN
    MK_DEBUG_REPORT
#endif
}
```

```cpp
#include <hip/hip_runtime.h>
#include <cstdio>
#include <cstdint>
#include <cmath>
namespace pg8 {
#define PG8_LAS __attribute__((address_space(3)))
typedef unsigned short bf16_t;
typedef short bf16x8 __attribute__((ext_vector_type(8)));
typedef float f32x4 __attribute__((ext_vector_type(4)));
typedef unsigned u32x4 __attribute__((ext_vector_type(4)));
constexpr int PG8_XROW_OFF = 135168;
constexpr int BM = 256, BK = 64, HALF = 128, HTB = HALF * BK * 2  , STAGE_BYTES = 8 * HTB, NXCD = 8, WGM = 8;

__host__ __device__ __forceinline__ int lds_byte(int r, int c) { const int st = (r >> 4) * 2 + (c >> 5), rr = r & 15, cc = c & 31, ob = rr * 64 + cc * 2; return st * 1024 + (ob ^ (((ob >> 9) & 1) << 5)); }
__host__ __device__ __forceinline__ void stage_rc(int b, int& R, int& C) { const int st = b / 1024, sb = b % 1024, swz = sb ^ (((sb >> 9) & 1) << 5); R = (st >> 1) * 16 + swz / 64; C = (st & 1) * 32 + (swz % 64) / 2; }
__host__ __device__ __forceinline__ int perm32(int rho) { const int n = rho >> 4, i = rho & 15; return 8 * (i >> 2) + 4 * n + (i & 3); }

struct Unit { int pm, pn; };
struct Gemm { const bf16_t* A; const bf16_t* Bt; int M, N, K; int ld; };

struct StaticOrder {
    int nM, nN, nwg, G, c, nx, sk, lim;
    __host__ __device__ void init(int M, int N, int G_, int c_) { nM = M / BM; nN = N / BM; nwg = nM * nN; G = G_; c = c_; nx = 0; sk = 0; lim = 0x7fffffff; }
    __host__ __device__ bool next(int i, Unit& u) const {
        const int ii = i + (c < nx ? sk : 0);
        const long L = ii < sk ? (long)ii * (G - nx) + (c - nx) : (long)sk * (G - nx) + (long)(ii - sk) * G + c; if (L >= nwg || L >= lim) return false;
        unit_at(L, u); return true;
    }
    __host__ __device__ void unit_at(long L, Unit& u) const {
        int wgid = (int)L; { const int q = nwg / NXCD, r = nwg % NXCD, xcd = wgid % NXCD, off = wgid / NXCD; wgid = (xcd < r ? xcd * (q + 1) : r * (q + 1) + (xcd - r) * q) + off; }
        const int nig = WGM * nN, gid = wgid / nig, fm = gid * WGM, gsz = (nM - fm) < WGM ? (nM - fm) : WGM;
        const int rem = wgid - gid * nig;
        if (gsz == WGM) { u.pm = fm + (int)((unsigned)rem & (unsigned)(WGM - 1)); u.pn = (int)((unsigned)rem >> 3); static_assert(WGM == 8, "shift"); }
        else { u.pm = fm + (rem % gsz); u.pn = rem / gsz; }
    }
    __device__ __forceinline__ void a_ready(const Unit&) const {}
    __device__ __forceinline__ void done(const Unit&) const {}
};

__device__ __forceinline__ unsigned cvt_pk_bf16(float lo, float hi) { unsigned r; asm volatile("v_cvt_pk_bf16_f32 %0, %1, %2" : "=v"(r) : "v"(lo), "v"(hi)); return r; }
typedef float f32x2 __attribute__((ext_vector_type(2)));

typedef int v8i_t __attribute__((ext_vector_type(8))); typedef int v4i_t __attribute__((ext_vector_type(4)));
template <class Epi, class Sched, bool ALIGN_EPI = false, bool SP2 = false, bool F8 = false>
__device__ __forceinline__ void gemm_phase(PG8_LAS unsigned char* lds, const Gemm g, const Sched& S, const Epi& E) {
    const int tid = threadIdx.x, wid = __builtin_amdgcn_readfirstlane(tid >> 6), lane = tid & 63, wr = wid >> 2, wc = wid & 3, fr = lane & 15, fq = lane >> 4;
    const int Kp_ = g.ld ? g.ld : g.K; const int K = F8 ? Kp_ / 2 : Kp_, nt = (F8 ? g.K / 2 : g.K) / BK;
    constexpr int NVO = F8 ? 1 : 2;
    unsigned voffA[NVO], voffB[NVO];
#pragma unroll
    for (int i = 0; i < NVO; ++i) { int R, C; stage_rc(tid * 16 + i * 8192, R, C); const int Rb = Epi::PERM ? ((R & ~31) + perm32(R & 31)) : R;
        voffA[i] = (unsigned)(R * K + C) * 2u; voffB[i] = (unsigned)(Rb * K + C) * 2u; }
    const size_t pstep = (size_t)64 * K * 2;
    const size_t kstep = (size_t)(BK * 2);
    const size_t hstep = (size_t)HALF * K * 2;
    const size_t tstep = 2 * hstep;
    const unsigned ldsbase = (unsigned)(uintptr_t)lds;
    const unsigned ldsw = (unsigned)wid * 1024u;
    const unsigned ldsw_s = (unsigned)__builtin_amdgcn_readfirstlane((int)(ldsbase + ldsw));
    const int aoff = lds_byte(wr * 64 + fr, fq * 8), boff = lds_byte(wc * 32 + fr, fq * 8);
#define PG8_SA(b, h) (((b) * 2 + (h)) * HTB)
#define PG8_SB(b, h) ((4 + (b) * 2 + (h)) * HTB)
#define PG8_STAGE(bufoff, gbase, voff) do { _Pragma("unroll") for (int _i = 0; _i < 2; ++_i) { \
        const unsigned long long gb_ = (unsigned long long)(gbase) + (unsigned long long)((F8 && _i) ? pstep : (size_t)0); const unsigned long long ub_ = ((unsigned long long)(unsigned)__builtin_amdgcn_readfirstlane((int)(gb_ >> 32)) << 32) | (unsigned)__builtin_amdgcn_readfirstlane((int)gb_); \
        asm volatile("s_add_i32 m0, %2, %3\n\ts_nop 0\n\tglobal_load_lds_dwordx4 %0, %1" : : "v"((voff)[F8 ? 0 : _i]), "s"(ub_), "s"(ldsw_s), "i"((int)(bufoff) + _i * 8192) : "memory", "scc"); } } while (0)
#define PG8_LDA(dst, b, h) do { _Pragma("unroll") for (int m = 0; m < 4; ++m) _Pragma("unroll") for (int k = 0; k < 2; ++k) dst[m][k] = *(const PG8_LAS bf16x8*)(lds + PG8_SA(b, h) + aoff + m * 2048 + k * 1024); } while (0)
#define PG8_LDB(dst, b, h) do { _Pragma("unroll") for (int n = 0; n < 2; ++n) _Pragma("unroll") for (int k = 0; k < 2; ++k) dst[n][k] = *(const PG8_LAS bf16x8*)(lds + PG8_SB(b, h) + boff + n * 2048 + k * 1024); } while (0)
#define PG8_MMA(ai, bj, At, Bt) do { __builtin_amdgcn_s_setprio(1); _Pragma("unroll") for (int m = 0; m < 4; ++m) _Pragma("unroll") for (int n = 0; n < 2; ++n) _Pragma("unroll") for (int k = 0; k < 2; ++k) \
        acc[ai][bj][m][n] = __builtin_amdgcn_mfma_f32_16x16x32_bf16(Bt[n][k], At[m][k], acc[ai][bj][m][n], 0, 0, 0); __builtin_amdgcn_s_setprio(0); } while (0)
#define PG8_MMA8(ai, bj, At, Bt) do { __builtin_amdgcn_s_setprio(1); _Pragma("unroll") for (int m = 0; m < 4; ++m) _Pragma("unroll") for (int n = 0; n < 2; ++n) \
        acc[ai][bj][m][n] = __builtin_amdgcn_mfma_scale_f32_16x16x128_f8f6f4(__builtin_shufflevector(__builtin_bit_cast(v4i_t, Bt[n][0]), __builtin_bit_cast(v4i_t, Bt[n][1]), 0, 1, 2, 3, 4, 5, 6, 7), \
            __builtin_shufflevector(__builtin_bit_cast(v4i_t, At[m][0]), __builtin_bit_cast(v4i_t, At[m][1]), 0, 1, 2, 3, 4, 5, 6, 7), acc[ai][bj][m][n], 0, 0, 0, 0, 0, 0); __builtin_amdgcn_s_setprio(0); } while (0)
#define PG8_MM(ai, bj, At, Bt) do { if constexpr (F8) PG8_MMA8(ai, bj, At, Bt); else PG8_MMA(ai, bj, At, Bt); } while (0)
#define PG8_WAIT_V(n) asm volatile("s_waitcnt vmcnt(" #n ")" ::: "memory")
#define PG8_WAIT_L(n) asm volatile("s_waitcnt lgkmcnt(" #n ")" ::: "memory")
#define PG8_BAR __builtin_amdgcn_s_barrier()
#define PG8_SCHED __builtin_amdgcn_sched_barrier(0)
#ifdef MK_GEMM_PROF
    unsigned long long gprof_[3] = {0, 0, 0}, gprev_ = 0;
#endif
    Unit cur, nxt; int ui = 0;
    if (!S.next(0, cur)) return;
    f32x4 acc[2][2][4][2];
#pragma unroll
    for (int a = 0; a < 2; ++a)
#pragma unroll
        for (int b = 0; b < 2; ++b)
#pragma unroll
            for (int m = 0; m < 4; ++m)
#pragma unroll
                for (int n = 0; n < 2; ++n) { acc[a][b][m][n] = (f32x4){0.f, 0.f, 0.f, 0.f}; if constexpr (F8) asm volatile("" : "+v"(acc[a][b][m][n])); }
    bf16x8 At[4][2], B0[2][2], B1[2][2];
    const char* cA = (const char*)g.A + (size_t)cur.pm * tstep; const char* cB = (const char*)g.Bt + (size_t)cur.pn * tstep;
    S.a_ready(cur);
    if constexpr (SP2) {
        PG8_STAGE(PG8_SB(0, 0), cB, voffB); PG8_STAGE(PG8_SB(0, 1), cB + hstep, voffB); PG8_STAGE(PG8_SA(0, 0), cA, voffA); PG8_STAGE(PG8_SA(0, 1), cA + hstep, voffA);
        if (wr == 1) PG8_BAR;
        PG8_WAIT_V(2); PG8_BAR;
        PG8_STAGE(PG8_SB(1, 0), cB + kstep, voffB); PG8_STAGE(PG8_SA(1, 0), cA + kstep, voffA); PG8_STAGE(PG8_SB(1, 1), cB + hstep + kstep, voffB);
        PG8_WAIT_V(6); PG8_BAR;
    } else {
        PG8_STAGE(PG8_SB(0, 0), cB, voffB); PG8_STAGE(PG8_SA(0, 0), cA, voffA); PG8_STAGE(PG8_SB(0, 1), cB + hstep, voffB); PG8_STAGE(PG8_SA(0, 1), cA + hstep, voffA);
        if (wr == 1) PG8_BAR;
        PG8_WAIT_V(4); PG8_BAR;
        PG8_STAGE(PG8_SB(1, 0), cB + kstep, voffB); PG8_STAGE(PG8_SA(1, 0), cA + kstep, voffA); PG8_STAGE(PG8_SB(1, 1), cB + hstep + kstep, voffB);
        PG8_WAIT_V(6); PG8_BAR;
    }
    for (;;) {
        const bool has_next = S.next(ui + 1, nxt);
#ifdef MK_GEMM_PROF
        unsigned long long gt0_ = 0; if constexpr (Epi::PROF) { gt0_ = __builtin_amdgcn_s_memtime(); if (gprev_) gprof_[2] += gt0_ - gprev_; }
#endif
        typename Epi::Pre pre; E.prefetch(pre, cur, wr, fr);
        if constexpr (Epi::NROWDMA > 0) { if (wid < 4 * Epi::NROWDMA) { unsigned keep_; const unsigned long long gb_ = (unsigned long long)E.row_src(wid >> 2, cur);
            const unsigned long long ub_ = ((unsigned long long)(unsigned)__builtin_amdgcn_readfirstlane((int)(gb_ >> 32)) << 32) | (unsigned)__builtin_amdgcn_readfirstlane((int)gb_);
            asm volatile("s_mov_b32 %0, m0\n\ts_mov_b32 m0, %3\n\ts_nop 0\n\tglobal_load_lds_dword %1, %2\n\ts_mov_b32 m0, %0" : "=&s"(keep_) : "v"((unsigned)((tid & 255) * 4)), "s"(ub_),
                "s"((unsigned)__builtin_amdgcn_readfirstlane((int)(ldsbase + PG8_XROW_OFF + (unsigned)(ui & 1) * 2048u + (unsigned)wid * 256u))) : "memory"); } }
        const char* nA = has_next ? (const char*)g.A + (size_t)nxt.pm * tstep : cA; const char* nB = has_next ? (const char*)g.Bt + (size_t)nxt.pn * tstep : cB;
        for (int t = 0; t < nt; t += 2) {
            const bool last = (t == nt - 2);
            const char* a1 = cA + (size_t)(t + 1) * kstep;
            const char* a2 = last ? nA : cA + (size_t)(t + 2) * kstep; const char* b2 = last ? nB : cB + (size_t)(t + 2) * kstep;
            const char* a3 = a2 + kstep; const char* b3 = b2 + kstep;
            if (last && has_next) S.a_ready(nxt);
            if constexpr (SP2) {
            PG8_LDB(B0, 0, 0); PG8_LDB(B1, 0, 1); PG8_SCHED; PG8_LDA(At, 0, 0); PG8_STAGE(PG8_SA(1, 1), a1 + hstep, voffA);
            PG8_WAIT_V(8); PG8_WAIT_L(0); PG8_BAR; PG8_MM(0, 0, At, B0); PG8_MM(0, 1, At, B1); PG8_BAR; PG8_SCHED;
            PG8_LDA(At, 0, 1); PG8_STAGE(PG8_SB(0, 0), b2, voffB); PG8_STAGE(PG8_SB(0, 1), b2 + hstep, voffB); PG8_STAGE(PG8_SA(0, 0), a2, voffA);
            PG8_WAIT_V(8); PG8_WAIT_L(0); PG8_BAR; PG8_MM(1, 0, At, B0); PG8_MM(1, 1, At, B1); PG8_BAR; PG8_SCHED;
            PG8_LDB(B0, 1, 0); PG8_LDB(B1, 1, 1); PG8_SCHED; PG8_LDA(At, 1, 0); PG8_STAGE(PG8_SA(0, 1), a2 + hstep, voffA);
            PG8_WAIT_V(8); PG8_WAIT_L(0); PG8_BAR; PG8_MM(0, 0, At, B0); PG8_MM(0, 1, At, B1); PG8_BAR; PG8_SCHED;
            PG8_LDA(At, 1, 1); PG8_STAGE(PG8_SB(1, 0), b3, voffB); PG8_STAGE(PG8_SB(1, 1), b3 + hstep, voffB); PG8_STAGE(PG8_SA(1, 0), a3, voffA);
            PG8_WAIT_V(8); PG8_WAIT_L(0); PG8_BAR; PG8_MM(1, 0, At, B0); PG8_MM(1, 1, At, B1); PG8_BAR; PG8_SCHED;
            } else {
            PG8_LDB(B0, 0, 0); PG8_SCHED; PG8_LDA(At, 0, 0); PG8_STAGE(PG8_SA(1, 1), a1 + hstep, voffA);
            PG8_WAIT_L(8); PG8_BAR; PG8_WAIT_L(0); PG8_MM(0, 0, At, B0); PG8_BAR; PG8_SCHED;
            PG8_LDB(B1, 0, 1); PG8_STAGE(PG8_SB(0, 0), b2, voffB);
            PG8_BAR; PG8_WAIT_L(0); PG8_MM(0, 1, At, B1); PG8_BAR;
            PG8_LDA(At, 0, 1); PG8_STAGE(PG8_SA(0, 0), a2, voffA);
            PG8_BAR; PG8_WAIT_L(0); PG8_MM(1, 0, At, B0); PG8_BAR; PG8_SCHED;
            PG8_STAGE(PG8_SB(0, 1), b2 + hstep, voffB);
            PG8_WAIT_V(6); PG8_BAR; PG8_MM(1, 1, At, B1); PG8_BAR;
            PG8_LDB(B0, 1, 0); PG8_SCHED; PG8_LDA(At, 1, 0); PG8_STAGE(PG8_SA(0, 1), a2 + hstep, voffA);
            PG8_WAIT_L(8); PG8_BAR; PG8_WAIT_L(0); PG8_MM(0, 0, At, B0); PG8_BAR; PG8_SCHED;
            PG8_LDB(B1, 1, 1); PG8_STAGE(PG8_SB(1, 0), b3, voffB);
            PG8_BAR; PG8_WAIT_L(0); PG8_MM(0, 1, At, B1); PG8_BAR;
            PG8_LDA(At, 1, 1); PG8_STAGE(PG8_SA(1, 0), a3, voffA);
            PG8_BAR; PG8_WAIT_L(0); PG8_MM(1, 0, At, B0); PG8_BAR; PG8_SCHED;
            PG8_STAGE(PG8_SB(1, 1), b3 + hstep, voffB);
            PG8_WAIT_V(6); PG8_BAR; PG8_MM(1, 1, At, B1); PG8_BAR;
            }
        }
#ifdef MK_GEMM_PROF
        unsigned long long gt1_ = 0; if constexpr (Epi::PROF) { gt1_ = __builtin_amdgcn_s_memtime(); gprof_[0] += gt1_ - gt0_; }
#endif
        if constexpr (ALIGN_EPI) { if (wr == 0) PG8_BAR; }
        if constexpr (!Epi::AFTER_DRAIN) { E(acc, cur, wr, wc, fr, fq, pre, (const PG8_LAS unsigned*)(lds + PG8_XROW_OFF + (ui & 1) * 2048)); S.done(cur); }
#ifdef MK_GEMM_PROF
        if constexpr (Epi::PROF) { gprev_ = __builtin_amdgcn_s_memtime(); gprof_[1] += gprev_ - gt1_; }
#endif
        if (!has_next) break;
#pragma unroll
        for (int a = 0; a < 2; ++a)
#pragma unroll
            for (int b = 0; b < 2; ++b)
#pragma unroll
                for (int m = 0; m < 4; ++m)
#pragma unroll
                    for (int n = 0; n < 2; ++n) { acc[a][b][m][n] = (f32x4){0.f, 0.f, 0.f, 0.f}; if constexpr (F8) asm volatile("" : "+v"(acc[a][b][m][n])); }
        cur = nxt; cA = nA; cB = nB; ++ui;
        if constexpr (ALIGN_EPI) { if (wr == 1) PG8_BAR; }
    }
#ifdef MK_GEMM_PROF
    if constexpr (Epi::PROF) { if (threadIdx.x == 0) { unsigned long long* g_ = (unsigned long long*)E.profbuf(); atomicAdd(g_ + 0, gprof_[0]); atomicAdd(g_ + 1, gprof_[1]); atomicAdd(g_ + 2, gprof_[2]); } }
#endif
    PG8_WAIT_V(0);
    if constexpr (!ALIGN_EPI) { if (wr == 0) PG8_BAR; }
    PG8_BAR;
    if constexpr (Epi::AFTER_DRAIN) { E.fused(acc, cur, wr, wc, fr, fq, lds, wid, lane); S.done(cur); }
#undef PG8_SA
#undef PG8_SB
#undef PG8_STAGE
#undef PG8_LDA
#undef PG8_LDB
#undef PG8_MMA
#undef PG8_MMA8
#undef PG8_MM
#undef PG8_WAIT_V
#undef PG8_WAIT_L
#undef PG8_BAR
#undef PG8_SCHED
}
}
namespace pg8 {
constexpr float LOG2E = 1.4426950408889634f;
constexpr float NORM_EPS = 1e-6f;
__device__ __forceinline__ float fast_exp2(float x) { return __builtin_amdgcn_exp2f(x); }
__device__ __forceinline__ float fast_rcp(float x) { return __builtin_amdgcn_rcpf(x); }
__device__ __forceinline__ float fast_rsq(float x) { return __builtin_amdgcn_rsqf(x); }
__device__ __forceinline__ float silu_f(float v) { return v * fast_rcp(1.f + fast_exp2(-LOG2E * v)); }
__device__ __forceinline__ float sigm_f(float v) { return fast_rcp(1.f + fast_exp2(-LOG2E * v)); }
__device__ __forceinline__ float st_rscale(const unsigned long long* st, int row) { return fast_rsq((float)st[row] * (1.f / (16777216.f * 1024.f)) + NORM_EPS); }
typedef float f32x2e __attribute__((ext_vector_type(2))); typedef __bf16 bf16x2e __attribute__((ext_vector_type(2)));
__device__ __forceinline__ unsigned cvt2(float lo, float hi) { f32x2e v = {lo, hi}; bf16x2e b = __builtin_convertvector(v, bf16x2e); return __builtin_bit_cast(unsigned, b); }
constexpr float A8S = 8.f, W8S = 256.f, ACC8 = 1.f / (A8S * W8S);
__device__ __forceinline__ float clamp8(float v) { return __builtin_amdgcn_fmed3f(v, -448.f, 448.f); }
__device__ __forceinline__ unsigned pk_fp8x4(float a, float b, float c, float d) { int w = __builtin_amdgcn_cvt_pk_fp8_f32(clamp8(a), clamp8(b), 0, false); w = __builtin_amdgcn_cvt_pk_fp8_f32(clamp8(c), clamp8(d), w, true); return (unsigned)w; }
typedef unsigned u32x2e __attribute__((ext_vector_type(2)));
__device__ __forceinline__ u32x2e pack8_fp8(const f32x4& a, const f32x4& b, float s) { u32x2e w; w.x = pk_fp8x4(a[0] * s, a[1] * s, a[2] * s, a[3] * s); w.y = pk_fp8x4(b[0] * s, b[1] * s, b[2] * s, b[3] * s); return w; }
__device__ __forceinline__ u32x4 pack8(const f32x4& a, const f32x4& b) { u32x4 w; w.x = cvt2(a[0], a[1]); w.y = cvt2(a[2], a[3]); w.z = cvt2(b[0], b[1]); w.w = cvt2(b[2], b[3]); return w; }

#define PG8_DPP_SHR1(x, n) __builtin_bit_cast(float, __builtin_amdgcn_update_dpp(0x3f800000, __builtin_bit_cast(int, (x)), 0x110 + (n), 0xf, 0xf, false))
#define PG8_DPP_SHR(x, n) __builtin_bit_cast(float, __builtin_amdgcn_update_dpp(0, __builtin_bit_cast(int, (x)), 0x110 + (n), 0xf, 0xf, true))
struct EpiHgrnIn {
    static constexpr bool PERM = true, AFTER_DRAIN = false, PROF = false; static constexpr int NROWDMA = 0;
    bf16_t* O; const float* st; const float* lb; float* dend;
    struct Pre { float s[2][4]; };
    __device__ __forceinline__ void prefetch(Pre& p, const Unit& u, int wr, int fr) const {
        const int row0 = u.pm * BM + wr * 64 + fr;
#pragma unroll
        for (int ai = 0; ai < 2; ++ai)
#pragma unroll
            for (int m = 0; m < 4; ++m) p.s[ai][m] = st[row0 + ai * HALF + m * 16];
    }
    __device__ __forceinline__ void operator()(const f32x4 (&acc)[2][2][4][2], const Unit& u, int wr, int wc, int fr, int fq, const Pre& pre, const PG8_LAS unsigned* xrow) const {
        const int row0 = u.pm * BM + wr * 64 + fr;
        float rsc[2][4];
#pragma unroll
        for (int ai = 0; ai < 2; ++ai)
#pragma unroll
            for (int m = 0; m < 4; ++m) rsc[ai][m] = fast_rsq(pre.s[ai][m] * (1.f / 1024.f) + NORM_EPS);
        if (u.pn < 8) {
            const int cq = 128 * u.pn + wc * 32 + 8 * fq;
            const int lane15 = ((int)(threadIdx.x & 48u)) | 15;
#pragma unroll
            for (int n = 0; n < 2; ++n) {
                const f32x4 lbv = *(const f32x4*)(lb + cq + 4 * n);
#pragma unroll
                for (int ai = 0; ai < 2; ++ai) {
                    f32x4 qv[4], kv[4]; f32x4 tot4;
#pragma unroll
                    for (int jp = 0; jp < 2; ++jp) {
                        const f32x2e l = {lbv[2 * jp], lbv[2 * jp + 1]}, oml = 1.f - l; f32x2e pf[4], om[4];
#pragma unroll
                        for (int m = 0; m < 4; ++m) {
                            const f32x2e fa = {acc[ai][1][m][n][2 * jp], acc[ai][1][m][n][2 * jp + 1]};
                            const f32x2e t = fa * (rsc[ai][m] * -LOG2E);
                            const f32x2e ex = {fminf(fast_exp2(t.x), 1e30f), fminf(fast_exp2(t.y), 1e30f)};
                            const f32x2e d = ex + 1.f;
                            const f32x2e sg = {fast_rcp(d.x), fast_rcp(d.y)};
                            om[m] = (oml * ex) * sg;
                            pf[m] = l + oml * sg;
                        }
#define PG8_PPSTEP(N) "v_mul_f32_dpp %0, %0, %0 row_shr:" #N " row_mask:0xf bank_mask:0xf\n v_mul_f32_dpp %1, %1, %1 row_shr:" #N " row_mask:0xf bank_mask:0xf\n v_mul_f32_dpp %2, %2, %2 row_shr:" #N " row_mask:0xf bank_mask:0xf\n v_mul_f32_dpp %3, %3, %3 row_shr:" #N " row_mask:0xf bank_mask:0xf\n" \
                      "v_mul_f32_dpp %4, %4, %4 row_shr:" #N " row_mask:0xf bank_mask:0xf\n v_mul_f32_dpp %5, %5, %5 row_shr:" #N " row_mask:0xf bank_mask:0xf\n v_mul_f32_dpp %6, %6, %6 row_shr:" #N " row_mask:0xf bank_mask:0xf\n v_mul_f32_dpp %7, %7, %7 row_shr:" #N " row_mask:0xf bank_mask:0xf\n"
                        { float p0 = pf[0].x, p1 = pf[0].y, p2 = pf[1].x, p3 = pf[1].y, p4 = pf[2].x, p5 = pf[2].y, p6 = pf[3].x, p7 = pf[3].y;
                          asm("s_nop 1\n" PG8_PPSTEP(1) PG8_PPSTEP(2) PG8_PPSTEP(4) PG8_PPSTEP(8) "s_nop 1\n" : "+v"(p0), "+v"(p1), "+v"(p2), "+v"(p3), "+v"(p4), "+v"(p5), "+v"(p6), "+v"(p7));
                          pf[0] = (f32x2e){p0, p1}; pf[1] = (f32x2e){p2, p3}; pf[2] = (f32x2e){p4, p5}; pf[3] = (f32x2e){p6, p7}; }
#undef PG8_PPSTEP
                        f32x2e off = {1.f, 1.f};
#pragma unroll
                        for (int m = 0; m < 4; ++m) {
                            const f32x2e t = {__shfl(pf[m].x, lane15), __shfl(pf[m].y, lane15)};
                            f32x2e F = pf[m] * off; off = off * t; F.x = fmaxf(F.x, 1e-36f); F.y = fmaxf(F.y, 1e-36f);
                            const f32x2e qa = {acc[ai][0][m][n][2 * jp], acc[ai][0][m][n][2 * jp + 1]};
                            const f32x2e tq = qa * (rsc[ai][m] * -LOG2E);
                            const f32x2e dq = (f32x2e){fast_exp2(tq.x), fast_exp2(tq.y)} + 1.f;
                            const f32x2e rq = {fast_rcp(dq.x), fast_rcp(dq.y)}, rF = {fast_rcp(F.x), fast_rcp(F.y)};
                            const f32x2e qo = ((qa * rsc[ai][m]) * F) * rq, ko = om[m] * rF;
                            qv[m][2 * jp] = qo.x; qv[m][2 * jp + 1] = qo.y; kv[m][2 * jp] = ko.x; kv[m][2 * jp + 1] = ko.y;
                        }
                        tot4[2 * jp] = fmaxf(off.x, 1e-36f); tot4[2 * jp + 1] = fmaxf(off.y, 1e-36f);
                    }
#pragma unroll
                    for (int m = 0; m < 4; ++m) {
                        bf16_t* rowp = O + (size_t)(row0 + ai * HALF + m * 16) * 4096 + cq + 4 * n;
                        u32x2e wq, wk; wq.x = cvt2(qv[m][0], qv[m][1]); wq.y = cvt2(qv[m][2], qv[m][3]); wk.x = cvt2(kv[m][0], kv[m][1]); wk.y = cvt2(kv[m][2], kv[m][3]);
                        *(u32x2e*)rowp = wq; *(u32x2e*)(rowp + 1024) = wk;
                    }
                    if (fr == 15) *(f32x4*)(dend + (size_t)(u.pm * 4 + ai * 2 + wr) * 1024 + cq + 4 * n) = tot4;
                }
            }
        } else {
            const int type = u.pn >> 2, col0 = u.pn * BM + wc * 32 + 8 * fq;
#pragma unroll
            for (int ai = 0; ai < 2; ++ai)
#pragma unroll
                for (int m = 0; m < 4; ++m) {
                    const int row = row0 + ai * HALF + m * 16; const float r = rsc[ai][m];
                    bf16_t* rowp = O + (size_t)row * 4096 + col0;
#pragma unroll
                    for (int bj = 0; bj < 2; ++bj) {
                        f32x4 v[2];
#pragma unroll
                        for (int n = 0; n < 2; ++n) {
                            v[n] = acc[ai][bj][m][n] * r;
                            if (type == 3) {
#pragma unroll
                                for (int jp = 0; jp < 2; ++jp) { const f32x2e x = {v[n][2 * jp], v[n][2 * jp + 1]}; const f32x2e t = x * -LOG2E;
                                    const f32x2e d = (f32x2e){fast_exp2(t.x), fast_exp2(t.y)} + 1.f; const f32x2e y = x * (f32x2e){fast_rcp(d.x), fast_rcp(d.y)}; v[n][2 * jp] = y.x; v[n][2 * jp + 1] = y.y; }
                            }
                        }
                        *(u32x4*)(rowp + bj * HALF) = pack8(v[0], v[1]);
                    }
                }
        }
    }
};

template <bool RES32> struct EpiRes {
    static constexpr bool PERM = true, AFTER_DRAIN = false, PROF = false; static constexpr int NROWDMA = 0;
    const float* res; bf16_t* ob; unsigned long long* st; float asc;
    struct Pre {}; __device__ __forceinline__ void prefetch(Pre&, const Unit&, int, int) const {}
    __device__ __forceinline__ void operator()(const f32x4 (&acc)[2][2][4][2], const Unit& u, int wr, int wc, int fr, int fq, const Pre&, const PG8_LAS unsigned* xrow) const {
        const int row0 = u.pm * BM + wr * 64 + fr, col0 = u.pn * BM + wc * 32 + 8 * fq;
#pragma unroll
        for (int ai = 0; ai < 2; ++ai)
#pragma unroll
            for (int m = 0; m < 4; ++m) {
                const int row = row0 + ai * HALF + m * 16; const size_t off = (size_t)row * 1024 + col0;
                float ss = 0.f;
#pragma unroll
                for (int bj = 0; bj < 2; ++bj) {
                    f32x4 r0, r1;
                    if constexpr (RES32) { r0 = *(const f32x4*)(res + off + bj * HALF); r1 = *(const f32x4*)(res + off + bj * HALF + 4); }
                    else { const u32x4 w = *(const u32x4*)(ob + off + bj * HALF);
                        r0 = (f32x4){__builtin_bit_cast(float, w.x << 16), __builtin_bit_cast(float, w.x & 0xffff0000u), __builtin_bit_cast(float, w.y << 16), __builtin_bit_cast(float, w.y & 0xffff0000u)};
                        r1 = (f32x4){__builtin_bit_cast(float, w.z << 16), __builtin_bit_cast(float, w.z & 0xffff0000u), __builtin_bit_cast(float, w.w << 16), __builtin_bit_cast(float, w.w & 0xffff0000u)}; }
                    const f32x4 v0 = acc[ai][bj][m][0] * asc + r0, v1 = acc[ai][bj][m][1] * asc + r1;
                    *(u32x4*)(ob + off + bj * HALF) = pack8(v0, v1);
                    ss += (v0[0] * v0[0] + v0[1] * v0[1]) + (v0[2] * v0[2] + v0[3] * v0[3]) + (v1[0] * v1[0] + v1[1] * v1[1]) + (v1[2] * v1[2] + v1[3] * v1[3]);
                }
                ss += __shfl_xor(ss, 16); ss += __shfl_xor(ss, 32);
                if (fq == 0) __hip_atomic_fetch_add(st + row, (unsigned long long)(ss * 16777216.f + 0.5f), __ATOMIC_RELAXED, __HIP_MEMORY_SCOPE_AGENT);
            }
    }
};

template <bool OUT8, bool PREF = true> struct EpiSwiGLU {
    static constexpr bool PERM = true, AFTER_DRAIN = false, PROF = !PREF; static constexpr int NROWDMA = PREF ? 0 : 1; void* pb; __device__ __forceinline__ void* profbuf() const { return pb; }
    __device__ __forceinline__ const void* row_src(int, const Unit& u) const { return sc + (size_t)u.pm * BM; }
    bf16_t* O; int ldc; const unsigned long long* st; const float* sc; int nNloc; float rs;
    struct Pre { float s[2][4]; };
    __device__ __forceinline__ void prefetch(Pre& p, const Unit& u, int wr, int fr) const {
        const int row0 = u.pm * BM + wr * 64 + fr;
#pragma unroll
        for (int ai = 0; ai < 2; ++ai)
#pragma unroll
            for (int m = 0; m < 4; ++m) { const int row = row0 + ai * HALF + m * 16; p.s[ai][m] = PREF ? (sc ? sc[row] : (float)st[row]) : 0.f; }
    }
    __device__ __forceinline__ void operator()(const f32x4 (&acc)[2][2][4][2], const Unit& u, int wr, int wc, int fr, int fq, const Pre& pre, const PG8_LAS unsigned* xrow) const {
        const int row0 = u.pm * BM + wr * 64 + fr, col0 = (u.pn % nNloc) * HALF + wc * 32 + 8 * fq;
        float rsc[2][4];
#pragma unroll
        for (int ai = 0; ai < 2; ++ai)
#pragma unroll
            for (int m = 0; m < 4; ++m) { const int row = row0 + ai * HALF + m * 16; rsc[ai][m] = PREF ? pre.s[ai][m] : __builtin_bit_cast(float, xrow[row - u.pm * BM]); }
#pragma unroll
        for (int ai = 0; ai < 2; ++ai)
#pragma unroll
            for (int m = 0; m < 4; ++m) {
                const int row = row0 + ai * HALF + m * 16;
                const float r = (sc ? rsc[ai][m] : fast_rsq(rsc[ai][m] * (1.f / (16777216.f * 1024.f)) + NORM_EPS)) * rs;
                const float rn = -LOG2E * r, cinv = fast_rcp(r * r * (OUT8 ? A8S : 1.f));
                f32x4 h[2];
#pragma unroll
                for (int n = 0; n < 2; ++n)
#pragma unroll
                    for (int jp = 0; jp < 2; ++jp) {
                        const f32x2e g = {acc[ai][0][m][n][2 * jp], acc[ai][0][m][n][2 * jp + 1]}, uu = {acc[ai][1][m][n][2 * jp], acc[ai][1][m][n][2 * jp + 1]};
                        const f32x2e t = g * rn;
                        const f32x2e d = (f32x2e){fast_exp2(t.x), fast_exp2(t.y)} * cinv + cinv;
                        const f32x2e q = {fast_rcp(d.x), fast_rcp(d.y)};
                        const f32x2e hv = (g * uu) * q;
                        h[n][2 * jp] = hv.x; h[n][2 * jp + 1] = hv.y; }
                if constexpr (OUT8) { u32x2e w; w.x = pk_fp8x4(h[0][0], h[0][1], h[0][2], h[0][3]); w.y = pk_fp8x4(h[1][0], h[1][1], h[1][2], h[1][3]); *(u32x2e*)((unsigned char*)O + (size_t)row * ldc + col0) = w; }
                else *(u32x4*)(O + (size_t)row * ldc + col0) = pack8(h[0], h[1]);
            }
    }
};

struct EpiQKV {
    static constexpr bool PERM = true, AFTER_DRAIN = false, PROF = false; static constexpr int NROWDMA = 0;
    bf16_t* O; const unsigned long long* st; const float* qg; const float* kg;
    struct Pre { float s[2][4]; };
    __device__ __forceinline__ void prefetch(Pre& p, const Unit& u, int wr, int fr) const {
        const int row0 = u.pm * BM + wr * 64 + fr;
#pragma unroll
        for (int ai = 0; ai < 2; ++ai)
#pragma unroll
            for (int m = 0; m < 4; ++m) p.s[ai][m] = (float)st[row0 + ai * HALF + m * 16];
    }
    __device__ __forceinline__ void operator()(const f32x4 (&acc)[2][2][4][2], const Unit& u, int wr, int wc, int fr, int fq, const Pre& pre, const PG8_LAS unsigned* xrow) const {
        const int row0 = u.pm * BM + wr * 64 + fr, type = u.pn >> 2, lc0 = u.pn * BM + 64 * wc + 8 * fq;
        const float* gp = (type == 0) ? qg : kg;
        f32x4 gv[2][2];
#pragma unroll
        for (int bj = 0; bj < 2; ++bj)
#pragma unroll
            for (int n = 0; n < 2; ++n) gv[bj][n] = (type < 2) ? *(const f32x4*)(gp + 32 * bj + 8 * fq + 4 * n) : (f32x4){1.f, 1.f, 1.f, 1.f};
        const float qs = (type == 0) ? 0.125f * LOG2E : 1.f;
        float rsc[2][4];
#pragma unroll
        for (int ai = 0; ai < 2; ++ai)
#pragma unroll
            for (int m = 0; m < 4; ++m) rsc[ai][m] = pre.s[ai][m];
#pragma unroll
        for (int ai = 0; ai < 2; ++ai)
#pragma unroll
            for (int m = 0; m < 4; ++m) {
                const int row = row0 + ai * HALF + m * 16;
                const float r = fast_rsq(rsc[ai][m] * (1.f / (16777216.f * 1024.f)) + NORM_EPS);
                f32x4 v[2][2]; float ss = 0.f;
#pragma unroll
                for (int bj = 0; bj < 2; ++bj)
#pragma unroll
                    for (int n = 0; n < 2; ++n) { v[bj][n] = acc[ai][bj][m][n] * r; const f32x4 x = v[bj][n]; ss += (x[0] * x[0] + x[1] * x[1]) + (x[2] * x[2] + x[3] * x[3]); }
                if (type < 2) {
                    ss += __shfl_xor(ss, 16); ss += __shfl_xor(ss, 32);
                    const float rr = fast_rsq(ss * (1.f / 64.f) + NORM_EPS) * qs;
#pragma unroll
                    for (int bj = 0; bj < 2; ++bj)
#pragma unroll
                        for (int n = 0; n < 2; ++n) v[bj][n] = v[bj][n] * gv[bj][n] * rr;
                }
#pragma unroll
                for (int bj = 0; bj < 2; ++bj) *(u32x4*)(O + (size_t)row * 3072 + lc0 + 32 * bj) = pack8(v[bj][0], v[bj][1]);
            }
    }
};

template <bool FINAL> struct EpiMoeDown {
    static constexpr bool PERM = true, AFTER_DRAIN = false, PROF = false; static constexpr int NROWDMA = 2;
    __device__ __forceinline__ const void* row_src(int k, const Unit& u) const { return k == 0 ? (const void*)(s2t + (size_t)u.pm * BM) : (const void*)(sg + (size_t)u.pm * BM); }
    float* out; bf16_t* hb; const int* s2t; const float* sg; int nNloc;
    struct Pre {}; __device__ __forceinline__ void prefetch(Pre&, const Unit&, int, int) const {}
    __device__ __forceinline__ void operator()(const f32x4 (&acc)[2][2][4][2], const Unit& u, int wr, int wc, int fr, int fq, const Pre&, const PG8_LAS unsigned* xrow) const {
        const int row0 = u.pm * BM + wr * 64 + fr, col0 = (u.pn % nNloc) * BM + wc * 32 + 8 * fq;
#pragma unroll
        for (int ai = 0; ai < 2; ++ai) {
            int tk[4]; float gt[4];
#pragma unroll
            for (int m = 0; m < 4; ++m) { const int r = wr * 64 + fr + ai * HALF + m * 16; tk[m] = (int)xrow[r]; gt[m] = __builtin_bit_cast(float, xrow[256 + r]); }
#pragma unroll
            for (int m = 0; m < 4; ++m) {
                const int tok = tk[m];
                if (tok >= 0) {
                    const float g = gt[m] * ACC8; const size_t off = (size_t)tok * 1024 + col0;
#pragma unroll
                    for (int bj = 0; bj < 2; ++bj) {
                        const u32x4 w = *(const u32x4*)(hb + off + bj * HALF);
                        const f32x4 r0 = (f32x4){__builtin_bit_cast(float, w.x << 16), __builtin_bit_cast(float, w.x & 0xffff0000u), __builtin_bit_cast(float, w.y << 16), __builtin_bit_cast(float, w.y & 0xffff0000u)};
                        const f32x4 r1 = (f32x4){__builtin_bit_cast(float, w.z << 16), __builtin_bit_cast(float, w.z & 0xffff0000u), __builtin_bit_cast(float, w.w << 16), __builtin_bit_cast(float, w.w & 0xffff0000u)};
                        const f32x4 v0 = acc[ai][bj][m][0] * g + r0, v1 = acc[ai][bj][m][1] * g + r1;
                        if constexpr (FINAL) { *(f32x4*)(out + off + bj * HALF) = v0; *(f32x4*)(out + off + bj * HALF + 4) = v1; }
                        else *(u32x4*)(hb + off + bj * HALF) = pack8(v0, v1);
                    }
                }
            }
        }
    }
};

struct GroupedOrder {
    StaticOrder so; int r1, r2, r3, r4, r5, r6, r7; int nNloc;
    __device__ __forceinline__ void init(const int* rts_, int nNloc_, int G, int c) { nNloc = nNloc_;
        r1 = __builtin_amdgcn_readfirstlane(rts_[1]); r2 = __builtin_amdgcn_readfirstlane(rts_[2]); r3 = __builtin_amdgcn_readfirstlane(rts_[3]); r4 = __builtin_amdgcn_readfirstlane(rts_[4]);
        r5 = __builtin_amdgcn_readfirstlane(rts_[5]); r6 = __builtin_amdgcn_readfirstlane(rts_[6]); r7 = __builtin_amdgcn_readfirstlane(rts_[7]);
        so.init(__builtin_amdgcn_readfirstlane(rts_[8]) * BM, nNloc_ * BM, G, c); }
    __device__ __forceinline__ void unit_at_v(long L, Unit& u) const { so.unit_at(L, u); const int pm = u.pm;
        const int e = (pm >= r1) + (pm >= r2) + (pm >= r3) + (pm >= r4) + (pm >= r5) + (pm >= r6) + (pm >= r7); u.pn += e * nNloc; }
    __device__ __forceinline__ void unit_at(long L, Unit& u) const { so.unit_at(L, u); const int pm = u.pm;
        const int e = (pm >= r1) + (pm >= r2) + (pm >= r3) + (pm >= r4) + (pm >= r5) + (pm >= r6) + (pm >= r7); u.pn = __builtin_amdgcn_readfirstlane(u.pn + e * nNloc); u.pm = __builtin_amdgcn_readfirstlane(pm); }
    __device__ __forceinline__ bool next(int i, Unit& u) const {
        if (!so.next(i, u)) return false;
        const int pm = u.pm;
        const int e = (pm >= r1) + (pm >= r2) + (pm >= r3) + (pm >= r4) + (pm >= r5) + (pm >= r6) + (pm >= r7);
        u.pn = __builtin_amdgcn_readfirstlane(u.pn + e * nNloc); u.pm = __builtin_amdgcn_readfirstlane(pm); return true;
    }
    __device__ __forceinline__ void a_ready(const Unit&) const {}
    __device__ __forceinline__ void done(const Unit&) const {}
};
struct EpiPartial {
    static constexpr bool PERM = true, AFTER_DRAIN = false, PROF = false; static constexpr int NROWDMA = 0;
    float* P;
    struct Pre {}; __device__ __forceinline__ void prefetch(Pre&, const Unit&, int, int) const {}
    __device__ __forceinline__ void operator()(const f32x4 (&acc)[2][2][4][2], const Unit&, int, int, int, int, const Pre&, const PG8_LAS unsigned*) const {
        int t_ = (int)threadIdx.x; asm volatile("" : "+v"(t_));
        const int wid = t_ >> 6, wr = wid >> 2, wc = wid & 3, fr = t_ & 15, fq = (t_ >> 4) & 3;
#pragma unroll
        for (int ai = 0; ai < 2; ++ai)
#pragma unroll
            for (int m = 0; m < 4; ++m) { float* rp = P + (size_t)(wr * 64 + fr + ai * HALF + m * 16) * BM + wc * 32 + 8 * fq;
#pragma unroll
                for (int bj = 0; bj < 2; ++bj) { *(f32x4*)(rp + bj * HALF) = acc[ai][bj][m][0]; *(f32x4*)(rp + bj * HALF + 4) = acc[ai][bj][m][1]; } }
    }
};
struct PieceOrder {
    Unit u; int has;
    __device__ __forceinline__ bool next(int i, Unit& uu) const { if (i != 0 || !has) return false; uu = u; return true; }
    __device__ __forceinline__ void a_ready(const Unit&) const {}
    __device__ __forceinline__ void done(const Unit&) const {}
};
}
#define GAS __attribute__((address_space(1)))
#define LAS __attribute__((address_space(3)))
typedef unsigned short bf16;
typedef unsigned v4u __attribute__((ext_vector_type(4)));
typedef float f32x4 __attribute__((ext_vector_type(4)));
typedef short bf16x8 __attribute__((ext_vector_type(8)));
typedef GAS unsigned gu32;
typedef GAS unsigned long long gu64;
#define RLX_AGENT __ATOMIC_RELAXED, __HIP_MEMORY_SCOPE_AGENT
#define LDS_WAIT() asm volatile("s_waitcnt lgkmcnt(0)" ::: "memory")
#define VM_WAIT() asm volatile("s_waitcnt vmcnt(0)" ::: "memory")
__device__ __forceinline__ unsigned long long rt() { return __builtin_amdgcn_s_memrealtime(); }
__device__ __forceinline__ unsigned f2bf(float f) { unsigned u = __builtin_bit_cast(unsigned, f); return (u + 0x7fffu + ((u >> 16) & 1u)) >> 16; }
__device__ __forceinline__ unsigned pk2(float lo, float hi) { return f2bf(lo) | (f2bf(hi) << 16); }
#define XB_TMO      128
#define XB_XCNT(j)  (256  + 64 * (j))
#define XB_XSUB(j)  (1280 + 64 * (j))
#define XB_XGEN(j)  (2304 + 64 * (j))
#define XB_TOP      3328
#define XB_TOPGEN   3392
#define XCD_BAR_WORDS 3456
#define XB_SPIN_CAP (1u << 18)

__device__ __forceinline__ unsigned xb_ld(unsigned* p)              { return __hip_atomic_load(p, __ATOMIC_RELAXED, __HIP_MEMORY_SCOPE_AGENT); }
__device__ __forceinline__ unsigned xb_add(unsigned* p, unsigned v) { return __hip_atomic_fetch_add(p, v, __ATOMIC_RELAXED, __HIP_MEMORY_SCOPE_AGENT); }
__device__ __forceinline__ unsigned xb_xcc_id() { return (unsigned)__builtin_amdgcn_s_getreg((3 << 11) | 20) & 0xFu; }
#define XB_SPIN(cond, bar) do { unsigned _sp = 0; while (cond) { __builtin_amdgcn_s_sleep(1); \
    if ((++_sp & 255u) == 0u) { if (xb_ld(&(bar)[XB_TMO])) break; if (_sp > XB_SPIN_CAP) { atomicAdd(&(bar)[XB_TMO], 1u); break; } } } } while (0)

struct XcdBarrier {
    unsigned* bar; unsigned x;
    volatile LAS unsigned* st;
};

__device__ __forceinline__ XcdBarrier xcd_barrier_post(unsigned* bar, volatile LAS unsigned* st) {
    XcdBarrier b; b.bar = bar; b.x = xb_xcc_id(); b.st = st;
    if (threadIdx.x == 0) (void)xb_add(&bar[XB_XCNT(b.x)], 1u);
    return b;
}
__device__ __forceinline__ void xcd_barrier_complete(unsigned* bar, unsigned x, unsigned& nloc, unsigned& nx) {
    const unsigned G = gridDim.x * gridDim.y * gridDim.z;
    unsigned sum, cnt, mine, sp = 0u;
    for (;;) {
        sum = 0u; cnt = 0u; mine = 0u;
#pragma unroll
        for (unsigned j = 0; j < 16; ++j) { const unsigned c = xb_ld(&bar[XB_XCNT(j)]); sum += c; cnt += (c > 0u) ? 1u : 0u; mine = (j == x) ? c : mine; }
        if (sum == G) break;
        __builtin_amdgcn_s_sleep(1);
        if ((++sp & 255u) == 0u) { if (xb_ld(&bar[XB_TMO])) break; if (sp > XB_SPIN_CAP) { atomicAdd(&bar[XB_TMO], 1u); break; } }
    }
    nloc = mine > 0u ? mine : 1u; nx = cnt > 0u ? cnt : 1u;
}

__device__ __forceinline__ void xcd_barrier(const XcdBarrier& b) {
    asm volatile("s_waitcnt vmcnt(0)" ::: "memory");
    __syncthreads();
    if (threadIdx.x == 0) {
        unsigned* bar = b.bar;
        __builtin_amdgcn_s_waitcnt(0);
        unsigned nloc = b.st[0], nx = b.st[1];
        if (nloc == 0u) { xcd_barrier_complete(bar, b.x, nloc, nx); b.st[0] = nloc; b.st[1] = nx; }
        const unsigned old = xb_add(&bar[XB_XSUB(b.x)], 1u);
        const unsigned gen = old / nloc;
        if (old + 1u == (gen + 1u) * nloc) {
            __builtin_amdgcn_fence(__ATOMIC_RELEASE, "agent");
            asm volatile("s_waitcnt vmcnt(0)" ::: "memory");
            const unsigned og = xb_add(&bar[XB_TOP], 1u);
            const unsigned tg = og / nx;
            if (og + 1u == (tg + 1u) * nx) xb_add(&bar[XB_TOPGEN], 1u);
            else XB_SPIN(xb_ld(&bar[XB_TOPGEN]) == tg, bar);
            __builtin_amdgcn_fence(__ATOMIC_ACQUIRE, "agent");
            xb_add(&bar[XB_XGEN(b.x)], 1u);
            asm volatile("s_waitcnt vmcnt(0)" ::: "memory");
        } else {
            XB_SPIN(xb_ld(&bar[XB_XGEN(b.x)]) == gen, bar);
            __builtin_amdgcn_fence(__ATOMIC_ACQUIRE, "agent");
            asm volatile("s_waitcnt vmcnt(0)" ::: "memory");
        }
    }
    __syncthreads();
}
constexpr int NWAVES = 8;
constexpr int BATCH = 8, T = 8192, D = 1024, M = BATCH * T;
constexpr int NH = 8, HDK = 128;
constexpr int FF = 2816, NE = 8, EF = 3584;
constexpr int SLOTS_MAX = M + NE * 256;
constexpr float LAMBDA_INIT = 0.35550906759f;
constexpr float EPS = 1e-6f;
constexpr float LOG2E = 1.4426950408889634f;
#ifndef MK_N_LAUNCHES
#define MK_N_LAUNCHES 1
#endif
constexpr int N_PHASES = 17;
constexpr int N_LAUNCHES = MK_N_LAUNCHES;

constexpr size_t MiB = 1u << 20, KiB = 1u << 10;
constexpr size_t WS_CTL = 0, CTL_ZERO_BYTES = 2 * MiB;
constexpr size_t WS_ST1 = 512 * KiB, WS_ST2 = 1 * MiB, WS_ST3 = 1 * MiB + 512 * KiB;
constexpr size_t WS_ST0 = 2 * MiB;
constexpr size_t WS_WGCNT = 2 * MiB + 256 * KiB;
constexpr size_t WS_RTS = WS_WGCNT + 16 * KiB;
constexpr size_t WS_UORDER = WS_RTS + 1 * KiB;
constexpr size_t WS_LB = WS_UORDER + 2 * KiB;
constexpr size_t WS_ROUTER = 2 * MiB + 512 * KiB;
constexpr size_t WS_TOKE = 3 * MiB, WS_TOKG = 3 * MiB + 512 * KiB;
constexpr size_t WS_TOKS = 4 * MiB;
constexpr size_t WS_S2T = 5 * MiB, WS_SG = 6 * MiB, WS_SR = 7 * MiB;
constexpr size_t WS_W1 = 8 * MiB, WS_W2 = 16 * MiB, WS_W3 = 18 * MiB, WS_W4 = 29 * MiB, WS_W5 = 35 * MiB, WS_W6 = 41 * MiB, WS_W7 = 43 * MiB, WS_W8 = 155 * MiB;
constexpr size_t WS_ACT0 = 212 * MiB, WS_ACT1 = 340 * MiB, WS_BIG = 474 * MiB, WS_DEND = 986 * MiB, WS_END = 1024 * MiB;
static_assert(WS_W4 + (size_t)FF * D * 2 <= WS_W5 && WS_W8 + (size_t)NE * D * EF * 2 <= WS_ACT0 && WS_ACT1 + (size_t)2 * SLOTS_MAX * D <= WS_BIG, "d_ws map");
static_assert(WS_BIG + (size_t)M * 4096 * 2 <= WS_END && WS_BIG + (size_t)SLOTS_MAX * EF * 2 <= WS_END && 2 * SLOTS_MAX * 4 <= (int)MiB, "d_ws map");
constexpr int CW_TMO = 0, CW_CODE = 1, CW_BAR = 4096, CW_ATTQ = 8192;

constexpr int RING_OFF = 0, RING_BYTES = 131072;
constexpr int LDSCTL_OFF = RING_BYTES, MISC_OFF = LDSCTL_OFF + 320;
constexpr int LDS_BYTES = 147456;

struct Frame {
    LAS unsigned char* lds;
    volatile LAS unsigned* MISC;
    gu32* ctl;
    unsigned char* ws;
    int tid, lane, wave, vcu, G;
};

__device__ __forceinline__ float wave_sum(float v) {
#pragma unroll
    for (int o = 1; o < 64; o <<= 1) v += __shfl_xor(v, o);
    return v;
}
typedef float f32x2 __attribute__((ext_vector_type(2)));
typedef unsigned u32x2 __attribute__((ext_vector_type(2)));
__device__ __forceinline__ unsigned lds_add(LAS unsigned* p, unsigned v) { return __hip_atomic_fetch_add(p, v, __ATOMIC_RELAXED, __HIP_MEMORY_SCOPE_WORKGROUP); }
__device__ __forceinline__ void lds_inc(LAS unsigned* p) { (void)lds_add(p, 1u); }
__device__ __forceinline__ float bf2f(unsigned short b) { return __builtin_bit_cast(float, (unsigned)b << 16); }
__device__ __forceinline__ float bflo(unsigned u) { return __builtin_bit_cast(float, u << 16); }
__device__ __forceinline__ float bfhi(unsigned u) { return __builtin_bit_cast(float, u & 0xffff0000u); }
typedef float f32x2_t __attribute__((ext_vector_type(2))); typedef __bf16 bf16x2_t __attribute__((ext_vector_type(2)));
__device__ __forceinline__ unsigned cvtpk(float lo, float hi) { f32x2_t v = {lo, hi}; bf16x2_t b = __builtin_convertvector(v, bf16x2_t); return __builtin_bit_cast(unsigned, b); }

template <int MODE>
__device__ __forceinline__ void tr_item(const float* W, int K, int N, bf16* WT, int FFD, const float* gain, int gmask, float gscale, LAS float* scr, int item, int lane) {
    const int nblk = N / 32, kb = item / nblk, nb = item % nblk, k0 = 64 * kb, n0 = 32 * nb;
    int src = n0;
    if (MODE != 0) { const int pn = n0 >> 8, rem = n0 & 255, bj = rem >> 7, wc = (rem >> 5) & 3; src = (MODE == 1) ? bj * FFD + 128 * pn + 32 * wc : (MODE == 2) ? 256 * pn + 64 * wc + 32 * bj : (pn < 8 ? bj * 1024 + 128 * pn + 32 * wc : n0); }
    { f32x4 v[8];
#pragma unroll
        for (int i = 0; i < 8; ++i) v[i] = *(const GAS f32x4*)(W + (size_t)(k0 + 8 * i + (lane >> 3)) * N + src + 4 * (lane & 7));
#pragma unroll
        for (int i = 0; i < 8; ++i) { LAS float* d = scr + (8 * i + (lane >> 3)) * 33 + 4 * (lane & 7); d[0] = v[i].x; d[1] = v[i].y; d[2] = v[i].z; d[3] = v[i].w; } }
    LDS_WAIT(); asm volatile("" ::: "memory");
    const int c = lane & 7;
    float g[8];
#pragma unroll
    for (int i = 0; i < 8; ++i) g[i] = gain ? gain[(k0 + 8 * c + i) & gmask] * gscale : 1.f;
#pragma unroll
    for (int j = 0; j < 4; ++j) { const int n = (lane >> 3) + 8 * j; const LAS float* s = scr + (8 * c) * 33 + n;
        v4u o; o.x = cvtpk(s[0 * 33] * g[0], s[1 * 33] * g[1]); o.y = cvtpk(s[2 * 33] * g[2], s[3 * 33] * g[3]); o.z = cvtpk(s[4 * 33] * g[4], s[5 * 33] * g[5]); o.w = cvtpk(s[6 * 33] * g[6], s[7 * 33] * g[7]);
        *(GAS v4u*)(WT + (size_t)(n0 + n) * K + k0 + 8 * c) = o; }
    LDS_WAIT(); asm volatile("" ::: "memory");
}

template <int MODE>
__device__ __forceinline__ void tr_item8(const float* W, int K, int N, unsigned char* WT, int FFD, const float* gain, int gmask, LAS float* scr, int item, int lane) {
    const int nblk = N / 32, kb = item / nblk, nb = item % nblk, k0 = 64 * kb, n0 = 32 * nb;
    int src = n0;
    if (MODE != 0) { const int pn = n0 >> 8, rem = n0 & 255, bj = rem >> 7, wc = (rem >> 5) & 3; src = (MODE == 1) ? bj * FFD + 128 * pn + 32 * wc : (MODE == 2) ? 256 * pn + 64 * wc + 32 * bj : (pn < 8 ? bj * 1024 + 128 * pn + 32 * wc : n0); }
    { f32x4 v[8];
#pragma unroll
        for (int i = 0; i < 8; ++i) v[i] = *(const GAS f32x4*)(W + (size_t)(k0 + 8 * i + (lane >> 3)) * N + src + 4 * (lane & 7));
#pragma unroll
        for (int i = 0; i < 8; ++i) { LAS float* d = scr + (8 * i + (lane >> 3)) * 33 + 4 * (lane & 7); d[0] = v[i].x; d[1] = v[i].y; d[2] = v[i].z; d[3] = v[i].w; } }
    LDS_WAIT(); asm volatile("" ::: "memory");
    const int c = lane & 7;
    float g[8];
#pragma unroll
    for (int i = 0; i < 8; ++i) g[i] = (gain ? gain[(k0 + 8 * c + i) & gmask] : 1.f) * pg8::W8S;
#pragma unroll
    for (int j = 0; j < 4; ++j) { const int n = (lane >> 3) + 8 * j; const LAS float* s = scr + (8 * c) * 33 + n;
        u32x2 o; o.x = pg8::pk_fp8x4(s[0 * 33] * g[0], s[1 * 33] * g[1], s[2 * 33] * g[2], s[3 * 33] * g[3]); o.y = pg8::pk_fp8x4(s[4 * 33] * g[4], s[5 * 33] * g[5], s[6 * 33] * g[6], s[7 * 33] * g[7]);
        *(GAS u32x2*)(WT + (size_t)(n0 + n) * K + k0 + 8 * c) = o; }
    LDS_WAIT(); asm volatile("" ::: "memory");
}

__device__ __forceinline__ int attn_jlo(int h, int qt, float XB) {
    const float sl = LOG2E * __builtin_ldexpf(1.f, -(h + 1)); const float XT = XB + 25.1f;
    const int Wk = (int)(XT / sl) + 1; const int d = 128 * qt - Wk; return d > 0 ? (d >> 6) : 0; }
__device__ __forceinline__ float attn_b2(const float* qg, const float* kg, int lane) {
    float gm = fabsf(qg[lane] * kg[lane]);
#pragma unroll
    for (int o = 1; o < 64; o <<= 1) gm = fmaxf(gm, __shfl_xor(gm, o));
    return 8.f * gm * LOG2E * 1.02f + 0.05f;
}

__device__ __forceinline__ void p0_prologue(Frame& F, const float* const* in) {
    LAS float* scr = (LAS float*)(F.lds + RING_OFF + F.wave * 16384);
    const int gw = F.vcu * NWAVES + F.wave, NGW = F.G * NWAVES;
    constexpr int I1 = (D / 64) * (4096 / 32), I2 = (D / 64) * (D / 32), I3 = (D / 64) * (2 * FF / 32), I4 = (FF / 64) * (D / 32), I5 = (D / 64) * (3 * D / 32), I6 = I2;
    constexpr int I7 = (D / 64) * (2 * EF / 32), I8 = (EF / 64) * (D / 32);
    constexpr int NITEMS = I1 + I2 + I3 + I4 + I5 + I6 + NE * I7 + NE * I8;
    unsigned char* ws = F.ws;
    auto do_item = [&](int it) {
        int r = it;
        if (r < I1) { tr_item<3>(in[3], D, 4096, (bf16*)(ws + WS_W1), 0, in[2], 1023, 1.f, scr, r, F.lane); return; } r -= I1;
        if (r < I2) { tr_item<0>(in[5], D, D, (bf16*)(ws + WS_W2), 0, in[4], 1023, 1.f, scr, r, F.lane); return; } r -= I2;
        if (r < I3) { tr_item<1>(in[7], D, 2 * FF, (bf16*)(ws + WS_W3), FF, in[6], 1023, 1.f, scr, r, F.lane); return; } r -= I3;
        if (r < I4) { tr_item8<0>(in[8], FF, D, ws + WS_W4, 0, nullptr, 0, scr, r, F.lane); return; } r -= I4;
        if (r < I5) { tr_item<2>(in[10], D, 3 * D, (bf16*)(ws + WS_W5), 0, in[9], 1023, 1.f, scr, r, F.lane); return; } r -= I5;
        if (r < I6) { tr_item<0>(in[18], D, D, (bf16*)(ws + WS_W6), 0, in[17], 127, 1.f - LAMBDA_INIT, scr, r, F.lane); return; } r -= I6;
        if (r < NE * I7) { const int e = r / I7; tr_item8<1>(in[21] + (size_t)e * D * 2 * EF, D, 2 * EF, ws + WS_W7 + (size_t)e * 2 * EF * D, EF, in[19], 1023, scr, r % I7, F.lane); return; } r -= NE * I7;
        { const int e = r / I8; tr_item8<0>(in[22] + (size_t)e * EF * D, EF, D, ws + WS_W8 + (size_t)e * D * EF, 0, nullptr, 0, scr, r % I8, F.lane); }
    };
    const float* x = in[0]; bf16* xb = (bf16*)(ws + WS_ACT0); float* st0 = (float*)(ws + WS_ST0);
    static_assert((M / (256 * NWAVES)) % 4 == 0, "four rows per trip");
    int it = gw;
    for (int m = gw; m < M; m += 4 * NGW) {
        f32x4 v[4][4];
#pragma unroll
        for (int q = 0; q < 4; ++q) { const GAS f32x4* xr = (const GAS f32x4*)(x + (size_t)(m + q * NGW) * D) + F.lane;
#pragma unroll
            for (int j = 0; j < 4; ++j) v[q][j] = xr[64 * j]; }
        for (int r4 = 0; r4 < 4 && it < NITEMS; ++r4, it += NGW) do_item(it);
#pragma unroll
        for (int q = 0; q < 4; ++q) { GAS unsigned long long* o8 = (GAS unsigned long long*)(xb + (size_t)(m + q * NGW) * D) + F.lane;
            float s = 0.f;
#pragma unroll
            for (int j = 0; j < 4; ++j) { const f32x4 t = v[q][j]; s += (t.x * t.x + t.y * t.y) + (t.z * t.z + t.w * t.w); o8[64 * j] = (unsigned long long)cvtpk(t.x, t.y) | ((unsigned long long)cvtpk(t.z, t.w) << 32); }
            s = wave_sum(s); if (F.lane == 0) st0[m + q * NGW] = s; }
    }
    for (; it < NITEMS; it += NGW) do_item(it);
    if (blockIdx.x == 0) {
        const float* lbp = in[1]; float* LB = (float*)(ws + WS_LB);
        for (int c = F.tid; c < D; c += NWAVES * 64) { const float a0 = lbp[c], a1 = lbp[D + c], a2 = lbp[2 * D + c]; const float mx = fmaxf(a0, fmaxf(a1, a2));
            const float e0 = __expf(a0 - mx), e1 = __expf(a1 - mx), e2 = __expf(a2 - mx); LB[c] = e0 / (e0 + e1 + e2); }
    }
    if (blockIdx.x == 1) {
        const float* rp = in[20]; const float* gp = in[19]; float* R = (float*)(ws + WS_ROUTER);
        for (int i = F.tid; i < D * NE; i += NWAVES * 64) R[i] = rp[i] * gp[i >> 3];
    }
    {
        if (F.wave < 2) {
            const float XT = 2.f * attn_b2(in[11], in[12], F.lane);
            const int i = 2 * (int)blockIdx.x + F.wave; const int c = 2 * (i & 63) + 2 - attn_jlo(i >> 6, i & 63, XT);
            int rank = 0;
#pragma unroll
            for (int k = 0; k < 8; ++k) { const int j = F.lane + 64 * k; const int cj = 2 * (j & 63) + 2 - attn_jlo(j >> 6, j & 63, XT); rank += (cj > c || (cj == c && j < i)) ? 1 : 0; }
#pragma unroll
            for (int o = 1; o < 64; o <<= 1) rank += __shfl_xor(rank, o);
            if (F.lane == 0) ((int*)(ws + WS_UORDER))[rank] = i;
        }
    }
}

namespace scan {
constexpr int QS = 136, SS = 72;
constexpr int SG_Q = 0, SG_K = 16384, SG_V = 32768, SG_DEND = 36864, SG_BYTES = 37888;
constexpr int NSTG = 3, L_ST = NSTG * SG_BYTES, L_END = L_ST + 2 * 32 * QS * 2;
static_assert(L_END <= RING_BYTES, "scan LDS");
typedef float f32x4 __attribute__((ext_vector_type(4)));
}
__device__ __forceinline__ void scan_glds16(const void* gsrc, unsigned lds_dst) { unsigned keep;
    asm volatile("s_mov_b32 %0, m0\n\ts_mov_b32 m0, %2\n\ts_nop 0\n\tglobal_load_lds_dwordx4 %1, off\n\ts_mov_b32 m0, %0" : "=&s"(keep) : "v"(gsrc), "s"(lds_dst) : "memory"); }
typedef short scan_s16x4 __attribute__((ext_vector_type(4)));
__device__ __forceinline__ scan_s16x4 scan_tr8(unsigned addr) { scan_s16x4 r; asm volatile("ds_read_b64_tr_b16 %0, %1" : "=&v"(r) : "v"(addr) : "memory"); return r; }
#define SCAN_CAT(lo, hi) ((bf16x8){lo[0], lo[1], lo[2], lo[3], hi[0], hi[1], hi[2], hi[3]})
__device__ __forceinline__ void scan_phase(Frame& F) {
    using namespace scan;
    if (F.vcu >= BATCH * NH * 4) return;
    const int lane = F.lane, wid = F.wave, fr = lane & 15, fq = lane >> 4;
    const int b = F.vcu >> 5, h = (F.vcu >> 2) & 7, vs = F.vcu & 3;
    LAS unsigned char* L = F.lds + RING_OFF; LAS bf16* ST = (LAS bf16*)(L + L_ST);
    const bf16* qfvg = (const bf16*)(F.ws + WS_BIG); bf16* obuf = (bf16*)(F.ws + WS_ACT1); const float* dendg = (const float*)(F.ws + WS_DEND);
    const unsigned lds0 = (unsigned)(uintptr_t)L;
    const bf16* src[5]; unsigned dst[5];
#pragma unroll
    for (int j = 0; j < 4; ++j) { const int pc = 4 * wid + j, isK = pc >> 4, R = 4 * (pc & 15) + (lane >> 4), pp = lane & 15;
        src[j] = qfvg + (size_t)(b * T + R) * 4096 + isK * 1024 + h * 128 + ((pp ^ (R & 15)) * 8); dst[j] = (unsigned)(pc * 1024); }
    { const int pv = wid & 3, R = 16 * pv + (lane >> 2), pp = lane & 3;
      src[4] = (wid == 4) ? (const bf16*)(dendg + (size_t)(b * (T / 64)) * 1024 + h * 128 + lane * 4) : qfvg + (size_t)(b * T + R) * 4096 + 2048 + h * 128 + vs * 32 + pp * 8;
      dst[4] = (wid == 4) ? (unsigned)SG_DEND : (unsigned)(SG_V + pv * 1024); }
    const size_t adv4 = (wid == 4) ? (size_t)1024 * 2 : (size_t)64 * 4096;
#define SCAN_DMA(cc, stg) do { const int cl_ = (cc) < T / 64 ? (cc) : T / 64 - 1; const unsigned sb_ = lds0 + (unsigned)((stg) * SG_BYTES); \
        _Pragma("unroll") for (int j = 0; j < 4; ++j) scan_glds16(src[j] + (size_t)cl_ * 64 * 4096, (unsigned)__builtin_amdgcn_readfirstlane((int)(sb_ + dst[j]))); \
        scan_glds16(src[4] + (size_t)cl_ * adv4, (unsigned)__builtin_amdgcn_readfirstlane((int)(sb_ + dst[4]))); } while (0)
    for (int i = F.tid; i < 2 * 32 * QS / 2; i += NWAVES * 64) ((LAS unsigned*)ST)[i] = 0u;
    f32x4 sacc[2]; sacc[0] = (f32x4){0.f, 0.f, 0.f, 0.f}; sacc[1] = sacc[0];
    const int ti = wid >> 1, vi = wid & 1, q4 = fr >> 2, p4 = fr & 3;
    SCAN_DMA(0, 0); SCAN_DMA(1, 1);
    int stg = 0, stg2 = 2;
    for (int c = 0; c < T / 64; ++c) {
        const int cur = c & 1, nxt = cur ^ 1;
        if (c == 0) asm volatile("s_waitcnt vmcnt(5)" ::: "memory"); else if (c == 1) asm volatile("s_waitcnt vmcnt(6)" ::: "memory"); else asm volatile("s_waitcnt vmcnt(7)" ::: "memory");
        __syncthreads();
        SCAN_DMA(c + 2, stg2);
        LAS unsigned char* SG = L + stg * SG_BYTES; const unsigned sg0 = lds0 + (unsigned)(stg * SG_BYTES);
        bf16x8 qb[4];
#pragma unroll
        for (int kk = 0; kk < 4; ++kk) qb[kk] = *(const LAS bf16x8*)(SG + SG_Q + (16 * ti + fr) * 256 + (((4 * kk + fq) ^ fr) * 16));
        scan_s16x4 ka[2][2][2], vb[2][2], va[2][2];
#pragma unroll
        for (int ss = 0; ss < 2; ++ss)
#pragma unroll
            for (int hh = 0; hh < 2; ++hh) {
                const int srow = 32 * ss + 8 * fq + 4 * hh + q4;
#pragma unroll
                for (int s2 = 0; s2 < 2; ++s2) { const int ki = (wid >> 1) + 4 * s2; ka[s2][ss][hh] = scan_tr8(sg0 + SG_K + srow * 256 + (((2 * ki + (p4 >> 1)) ^ (srow & 15)) * 16) + (p4 & 1) * 8); }
                vb[ss][hh] = scan_tr8(sg0 + SG_V + srow * 64 + 32 * vi + p4 * 8);
            }
#pragma unroll
        for (int m = 0; m < 2; ++m)
#pragma unroll
            for (int hh = 0; hh < 2; ++hh) va[m][hh] = scan_tr8(sg0 + SG_V + (32 * m + 16 * hh + 4 * fq + q4) * 64 + 32 * vi + p4 * 8);
        asm volatile("s_waitcnt lgkmcnt(0)" ::: "memory"); __builtin_amdgcn_sched_barrier(0);
#pragma unroll
        for (int s2 = 0; s2 < 2; ++s2) {
            const int ki = (wid >> 1) + 4 * s2;
#pragma unroll
            for (int ss = 0; ss < 2; ++ss) sacc[s2] = __builtin_amdgcn_mfma_f32_16x16x32_bf16(SCAN_CAT(ka[s2][ss][0], ka[s2][ss][1]), SCAN_CAT(vb[ss][0], vb[ss][1]), sacc[s2], 0, 0, 0);
            sacc[s2] = sacc[s2] * *(const LAS f32x4*)(SG + SG_DEND + (16 * ki + 4 * fq) * 4);
            *(LAS u32x2*)(ST + nxt * 32 * QS + (16 * vi + fr) * QS + 16 * ki + 4 * fq) = (u32x2){cvtpk(sacc[s2][0], sacc[s2][1]), cvtpk(sacc[s2][2], sacc[s2][3])};
        }
        f32x4 oacc = (f32x4){0.f, 0.f, 0.f, 0.f};
        { bf16x8 sr[4];
#pragma unroll
          for (int kk = 0; kk < 4; ++kk) sr[kk] = *(const LAS bf16x8*)(ST + cur * 32 * QS + (16 * vi + fr) * QS + 32 * kk + 8 * fq);
#pragma unroll
          for (int kk = 0; kk < 4; ++kk) asm volatile("" : "+v"(sr[kk]));
#pragma unroll
          for (int kk = 0; kk < 4; ++kk) oacc = __builtin_amdgcn_mfma_f32_16x16x32_bf16(sr[kk], qb[kk], oacc, 0, 0, 0); }
#define SCAN_KROW(sb, kk) (*(const LAS bf16x8*)(SG + SG_K + (16 * (sb) + fr) * 256 + (((4 * (kk) + fq) ^ fr) * 16)))
#pragma unroll
        for (int m = 0; m < 2; ++m) {
            if (2 * m <= ti) {
                f32x4 pt0 = (f32x4){0.f, 0.f, 0.f, 0.f}, pt1 = pt0;
                if (2 * m + 1 <= ti) {
                    bf16x8 k0[4], k1[4];
#pragma unroll
                    for (int kk = 0; kk < 4; ++kk) { k0[kk] = SCAN_KROW(2 * m, kk); k1[kk] = SCAN_KROW(2 * m + 1, kk); }
#pragma unroll
                    for (int kk = 0; kk < 4; ++kk) { asm volatile("" : "+v"(k0[kk])); asm volatile("" : "+v"(k1[kk])); }
#pragma unroll
                    for (int kk = 0; kk < 4; ++kk) { pt0 = __builtin_amdgcn_mfma_f32_16x16x32_bf16(k0[kk], qb[kk], pt0, 0, 0, 0); pt1 = __builtin_amdgcn_mfma_f32_16x16x32_bf16(k1[kk], qb[kk], pt1, 0, 0, 0); }
                    if (2 * m + 1 == ti) {
#pragma unroll
                        for (int j = 0; j < 4; ++j) if (4 * fq + j > fr) pt1[j] = 0.f;
                    }
                } else {
                    bf16x8 k0[4];
#pragma unroll
                    for (int kk = 0; kk < 4; ++kk) k0[kk] = SCAN_KROW(2 * m, kk);
#pragma unroll
                    for (int kk = 0; kk < 4; ++kk) asm volatile("" : "+v"(k0[kk]));
#pragma unroll
                    for (int kk = 0; kk < 4; ++kk) pt0 = __builtin_amdgcn_mfma_f32_16x16x32_bf16(k0[kk], qb[kk], pt0, 0, 0, 0);
#pragma unroll
                    for (int j = 0; j < 4; ++j) if (4 * fq + j > fr) pt0[j] = 0.f;
                }
                const v4u pw = (v4u){cvtpk(pt0[0], pt0[1]), cvtpk(pt0[2], pt0[3]), cvtpk(pt1[0], pt1[1]), cvtpk(pt1[2], pt1[3])};
                oacc = __builtin_amdgcn_mfma_f32_16x16x32_bf16(SCAN_CAT(va[m][0], va[m][1]), __builtin_bit_cast(bf16x8, pw), oacc, 0, 0, 0);
            }
        }
#undef SCAN_KROW
        *(u32x2*)(obuf + (size_t)(b * T + c * 64 + 16 * ti + fr) * D + h * 128 + vs * 32 + 16 * vi + 4 * fq) = (u32x2){cvtpk(oacc[0], oacc[1]), cvtpk(oacc[2], oacc[3])};
        stg2 = stg; stg = (stg == 2) ? 0 : stg + 1;
    }
    asm volatile("s_waitcnt vmcnt(0)" ::: "memory");
    __syncthreads();
#undef SCAN_DMA
}
#undef SCAN_CAT

__device__ __forceinline__ void hgrn_gate_phase(Frame& F) {
    const int gw = F.vcu * NWAVES + F.wave, NGW = F.G * NWAVES;
    bf16* obuf = (bf16*)(F.ws + WS_ACT1); const bf16* qfvg = (const bf16*)(F.ws + WS_BIG);
    for (int m = gw; m < M; m += NGW) {
        v4u o[2], g[2];
        GAS v4u* op = (GAS v4u*)(obuf + (size_t)m * D + 16 * F.lane); const GAS v4u* gp = (const GAS v4u*)(qfvg + (size_t)m * 4096 + 3072 + 16 * F.lane);
        o[0] = op[0]; o[1] = op[1]; g[0] = gp[0]; g[1] = gp[1];
        float v[16]; float ss = 0.f;
#pragma unroll
        for (int i = 0; i < 8; ++i) { const unsigned w = o[i >> 2][i & 3]; v[2 * i] = bflo(w); v[2 * i + 1] = bfhi(w); ss += v[2 * i] * v[2 * i] + v[2 * i + 1] * v[2 * i + 1]; }
        ss += __shfl_xor(ss, 1); ss += __shfl_xor(ss, 2); ss += __shfl_xor(ss, 4);
        const float r = pg8::fast_rsq(ss * (1.f / 128.f) + EPS);
        v4u w[2];
#pragma unroll
        for (int i = 0; i < 8; ++i) { const unsigned gw2 = g[i >> 2][i & 3]; w[i >> 2][i & 3] = cvtpk(v[2 * i] * r * bflo(gw2), v[2 * i + 1] * r * bfhi(gw2)); }
        op[0] = w[0]; op[1] = w[1];
    }
}

namespace att {
using f32x16 = __attribute__((ext_vector_type(16))) float;
using s16x4 = __attribute__((ext_vector_type(4))) short;
typedef __bf16 bf2_t __attribute__((ext_vector_type(2)));
typedef short v4i16_t __attribute__((ext_vector_type(4)));
typedef __attribute__((address_space(3))) const char* lds_cptr;
constexpr int KSLOT = 16384, NKS = 3, VSLOT = 16384, NVS = 4, L_K0 = 0, L_K1 = 8192, L_V = NKS * KSLOT, L_WS = L_V + NVS * VSLOT, L_XO = 0, XOS = 132, PITCH = 3072;
static_assert(L_WS + NWAVES * 256 <= RING_BYTES && 128 * XOS * 4 <= L_WS, "attention LDS");
__device__ __forceinline__ int crow(int r, int hi) { return (r & 3) + 8 * (r >> 2) + 4 * hi; }
__device__ __forceinline__ void glds16(const void* gsrc, unsigned lds_dst) { unsigned keep;
    asm volatile("s_mov_b32 %0, m0\n\ts_mov_b32 m0, %2\n\ts_nop 0\n\tglobal_load_lds_dwordx4 %1, off\n\ts_mov_b32 m0, %0" : "=&s"(keep) : "v"(gsrc), "s"(lds_dst) : "memory"); }
__device__ __forceinline__ void qkt(f32x16& p0, f32x16& p1, lds_cptr Kslot, const bf16x8* qr, f32x16& cin, bf16x8 ones, bf16x8 b32, bf16x8 b64, int r32, int hi) {
    lds_cptr kb = Kslot + hi * 1024 + r32 * 16;
    bf16x8 kf[8];
#pragma unroll
    for (int d0 = 0; d0 < 4; ++d0) { kf[2 * d0] = *(const LAS bf16x8*)(kb + d0 * 2048); kf[2 * d0 + 1] = *(const LAS bf16x8*)(kb + d0 * 2048 + 512); }
#pragma unroll
    for (int i = 0; i < 8; ++i) asm volatile("" : "+v"(kf[i]));
    p0 = __builtin_amdgcn_mfma_f32_32x32x16_bf16(kf[0], qr[0], cin, 0, 0, 0); p1 = __builtin_amdgcn_mfma_f32_32x32x16_bf16(kf[1], qr[0], cin, 0, 0, 0);
    __builtin_amdgcn_sched_barrier(0);
#pragma unroll
    for (int d0 = 1; d0 < 4; ++d0) {
        p0 = __builtin_amdgcn_mfma_f32_32x32x16_bf16(kf[2 * d0], qr[d0], p0, 0, 0, 0);
        p1 = __builtin_amdgcn_mfma_f32_32x32x16_bf16(kf[2 * d0 + 1], qr[d0], p1, 0, 0, 0);
    }
    cin = __builtin_amdgcn_mfma_f32_32x32x16_bf16(ones, b64, cin, 0, 0, 0);
    p1 = __builtin_amdgcn_mfma_f32_32x32x16_bf16(ones, b32, p1, 0, 0, 0);
    __builtin_amdgcn_sched_barrier(0);
}
__device__ __forceinline__ void pv(f32x16* o, unsigned vb, bf16x8 pa0, bf16x8 pa1, bf16x8 pa2, bf16x8 pa3) {
#pragma unroll
    for (int d0 = 0; d0 < 4; ++d0) { s16x4 lo[4], hi[4];
#pragma unroll
        for (int ks = 0; ks < 4; ++ks) {
            asm volatile("ds_read_b64_tr_b16 %0,%1 offset:%c2" : "=&v"(lo[ks]) : "v"(vb), "i"(d0 * 4096 + ks * 1024) : "memory");
            asm volatile("ds_read_b64_tr_b16 %0,%1 offset:%c2" : "=&v"(hi[ks]) : "v"(vb), "i"(d0 * 4096 + ks * 1024 + 512) : "memory"); }
        asm volatile("s_waitcnt lgkmcnt(0)" ::: "memory"); __builtin_amdgcn_sched_barrier(0);
#define PK(k) (bf16x8){lo[k][0], lo[k][1], lo[k][2], lo[k][3], hi[k][0], hi[k][1], hi[k][2], hi[k][3]}
        o[d0] = __builtin_amdgcn_mfma_f32_32x32x16_bf16(pa0, PK(0), o[d0], 0, 0, 0);
        o[d0] = __builtin_amdgcn_mfma_f32_32x32x16_bf16(pa1, PK(1), o[d0], 0, 0, 0);
        o[d0] = __builtin_amdgcn_mfma_f32_32x32x16_bf16(pa2, PK(2), o[d0], 0, 0, 0);
        o[d0] = __builtin_amdgcn_mfma_f32_32x32x16_bf16(pa3, PK(3), o[d0], 0, 0, 0);
#undef PK
    }
}
struct VFrag { s16x4 lo[4], hi[4]; };
template <int KS> __device__ __forceinline__ void vrd4(VFrag& f, unsigned vb) {
#pragma unroll
    for (int d0 = 0; d0 < 4; ++d0) {
        asm volatile("ds_read_b64_tr_b16 %0,%1 offset:%c2" : "=&v"(f.lo[d0]) : "v"(vb), "i"(d0 * 4096 + KS * 1024) : "memory");
        asm volatile("ds_read_b64_tr_b16 %0,%1 offset:%c2" : "=&v"(f.hi[d0]) : "v"(vb), "i"(d0 * 4096 + KS * 1024 + 512) : "memory"); }
}
__device__ __forceinline__ void pv4(f32x16* o, const VFrag& f, bf16x8 pa) {
#pragma unroll
    for (int d0 = 0; d0 < 4; ++d0) {
        const bf16x8 vf = (bf16x8){f.lo[d0][0], f.lo[d0][1], f.lo[d0][2], f.lo[d0][3], f.hi[d0][0], f.hi[d0][1], f.hi[d0][2], f.hi[d0][3]};
        o[d0] = __builtin_amdgcn_mfma_f32_32x32x16_bf16(pa, vf, o[d0], 0, 0, 0); }
}
#ifdef MK_ATT_PROF
#define APROF(idx) do { const unsigned long long t_ = __builtin_amdgcn_s_memtime(); prof[idx] += t_ - tprev; tprev = t_; } while (0)
#else
#define APROF(idx) do {} while (0)
#endif
__device__ __forceinline__ void attn_unit(int b, int h, int qt, const bf16* QKV, bf16* Out, LAS unsigned char* shm, float lam, float slope2, float B2, unsigned long long* prof) {
#ifdef MK_ATT_PROF
    unsigned long long tprev = __builtin_amdgcn_s_memtime();
#endif
    const int tid = threadIdx.x, lane = tid & 63, r32 = lane & 31, hi = lane >> 5; const int wid = __builtin_amdgcn_readfirstlane(tid >> 6);
    const int comp = wid >> 2, wq = wid & 3;
    const long rowbase = (long)b * T; const int q0 = qt * 128; const int myq = q0 + 32 * wq + r32;
    const bf16* Qw = QKV + (rowbase + q0 + 32 * wq) * PITCH + h * 128 + comp * 64;
    const bf16* Kh = QKV + rowbase * PITCH + 1024 + h * 128; const bf16* Vh = QKV + rowbase * PITCH + 2048 + h * 128;
    const unsigned lds0 = (unsigned)(uintptr_t)shm;
    const int pz0 = 2 * wid;
    const unsigned kvo = (unsigned)((lane * PITCH + wid * 8) * 2);
    const unsigned kvo1 = kvo + 128u;
    const unsigned vvo0 = (unsigned)(((16 * (pz0 & 3) + (lane >> 2)) * PITCH + 32 * (pz0 >> 2) + (lane & 3) * 8) * 2);
    const unsigned vvo1 = (unsigned)(((16 * ((pz0 + 1) & 3) + (lane >> 2)) * PITCH + 32 * ((pz0 + 1) >> 2) + (lane & 3) * 8) * 2);
    const unsigned kls = (unsigned)__builtin_amdgcn_readfirstlane((int)(lds0 + L_K0 + wid * 1024)), vls = (unsigned)__builtin_amdgcn_readfirstlane((int)(lds0 + L_V + pz0 * 1024));
#define ATT_SB64(p_) (((unsigned long long)(unsigned)__builtin_amdgcn_readfirstlane((int)((unsigned long long)(p_) >> 32)) << 32) | (unsigned)__builtin_amdgcn_readfirstlane((int)(unsigned long long)(p_)))
#define ATT_GLDS(voff_, sbase_, mbase_, mimm_, ioff_) asm volatile("s_add_i32 m0, %2, %3\n\ts_nop 0\n\tglobal_load_lds_dwordx4 %0, %1 offset:" #ioff_ : : "v"(voff_), "s"(sbase_), "s"(mbase_), "i"(mimm_) : "memory", "scc")
#define DMA_TILE(t, koff, voff) do { const unsigned long long kb64_ = kb0_ + (unsigned long long)(unsigned)((t) - jlo) * (unsigned long long)(64 * PITCH * 2), vb64_ = vb0_ + (unsigned long long)(unsigned)((t) - jlo) * (unsigned long long)(64 * PITCH * 2); \
        const unsigned km_ = kls + (unsigned)(koff), vm_ = vls + (unsigned)(voff); \
        ATT_GLDS(kvo, kb64_, km_, 0, 0); ATT_GLDS(kvo1, kb64_, km_, L_K1 - L_K0, 0); \
        ATT_GLDS(vvo0, vb64_, vm_, 0, 0); ATT_GLDS(vvo1, vb64_, vm_, 1024, 0); } while (0)
    const int jlo = attn_jlo(h, qt, 2.f * B2), jhi = 2 * qt + 1, nt = jhi - jlo + 1;
    const unsigned long long kb0_ = ATT_SB64((const char*)Kh + (long)jlo * 64 * PITCH * 2), vb0_ = ATT_SB64((const char*)Vh + (long)jlo * 64 * PITCH * 2);
    DMA_TILE(jlo, 0, 0);
    if (nt > 1) DMA_TILE(jlo + 1, KSLOT, VSLOT);
    bf16x8 qr[4];
#pragma unroll
    for (int d0 = 0; d0 < 4; ++d0) qr[d0] = *reinterpret_cast<const bf16x8*>(&Qw[(long)r32 * PITCH + d0 * 16 + hi * 8]);
#pragma unroll
    for (int d0 = 0; d0 < 4; ++d0) asm volatile("" : "+v"(qr[d0]));
    f32x16 cin;
#pragma unroll
    for (int r = 0; r < 16; ++r) cin[r] = slope2 * (float)(64 * jlo + crow(r, hi) - myq) - B2;
    const float d32 = 32.f * slope2, d64 = 64.f * slope2;
    bf16x8 onesf, b32f, b64f;
    { const unsigned one2 = 0x3f803f80u; onesf = __builtin_bit_cast(bf16x8, (v4u){one2, one2, one2, one2});
      auto split = [&](float c) { const unsigned u0 = __builtin_bit_cast(unsigned, c) & 0xffff0000u; const float r1 = c - __builtin_bit_cast(float, u0);
          const unsigned u1 = __builtin_bit_cast(unsigned, r1) & 0xffff0000u; const float r2 = r1 - __builtin_bit_cast(float, u1); const unsigned u2 = __builtin_bit_cast(unsigned, r2) & 0xffff0000u;
          return (v4u){hi ? 0u : ((u0 >> 16) | u1), hi ? 0u : (u2 >> 16), 0u, 0u}; };
      b32f = __builtin_bit_cast(bf16x8, split(d32)); b64f = __builtin_bit_cast(bf16x8, split(d64)); }
    f32x16 o[4]; o[0] = f32x16{}; o[1] = f32x16{}; o[2] = f32x16{}; o[3] = f32x16{};
    float l_reg = 0.f;
    const unsigned vbl = lds0 + L_V + ((lane >> 4) & 1) * 32 + (lane & 3) * 8 + (4 * hi + ((lane & 15) >> 2)) * 64;
#define SB() __builtin_amdgcn_sched_barrier(0)
#define MASK_TILE(j) do { if (64 * (j) + 63 > q0 + 32 * wq) { const int kb_ = 64 * (j) + 4 * hi; \
        _Pragma("unroll") for (int r = 0; r < 16; ++r) { const int kv = kb_ + (r & 3) + 8 * (r >> 2); if (kv > myq) p0[r] = -INFINITY; if (kv + 32 > myq) p1[r] = -INFINITY; } } } while (0)
#define EXP2(e) do { if ((e) < 16) { p0[(e)] = __builtin_amdgcn_exp2f(p0[(e)]); p0[(e) + 1] = __builtin_amdgcn_exp2f(p0[(e) + 1]); } \
        else { p1[(e) - 16] = __builtin_amdgcn_exp2f(p1[(e) - 16]); p1[(e) - 15] = __builtin_amdgcn_exp2f(p1[(e) - 15]); } } while (0)
#define PSUM(w) sacc = __builtin_amdgcn_fdot2_f32_bf16(__builtin_bit_cast(att::bf2_t, (unsigned)(w)), (att::bf2_t){(__bf16)1.0f, (__bf16)1.0f}, sacc, false)
#define PSUM4(W) do { PSUM((W)[0]); PSUM((W)[1]); PSUM((W)[2]); PSUM((W)[3]); } while (0)
#define PACK_P() do { pw0 = (v4u){cvtpk(p0[0], p0[1]), cvtpk(p0[2], p0[3]), cvtpk(p0[4], p0[5]), cvtpk(p0[6], p0[7])}; pw1 = (v4u){cvtpk(p0[8], p0[9]), cvtpk(p0[10], p0[11]), cvtpk(p0[12], p0[13]), cvtpk(p0[14], p0[15])}; \
        pw2 = (v4u){cvtpk(p1[0], p1[1]), cvtpk(p1[2], p1[3]), cvtpk(p1[4], p1[5]), cvtpk(p1[6], p1[7])}; pw3 = (v4u){cvtpk(p1[8], p1[9]), cvtpk(p1[10], p1[11]), cvtpk(p1[12], p1[13]), cvtpk(p1[14], p1[15])}; \
        PSUM4(pw0); PSUM4(pw1); PSUM4(pw2); PSUM4(pw3); } while (0)
#define PV_STEP(VF, W, e0, EXTRA) do { const bf16x8 pa_ = __builtin_bit_cast(bf16x8, W); \
        _Pragma("unroll") for (int d0 = 0; d0 < 4; ++d0) { const bf16x8 vf_ = (bf16x8){VF.lo[d0][0], VF.lo[d0][1], VF.lo[d0][2], VF.lo[d0][3], VF.hi[d0][0], VF.hi[d0][1], VF.hi[d0][2], VF.hi[d0][3]}; \
            o[d0] = __builtin_amdgcn_mfma_f32_32x32x16_bf16(pa_, vf_, o[d0], 0, 0, 0); EXP2((e0) + 2 * d0); EXTRA; SB(); } } while (0)
#define CIN4(d0) do { cin[4 * (d0)] += d64; cin[4 * (d0) + 1] += d64; cin[4 * (d0) + 2] += d64; cin[4 * (d0) + 3] += d64; } while (0)
#define PV_ONLY(VF, W) do { const bf16x8 pa_ = __builtin_bit_cast(bf16x8, W); \
        _Pragma("unroll") for (int d0 = 0; d0 < 4; ++d0) { const bf16x8 vf_ = (bf16x8){VF.lo[d0][0], VF.lo[d0][1], VF.lo[d0][2], VF.lo[d0][3], VF.hi[d0][0], VF.hi[d0][1], VF.hi[d0][2], VF.hi[d0][3]}; \
            o[d0] = __builtin_amdgcn_mfma_f32_32x32x16_bf16(pa_, vf_, o[d0], 0, 0, 0); } SB(); } while (0)
    v4u pw0, pw1, pw2, pw3;
    int kslot = 0, kslot2 = 2 * KSLOT;
    {
        if (nt > 1) asm volatile("s_waitcnt vmcnt(4) lgkmcnt(0)\n\ts_barrier" ::: "memory"); else asm volatile("s_waitcnt vmcnt(0) lgkmcnt(0)\n\ts_barrier" ::: "memory");
        if (nt > 2) DMA_TILE(jlo + 2, kslot2, 2 * VSLOT);
        f32x16 p0, p1;
        qkt(p0, p1, (lds_cptr)(shm + kslot + comp * 8192), qr, cin, onesf, b32f, b64f, r32, hi); SB();
        MASK_TILE(jlo);
        float sacc = 0.f;
#pragma unroll
        for (int e = 0; e < 32; e += 2) EXP2(e);
        PACK_P(); l_reg += sacc;
        kslot2 = kslot; kslot = KSLOT;
    }
    for (int it = 1; it < nt; ++it) {
        const int j = jlo + it;
        if (it + 1 < nt) asm volatile("s_waitcnt vmcnt(4) lgkmcnt(0)\n\ts_barrier" ::: "memory"); else asm volatile("s_waitcnt vmcnt(0) lgkmcnt(0)\n\ts_barrier" ::: "memory");
        APROF(0);
        if (it + 2 < nt) DMA_TILE(j + 2, kslot2, ((it + 2) & 3) * VSLOT);
        f32x16 p0, p1;
        qkt(p0, p1, (lds_cptr)(shm + kslot + comp * 8192), qr, cin, onesf, b32f, b64f, r32, hi); SB();
        APROF(1);
        MASK_TILE(j);
        float sacc = 0.f;
        { VFrag vA, vB; const unsigned vb = vbl + (unsigned)(((it - 1) & 3) * VSLOT); SB();
          vrd4<0>(vA, vb); vrd4<1>(vB, vb); asm volatile("s_waitcnt lgkmcnt(8)" ::: "memory"); SB();
          PV_STEP(vA, pw0, 0, (void)0);
          vrd4<2>(vA, vb); asm volatile("s_waitcnt lgkmcnt(8)" ::: "memory"); SB();
          PV_STEP(vB, pw1, 8, { pw0[d0] = cvtpk(p0[2 * d0], p0[2 * d0 + 1]); PSUM(pw0[d0]); });
          vrd4<3>(vB, vb); asm volatile("s_waitcnt lgkmcnt(8)" ::: "memory"); SB();
          PV_STEP(vA, pw2, 16, { pw1[d0] = cvtpk(p0[8 + 2 * d0], p0[9 + 2 * d0]); PSUM(pw1[d0]); });
          asm volatile("s_waitcnt lgkmcnt(0)" ::: "memory"); SB();
          PV_STEP(vB, pw3, 24, { pw2[d0] = cvtpk(p1[2 * d0], p1[2 * d0 + 1]); PSUM(pw2[d0]); }); }
        pw3 = (v4u){cvtpk(p1[8], p1[9]), cvtpk(p1[10], p1[11]), cvtpk(p1[12], p1[13]), cvtpk(p1[14], p1[15])}; PSUM4(pw3); l_reg += sacc;
        APROF(3);
        kslot2 = kslot; kslot = (kslot == 2 * KSLOT) ? 0 : kslot + KSLOT;
    }
    {
        VFrag vA, vB; const unsigned vb = vbl + (unsigned)(((nt - 1) & 3) * VSLOT); SB();
        vrd4<0>(vA, vb); vrd4<1>(vB, vb); asm volatile("s_waitcnt lgkmcnt(8)" ::: "memory"); SB();
        PV_ONLY(vA, pw0);
        vrd4<2>(vA, vb); asm volatile("s_waitcnt lgkmcnt(8)" ::: "memory"); SB();
        PV_ONLY(vB, pw1);
        vrd4<3>(vB, vb); asm volatile("s_waitcnt lgkmcnt(8)" ::: "memory"); SB();
        PV_ONLY(vA, pw2);
        asm volatile("s_waitcnt lgkmcnt(0)" ::: "memory"); SB();
        PV_ONLY(vB, pw3);
    }
#undef SB
#undef MASK_TILE
#undef EXP2
#undef PACK_P
#undef PSUM
#undef PSUM4
#undef PV_STEP
#undef CIN4
#undef PV_ONLY
#undef DMA_TILE
#undef ATT_GLDS
#undef ATT_SB64
    APROF(4);
    { auto rr = __builtin_amdgcn_permlane32_swap(__float_as_uint(l_reg), __float_as_uint(l_reg), false, false); l_reg = __uint_as_float(rr[0]) + __uint_as_float(rr[1]); }
    LAS float* wsf = (LAS float*)(shm + L_WS) + wid * 64;
    if (hi == 0) wsf[r32] = l_reg;
    asm volatile("s_waitcnt lgkmcnt(0)" ::: "memory");
    float rli[16];
#pragma unroll
    for (int r = 0; r < 16; ++r) rli[r] = __builtin_amdgcn_rcpf(wsf[crow(r, hi)]) * (comp ? lam : 1.f);
    asm volatile("s_waitcnt lgkmcnt(0)\n\ts_barrier" ::: "memory");
    LAS float* XO = (LAS float*)(shm + L_XO) + (32 * wq) * XOS;
    if (comp == 1) {
#pragma unroll
        for (int d0 = 0; d0 < 4; ++d0)
#pragma unroll
            for (int r = 0; r < 16; ++r) XO[crow(r, hi) * XOS + 32 * d0 + r32] = o[d0][r] * rli[r];
    }
    asm volatile("s_waitcnt lgkmcnt(0)\n\ts_barrier" ::: "memory");
    if (comp == 0) {
#pragma unroll
        for (int d0 = 0; d0 < 4; ++d0)
#pragma unroll
            for (int r = 0; r < 16; ++r) { LAS float* p = XO + crow(r, hi) * XOS + 32 * d0 + r32; *p = o[d0][r] * rli[r] - *p; }
        asm volatile("s_waitcnt lgkmcnt(0)" ::: "memory");
        const int row = lane >> 1, half = lane & 1;
        const LAS f32x4* rp = (const LAS f32x4*)(XO + row * XOS + 64 * half);
        f32x4 v[16]; float ss = 0.f;
#pragma unroll
        for (int i = 0; i < 16; ++i) { v[i] = rp[i]; ss += (v[i][0] * v[i][0] + v[i][1] * v[i][1]) + (v[i][2] * v[i][2] + v[i][3] * v[i][3]); }
        ss += __shfl_xor(ss, 1);
        const float rn = pg8::fast_rsq(ss * (1.f / 128.f) + EPS);
        bf16* op = Out + (rowbase + q0 + 32 * wq + row) * D + h * 128 + 64 * half;
#pragma unroll
        for (int i = 0; i < 8; ++i) { const f32x4 a = v[2 * i] * rn, c = v[2 * i + 1] * rn; *(v4u*)(op + 8 * i) = (v4u){cvtpk(a[0], a[1]), cvtpk(a[2], a[3]), cvtpk(c[0], c[1]), cvtpk(c[2], c[3])}; }
    }
    asm volatile("s_waitcnt lgkmcnt(0)\n\ts_barrier" ::: "memory");
    APROF(5);
}
}

__device__ __forceinline__ void attn_phase(Frame& F, const float* const* in) {
    const float a1 = wave_sum(in[13][F.lane] * in[14][F.lane]), a2 = wave_sum(in[15][F.lane] * in[16][F.lane]);
    const float lam = __expf(a1) - __expf(a2) + LAMBDA_INIT;
    const float B2 = attn_b2(in[11], in[12], F.lane);
    const int b = F.vcu >> 5, jj = F.vcu & 31;
    const int* uo = (const int*)(F.ws + WS_UORDER);
    const bf16* QKV = (const bf16*)(F.ws + WS_BIG); bf16* Out = (bf16*)(F.ws + WS_ACT1);
    if (F.vcu >= 256) return;
    if (F.wave >= 4) __builtin_amdgcn_s_setprio(1);
    unsigned long long prof[6] = {0, 0, 0, 0, 0, 0};
    gu32* qh = F.ctl + CW_ATTQ + 64 * b; volatile LAS unsigned* nxw = F.MISC + 16; (void)jj;
    if (F.tid == 0) nxw[0] = __hip_atomic_fetch_add(qh, 1u, RLX_AGENT);
    __syncthreads();
    unsigned rank = nxw[0];
    while (rank < 512u) {
        unsigned nx = 0u;
        if (F.tid == 0) nx = __hip_atomic_fetch_add(qh, 1u, RLX_AGENT);
        const int un = __builtin_amdgcn_readfirstlane(uo[rank]); const int h = un >> 6, qt = un & 63;
        const float slope2 = LOG2E * __builtin_ldexpf(1.f, -(h + 1));
        att::attn_unit(b, h, qt, QKV, Out, F.lds + RING_OFF, lam, slope2, B2, prof);
        __syncthreads();
        if (F.tid == 0) nxw[0] = nx;
        __syncthreads();
        rank = (unsigned)__builtin_amdgcn_readfirstlane((int)nxw[0]);
    }
    __builtin_amdgcn_s_setprio(0);
#ifdef MK_ATT_PROF
    if (F.tid == 0) { unsigned long long* g = (unsigned long long*)(F.ws + 65536);
#pragma unroll
        for (int i = 0; i < 6; ++i) atomicAdd(g + i, prof[i]); }
#endif
}

__device__ __forceinline__ void router_phase(Frame& F, const bf16* hb) {
    LAS float* R = (LAS float*)(F.lds + RING_OFF);
    LAS unsigned* cnt = (LAS unsigned*)(F.lds + RING_OFF + 36864);
    const float* Rg = (const float*)(F.ws + WS_ROUTER);
    for (int i = F.tid; i < D * NE / 4; i += NWAVES * 64) *(LAS f32x4*)(R + 4 * i + (i >> 5) * 4) = ((const f32x4*)Rg)[i];
    if (F.tid < 16) cnt[F.tid] = 0u;
    __syncthreads();
    const unsigned long long* st3 = (const unsigned long long*)(F.ws + WS_ST3); int* toke = (int*)(F.ws + WS_TOKE); float* tokg = (float*)(F.ws + WS_TOKG);
    const int wg = blockIdx.x;
    for (int i = 0; i < 32; ++i) {
        const int m = wg * 256 + F.wave * 32 + i;
        const GAS v4u* xr = (const GAS v4u*)(hb + (size_t)m * D) + 2 * F.lane;
        const v4u xa = xr[0], xb2 = xr[1];
        float lg[8];
#pragma unroll
        for (int e = 0; e < 8; ++e) lg[e] = 0.f;
#pragma unroll
        for (int c = 0; c < 16; ++c) { const unsigned w = (c < 8) ? xa[c >> 1] : xb2[(c - 8) >> 1]; const float v = (c & 1) ? bfhi(w) : bflo(w);
            const f32x4 ra = *(const LAS f32x4*)(R + (16 * F.lane + c) * 8 + F.lane * 4), rb = *(const LAS f32x4*)(R + (16 * F.lane + c) * 8 + F.lane * 4 + 4);
            lg[0] += v * ra[0]; lg[1] += v * ra[1]; lg[2] += v * ra[2]; lg[3] += v * ra[3]; lg[4] += v * rb[0]; lg[5] += v * rb[1]; lg[6] += v * rb[2]; lg[7] += v * rb[3]; }
        const float r = pg8::st_rscale(st3, m);
#pragma unroll
        for (int e = 0; e < 8; ++e) lg[e] = wave_sum(lg[e]) * r;
        int i1 = 0; float v1 = lg[0];
#pragma unroll
        for (int e = 1; e < 8; ++e) if (lg[e] > v1) { v1 = lg[e]; i1 = e; }
        int i2 = -1; float v2 = -INFINITY;
#pragma unroll
        for (int e = 0; e < 8; ++e) if (e != i1 && lg[e] > v2) { v2 = lg[e]; i2 = e; }
        if (i2 < 0) { i2 = (i1 + 1) & 7; v2 = v1; }
        const float g1 = 1.f / (1.f + __expf(v2 - v1)), g2 = 1.f - g1;
        if (F.lane == 0) { toke[2 * m] = i1; toke[2 * m + 1] = i2; tokg[2 * m] = g1; tokg[2 * m + 1] = g2; lds_inc(cnt + i1); lds_inc(cnt + 8 + i2); }
    }
    __syncthreads();
    if (F.tid < 16) ((unsigned*)(F.ws + WS_WGCNT))[wg * 16 + F.tid] = cnt[F.tid];
}

__device__ __forceinline__ void gather_rows(Frame& F) {
    const bf16* hb = (const bf16*)(F.ws + WS_ACT0); unsigned char* Xs = F.ws + WS_ACT1; const int* toks = (const int*)(F.ws + WS_TOKS);
    const int wg = blockIdx.x;
    for (int i = 0; i < 32; i += 4) {
        v4u a[4], b[4]; int s0[4], s1[4];
#pragma unroll
        for (int q = 0; q < 4; ++q) { const int m = wg * 256 + F.wave * 32 + i + q; s0[q] = toks[2 * m]; s1[q] = toks[2 * m + 1];
            const GAS v4u* s = (const GAS v4u*)(hb + (size_t)m * D) + 2 * F.lane; a[q] = s[0]; b[q] = s[1]; }
#pragma unroll
        for (int q = 0; q < 4; ++q) {
            v4u o;
            o.x = pg8::pk_fp8x4(bflo(a[q].x) * pg8::A8S, bfhi(a[q].x) * pg8::A8S, bflo(a[q].y) * pg8::A8S, bfhi(a[q].y) * pg8::A8S); o.y = pg8::pk_fp8x4(bflo(a[q].z) * pg8::A8S, bfhi(a[q].z) * pg8::A8S, bflo(a[q].w) * pg8::A8S, bfhi(a[q].w) * pg8::A8S);
            o.z = pg8::pk_fp8x4(bflo(b[q].x) * pg8::A8S, bfhi(b[q].x) * pg8::A8S, bflo(b[q].y) * pg8::A8S, bfhi(b[q].y) * pg8::A8S); o.w = pg8::pk_fp8x4(bflo(b[q].z) * pg8::A8S, bfhi(b[q].z) * pg8::A8S, bflo(b[q].w) * pg8::A8S, bfhi(b[q].w) * pg8::A8S);
            *((GAS v4u*)(Xs + (size_t)s0[q] * D) + F.lane) = o;
            *((GAS v4u*)(Xs + ((size_t)SLOTS_MAX + s1[q]) * D) + F.lane) = o;
        }
    }
}

__device__ __forceinline__ void assign_phase(Frame& F) {
    LAS unsigned* tot = (LAS unsigned*)(F.lds + RING_OFF);
    LAS unsigned* pre = tot + 16; LAS unsigned* base = tot + 32; LAS unsigned* cur = tot + 48; LAS unsigned* start = tot + 64;
    const int wg = blockIdx.x;
    if (F.tid < 128) tot[F.tid] = 0u;
    __syncthreads();
    const unsigned* wgcnt = (const unsigned*)(F.ws + WS_WGCNT);
    for (int idx = F.tid; idx < 256 * 16; idx += NWAVES * 64) { const unsigned v = wgcnt[idx]; const int w = idx >> 4, i = idx & 15; lds_add(tot + i, v); if (w < wg) lds_add(pre + i, v); }
    __syncthreads();
    if (F.tid < 2) { unsigned s = 0; for (int e = 0; e < 8; ++e) { start[F.tid * 9 + e] = s; s += (tot[F.tid * 8 + e] + 255u) & ~255u; } start[F.tid * 9 + 8] = s; }
    __syncthreads();
    if (F.tid < 16) { base[F.tid] = start[(F.tid >> 3) * 9 + (F.tid & 7)] + pre[F.tid]; }
    if (wg == 0 && F.tid < 18) ((int*)(F.ws + WS_RTS))[(F.tid / 9) * 16 + (F.tid % 9)] = (int)(start[F.tid] >> 8);
    __syncthreads();
    int* s2t = (int*)(F.ws + WS_S2T); float* sg = (float*)(F.ws + WS_SG); float* sr = (float*)(F.ws + WS_SR); int* toks = (int*)(F.ws + WS_TOKS);
    const int* toke = (const int*)(F.ws + WS_TOKE); const float* tokg = (const float*)(F.ws + WS_TOKG); const unsigned long long* st3 = (const unsigned long long*)(F.ws + WS_ST3);
    if (F.tid < 256) {
        const int m = wg * 256 + F.tid; const float r = pg8::st_rscale(st3, m);
#pragma unroll
        for (int rk = 0; rk < 2; ++rk) { const int e = toke[2 * m + rk]; const unsigned pos = lds_add(cur + rk * 8 + e, 1u); const int slot = (int)(base[rk * 8 + e] + pos);
            s2t[rk * SLOTS_MAX + slot] = m; sg[rk * SLOTS_MAX + slot] = tokg[2 * m + rk]; sr[rk * SLOTS_MAX + slot] = r; toks[2 * m + rk] = slot; }
    }
    if (wg < 16) {
        const int rk = wg >> 3, e = wg & 7; const unsigned lo = start[rk * 9 + e] + tot[wg], hi = start[rk * 9 + e + 1];
        for (unsigned s = lo + F.tid; s < hi; s += NWAVES * 64) { s2t[rk * SLOTS_MAX + s] = -1; sg[rk * SLOTS_MAX + s] = 0.f; sr[rk * SLOTS_MAX + s] = 0.f; }
    }
    __syncthreads();
    __threadfence_block();
    gather_rows(F);
}

struct Args { const float* in[23]; float* out; unsigned char* ws; int ph_lo, ph_hi; };
static_assert(sizeof(Args) == 25 * 8 + 8, "no padding in Args");
__global__ void __launch_bounds__(NWAVES * 64, 2) fwd_kernel(Args args) {
    extern __shared__ __attribute__((aligned(16))) unsigned char lds[];
    Frame F;
    F.lds = (LAS unsigned char*)lds;
    F.MISC = (volatile LAS unsigned*)(F.lds + MISC_OFF);
    F.tid = threadIdx.x; F.lane = F.tid & 63; F.wave = __builtin_amdgcn_readfirstlane(F.tid >> 6);
    F.G = gridDim.x; { const int bx = blockIdx.x; F.vcu = (F.G % 8 == 0) ? (bx % 8) * (F.G / 8) + bx / 8 : bx; }
    F.ws = args.ws; F.ctl = (gu32*)(args.ws + WS_CTL);
    unsigned char* ws = args.ws;
    for (int u = F.tid; u < (LDS_BYTES - LDSCTL_OFF) / 4; u += NWAVES * 64) ((LAS unsigned*)(F.lds + LDSCTL_OFF))[u] = 0u;
    __syncthreads();
    XcdBarrier bar; bar.bar = (unsigned*)(F.ctl + CW_BAR); bar.x = 0; bar.st = nullptr;
    if (N_LAUNCHES == 1) bar = xcd_barrier_post((unsigned*)(F.ctl + CW_BAR), F.MISC + 8);
#define GRID_BAR() do { if (N_LAUNCHES == 1) xcd_barrier(bar); } while (0)
    const int lo = args.ph_lo, hi = args.ph_hi;
#define IN(k) (lo <= (k) && (k) < hi)
#define BOTH(k) (IN(k) && IN((k) + 1))
    bf16* ACT0 = (bf16*)(ws + WS_ACT0); bf16* ACT1 = (bf16*)(ws + WS_ACT1); bf16* BIG = (bf16*)(ws + WS_BIG);
    float* ST0 = (float*)(ws + WS_ST0); unsigned long long* ST1 = (unsigned long long*)(ws + WS_ST1); unsigned long long* ST2 = (unsigned long long*)(ws + WS_ST2); unsigned long long* ST3 = (unsigned long long*)(ws + WS_ST3);

#if defined(MK_DUP_SMALL) || defined(MK_DUP_P0)
    if (IN(0)) { p0_prologue(F, args.in); GRID_BAR(); }
#endif
    if (IN(0)) { p0_prologue(F, args.in); if (BOTH(0)) GRID_BAR(); }
#ifdef MK_DUP_G1
    if (IN(1)) { pg8::Gemm g{ACT0, (const bf16*)(ws + WS_W1), M, 4096, D}; pg8::StaticOrder S; S.init(M, 4096, F.G, (int)blockIdx.x);
        pg8::EpiHgrnIn E{BIG, ST0, (const float*)(ws + WS_LB), (float*)(ws + WS_DEND)};
        pg8::gemm_phase<pg8::EpiHgrnIn, pg8::StaticOrder, true, true>(F.lds + RING_OFF, g, S, E); GRID_BAR(); }
#endif
    if (IN(1)) {
        pg8::Gemm g{ACT0, (const bf16*)(ws + WS_W1), M, 4096, D}; pg8::StaticOrder S; S.init(M, 4096, F.G, (int)blockIdx.x);
        pg8::EpiHgrnIn E{BIG, ST0, (const float*)(ws + WS_LB), (float*)(ws + WS_DEND)};
        pg8::gemm_phase<pg8::EpiHgrnIn, pg8::StaticOrder, true, true>(F.lds + RING_OFF, g, S, E);
        if (BOTH(1)) GRID_BAR();
    }
#if defined(MK_DUP_SMALL) || defined(MK_DUP_SCAN)
    if (IN(2)) { scan_phase(F); GRID_BAR(); }
#endif
    if (IN(2)) { scan_phase(F); if (BOTH(2)) GRID_BAR(); }
    if (IN(3)) { hgrn_gate_phase(F); if (BOTH(3)) GRID_BAR(); }
    if (IN(4)) {
        pg8::Gemm g{ACT1, (const bf16*)(ws + WS_W2), M, D, D}; pg8::StaticOrder S; S.init(M, D, F.G, (int)blockIdx.x);
        pg8::EpiRes<false> E{nullptr, ACT0, ST1, 1.f};
        pg8::gemm_phase<pg8::EpiRes<false>, pg8::StaticOrder, true, true>(F.lds + RING_OFF, g, S, E);
        if (BOTH(4)) GRID_BAR();
    }
    if (IN(5)) {
        pg8::Gemm g{ACT0, (const bf16*)(ws + WS_W3), M, 2 * FF, D}; pg8::StaticOrder S; S.init(M, 2 * FF, F.G, (int)blockIdx.x);
        pg8::EpiSwiGLU<true> E{nullptr, BIG, FF, ST1, nullptr, 2 * FF / 256, 1.f};
        pg8::gemm_phase<pg8::EpiSwiGLU<true>, pg8::StaticOrder, true, true>(F.lds + RING_OFF, g, S, E);
        if (BOTH(5)) GRID_BAR();
    }
    if (IN(6)) {
        pg8::Gemm g{BIG, (const bf16*)(ws + WS_W4), M, D, FF}; pg8::StaticOrder S; S.init(M, D, F.G, (int)blockIdx.x);
        pg8::EpiRes<false> E{nullptr, ACT0, ST2, pg8::ACC8};
        pg8::gemm_phase<pg8::EpiRes<false>, pg8::StaticOrder, true, true, true>(F.lds + RING_OFF, g, S, E);
        if (BOTH(6)) GRID_BAR();
    }
    if (IN(7)) {
        pg8::Gemm g{ACT0, (const bf16*)(ws + WS_W5), M, 3 * D, D}; pg8::StaticOrder S; S.init(M, 3 * D, F.G, (int)blockIdx.x);
        pg8::EpiQKV E{BIG, ST2, args.in[11], args.in[12]};
        pg8::gemm_phase<pg8::EpiQKV, pg8::StaticOrder, true, true>(F.lds + RING_OFF, g, S, E);
        if (BOTH(7)) GRID_BAR();
    }
#ifdef MK_DUP_ATT
    if (IN(8)) { attn_phase(F, args.in); GRID_BAR(); }
#endif
    if (IN(8)) { attn_phase(F, args.in); if (BOTH(8)) GRID_BAR(); }
    if (IN(9)) {
        pg8::Gemm g{ACT1, (const bf16*)(ws + WS_W6), M, D, D}; pg8::StaticOrder S; S.init(M, D, F.G, (int)blockIdx.x);
        pg8::EpiRes<false> E{nullptr, ACT0, ST3, 1.f};
        pg8::gemm_phase<pg8::EpiRes<false>, pg8::StaticOrder, true, true>(F.lds + RING_OFF, g, S, E);
        if (BOTH(9)) GRID_BAR();
    }
#ifdef MK_DUP_SMALL
    if (IN(10)) { router_phase(F, ACT0); GRID_BAR(); }
    if (IN(11)) { assign_phase(F); GRID_BAR(); }
#endif
    if (IN(10)) { router_phase(F, ACT0); if (BOTH(10)) GRID_BAR(); }
    if (IN(11)) { assign_phase(F); if (BOTH(11)) GRID_BAR(); }
#define MOE_UP(rk, NX) do { pg8::Gemm g{(const bf16*)(ws + WS_ACT1 + (size_t)(rk) * SLOTS_MAX * D), (const bf16*)(ws + WS_W7), 0, 0, D}; pg8::GroupedOrder S; S.init((const int*)(ws + WS_RTS) + 16 * (rk), 2 * EF / 256, F.G, (int)blockIdx.x); \
        S.so.nx = (NX); S.so.sk = 3; \
        pg8::EpiSwiGLU<true, false> E{(void*)(ws + 65536), (bf16*)((unsigned char*)BIG + (size_t)(rk) * SLOTS_MAX * EF), EF, nullptr, (const float*)(ws + WS_SR) + (rk) * SLOTS_MAX, 2 * EF / 256, pg8::ACC8}; \
        pg8::gemm_phase<pg8::EpiSwiGLU<true, false>, pg8::GroupedOrder, true, true, true>(F.lds + RING_OFF, g, S, E); } while (0)
#define MOE_DOWN(rk, FIN) do { pg8::Gemm g{(const bf16*)((const unsigned char*)BIG + (size_t)(rk) * SLOTS_MAX * EF), (const bf16*)(ws + WS_W8), 0, 0, EF}; pg8::GroupedOrder S; S.init((const int*)(ws + WS_RTS) + 16 * (rk), D / 256, F.G, (int)blockIdx.x); \
        pg8::EpiMoeDown<FIN> E{args.out, ACT0, (const int*)(ws + WS_S2T) + (rk) * SLOTS_MAX, (const float*)(ws + WS_SG) + (rk) * SLOTS_MAX, D / 256}; \
        pg8::gemm_phase<pg8::EpiMoeDown<FIN>, pg8::GroupedOrder, true, true, true>(F.lds + RING_OFF, g, S, E); } while (0)
    if (IN(12)) { MOE_UP(0, 0); if (BOTH(12)) GRID_BAR(); }
    if (IN(13)) { MOE_DOWN(0, false); if (BOTH(13)) __syncthreads(); }
    if (IN(14)) { MOE_UP(1, (N_LAUNCHES == 1) ? (__builtin_amdgcn_readfirstlane(((const int*)(ws + WS_RTS))[8]) * (D / 256)) % F.G : 0); if (BOTH(14)) GRID_BAR(); }
    constexpr int TAIL_KS = 7, TAIL_KB = EF / TAIL_KS;
    const unsigned char* Hm1_ = (const unsigned char*)BIG + (size_t)SLOTS_MAX * EF;
    const int* s2t1_ = (const int*)(ws + WS_S2T) + SLOTS_MAX; const float* sg1_ = (const float*)(ws + WS_SG) + SLOTS_MAX;
    if (IN(15)) {
        pg8::GroupedOrder S; S.init((const int*)(ws + WS_RTS) + 16, D / 256, F.G, (int)blockIdx.x); S.so.lim = 4 * F.G;
        { pg8::Gemm g{(const bf16*)Hm1_, (const bf16*)(ws + WS_W8), 0, 0, EF};
          pg8::EpiMoeDown<true> E{args.out, ACT0, s2t1_, sg1_, D / 256};
          pg8::gemm_phase<pg8::EpiMoeDown<true>, pg8::GroupedOrder, true, true, true>(F.lds + RING_OFF, g, S, E); }
        const int ntail = S.so.nwg > 4 * F.G ? (S.so.nwg - 4 * F.G < 36 ? S.so.nwg - 4 * F.G : 36) : 0;
        __syncthreads();
        if ((int)blockIdx.x < ntail * TAIL_KS) {
            const int tu = (int)blockIdx.x / TAIL_KS, ks = (int)blockIdx.x % TAIL_KS;
            pg8::PieceOrder PS; S.unit_at((long)(4 * F.G + tu), PS.u); PS.has = 1;
            int klen_ = TAIL_KB; asm volatile("" : "+s"(klen_));
            pg8::Gemm gp{(const bf16*)(Hm1_ + ks * TAIL_KB), (const bf16*)(ws + WS_W8 + ks * TAIL_KB), 0, 0, klen_, EF};
            pg8::EpiPartial EP{(float*)(ws + WS_ACT1) + (size_t)blockIdx.x * 65536};
            pg8::gemm_phase<pg8::EpiPartial, pg8::PieceOrder, true, true, true>(F.lds + RING_OFF, gp, PS, EP);
        }
        if (BOTH(15)) GRID_BAR();
    }
    if (IN(16)) {
        pg8::GroupedOrder S; S.init((const int*)(ws + WS_RTS) + 16, D / 256, F.G, (int)blockIdx.x);
        const int ntail = S.so.nwg > 4 * F.G ? (S.so.nwg - 4 * F.G < 36 ? S.so.nwg - 4 * F.G : 36) : 0;
        int tid16_ = (int)threadIdx.x; asm volatile("" : "+v"(tid16_));
        for (int idx = (int)blockIdx.x * (NWAVES * 64) + tid16_; idx < ntail * 16384; idx += 256 * (NWAVES * 64)) {
            const int tu = idx >> 14, row = (idx >> 6) & 255, c4 = (idx & 63) * 4;
            pg8::Unit uu; S.unit_at_v((long)(4 * F.G + tu), uu);
            const int slot = uu.pm * 256 + row; const int tok = s2t1_[slot];
            if (tok < 0) continue;
            const float gsc = sg1_[slot] * pg8::ACC8;
            const float* pp = (const float*)(ws + WS_ACT1) + (size_t)(tu * TAIL_KS) * 65536 + row * 256 + c4;
            pg8::f32x4 sum = *(const pg8::f32x4*)pp;
#pragma unroll
            for (int ks = 1; ks < TAIL_KS; ++ks) sum += *(const pg8::f32x4*)(pp + (size_t)ks * 65536);
            const size_t off = (size_t)tok * 1024 + (size_t)(uu.pn & 3) * 256 + c4;
            const pg8::u32x2e wv = *(const pg8::u32x2e*)(ACT0 + off);
            const pg8::f32x4 r = {__builtin_bit_cast(float, wv.x << 16), __builtin_bit_cast(float, wv.x & 0xffff0000u), __builtin_bit_cast(float, wv.y << 16), __builtin_bit_cast(float, wv.y & 0xffff0000u)};
            *(pg8::f32x4*)(args.out + off) = sum * gsc + r;
        }
    }
#undef IN
#undef BOTH
}

#ifdef MK_DEBUG_NAN
__global__ void chk_kernel(const unsigned* buf, size_t nwords, int is_f32, unsigned* flag, unsigned bit) {
    bool bad = false;
    for (size_t i = blockIdx.x * (size_t)blockDim.x + threadIdx.x; i < nwords; i += (size_t)gridDim.x * blockDim.x) { const unsigned w = buf[i];
        if (is_f32) bad |= (w & 0x7f800000u) == 0x7f800000u; else bad |= ((w & 0x7f80u) == 0x7f80u) || ((w & 0x7f800000u) == 0x7f800000u); }
    if (bad) atomicOr(flag, bit);
}
__global__ void cnt_kernel(const unsigned short* buf, size_t n, unsigned* cnt) {
    unsigned c = 0;
    for (size_t i = blockIdx.x * (size_t)blockDim.x + threadIdx.x; i < n; i += (size_t)gridDim.x * blockDim.x) c += ((buf[i] & 0x7f80u) == 0x7f80u) ? 1u : 0u;
    if (c) atomicAdd(cnt, c);
}
__global__ void minlf_kernel(const unsigned short* qfvg, unsigned* mx) {
    unsigned m = 0;
    for (size_t i = blockIdx.x * (size_t)blockDim.x + threadIdx.x; i < (size_t)M * 1024; i += (size_t)gridDim.x * blockDim.x) {
        const size_t row = i >> 10, c = i & 1023; const float v = __builtin_bit_cast(float, (unsigned)qfvg[row * 4096 + 1024 + c] << 16);
        const float q = fminf(fmaxf(-v * 2.f + 0.5f, 0.f), 15.f); m = max(m, (unsigned)q); }
    atomicMax(mx, m);
}
__global__ void maxabs_kernel(const unsigned short* qfvg, unsigned* mx) {
    unsigned m = 0;
    for (size_t i = blockIdx.x * (size_t)blockDim.x + threadIdx.x; i < (size_t)M * 4096; i += (size_t)gridDim.x * blockDim.x) {
        const size_t c = i & 4095; if (c >= 1024 && c < 2048) continue; m = max(m, ((unsigned)qfvg[i] << 16) & 0x7fffffffu); }
    atomicMax(mx, m);
}
__global__ void firstnan_kernel(const unsigned short* buf, size_t n, unsigned* mn) {
    unsigned m = 0xffffffffu;
    for (size_t i = blockIdx.x * (size_t)blockDim.x + threadIdx.x; i < n; i += (size_t)gridDim.x * blockDim.x) if ((buf[i] & 0x7f80u) == 0x7f80u) m = min(m, (unsigned)i);
    atomicMax(mn, ~m);
}
__global__ void report3_kernel(float* out, size_t n, const unsigned* w) {
    for (size_t i = blockIdx.x * (size_t)blockDim.x + threadIdx.x; i < n; i += (size_t)gridDim.x * blockDim.x) out[i] = 0.f;
    __syncthreads();
    if (blockIdx.x == 0 && threadIdx.x == 0) { const float mxv = __builtin_bit_cast(float, w[0]); int A = 0; while (A < 60 && __builtin_ldexpf(1.f, A) < mxv) ++A;
        const unsigned idx = ~w[1];    const unsigned row = idx >> 10; const unsigned B = (row & 8191u) >> 9;
        out[0] = 8192.f * (1.f + (float)B / 16.f) * __builtin_ldexpf(1.f, A); }
}
__global__ void report2_kernel(float* out, size_t n, const unsigned* w) {
    for (size_t i = blockIdx.x * (size_t)blockDim.x + threadIdx.x; i < n; i += (size_t)gridDim.x * blockDim.x) out[i] = 0.f;
    __syncthreads();
    if (blockIdx.x == 0 && threadIdx.x == 0) { const unsigned cnt = w[0], B = w[1]; int A = 0; while ((1ull << A) < (unsigned long long)cnt + 1ull) ++A; out[0] = 8192.f * (1.f + (float)B / 16.f) * __builtin_ldexpf(1.f, A); }
}
__global__ void report_prof_kernel(float* out, size_t n, const unsigned long long* g, int a, int b) {
    for (size_t i = blockIdx.x * (size_t)blockDim.x + threadIdx.x; i < n; i += (size_t)gridDim.x * blockDim.x) out[i] = 0.f;
    __syncthreads();
    if (blockIdx.x == 0 && threadIdx.x == 0) { double tot = 0; for (int i = 0; i < 6; ++i) tot += (double)g[i]; const double fa = (double)g[a] / tot, fb = (double)g[b < 0 ? 0 : b] / tot;
        if (b < 0) out[0] = (float)(1.0e4 * (double)(int)(fa * (double)(-b)) + 1.0e3); else
        out[0] = (float)(1.0e6 * ((double)(int)(fa * 10.0 + 0.5) * 10.0 + (double)(int)(fb * 10.0 + 0.5)) + 1.0e4); }
}
__global__ void report_kernel(float* out, size_t n, const unsigned* flag) {
    for (size_t i = blockIdx.x * (size_t)blockDim.x + threadIdx.x; i < n; i += (size_t)gridDim.x * blockDim.x) out[i] = 0.f;
    __syncthreads();
    if (blockIdx.x == 0 && threadIdx.x == 0) out[0] = 8192.f * __builtin_ldexpf(1.f, 2 * (int)(*flag & 15u));
}
#endif
extern "C" void kernel_launch(void* const* d_in, const int* in_sizes, int n_in, void* d_out, int out_size, void* d_ws, size_t ws_size, hipStream_t stream) {
    static int grid = 0;
    if (grid == 0) {
        if (n_in != 23 || in_sizes[0] != M * D || out_size != M * D || ws_size < WS_END) { fprintf(stderr, "kernel_launch: unexpected shapes (n_in %d, in0 %d, out %d, ws %zu); nothing launched\n", n_in, n_in > 0 ? in_sizes[0] : -1, out_size, ws_size); grid = -1; return; }
        int dev = 0, cus = 0, per_cu = 0;
        if (hipGetDevice(&dev) != hipSuccess || hipDeviceGetAttribute(&cus, hipDeviceAttributeMultiprocessorCount, dev) != hipSuccess) { grid = -1; return; }
        if (hipFuncSetAttribute((const void*)fwd_kernel, hipFuncAttributeMaxDynamicSharedMemorySize, LDS_BYTES) != hipSuccess) { fprintf(stderr, "kernel_launch: hipFuncSetAttribute failed\n"); grid = -1; return; }
        if (hipOccupancyMaxActiveBlocksPerMultiprocessor(&per_cu, (const void*)fwd_kernel, NWAVES * 64, LDS_BYTES) != hipSuccess || per_cu < 1) fprintf(stderr, "kernel_launch: occupancy query reports %d\n", per_cu);
        (void)hipGetLastError();
        grid = cus;
        if (grid != 256) fprintf(stderr, "kernel_launch: %d CUs; this kernel is built for 256\n", grid);
    }
    if (grid < 0) return;
    if (hipMemsetAsync((char*)d_ws + WS_CTL, 0, CTL_ZERO_BYTES, stream) != hipSuccess) return;
    Args a{};
    for (int i = 0; i < 23; ++i) a.in[i] = (const float*)d_in[i];
    a.out = (float*)d_out; a.ws = (unsigned char*)d_ws;
#ifndef MK_CUT
#define MK_CUT N_PHASES
#endif
    for (int li = 0; li < N_LAUNCHES; ++li) {
        a.ph_lo = (N_LAUNCHES == 1) ? 0 : li; a.ph_hi = (N_LAUNCHES == 1) ? MK_CUT : li + 1;
        if (a.ph_lo >= MK_CUT) break;
        hipLaunchKernelGGL(fwd_kernel, dim3(grid), dim3(NWAVES * 64), LDS_BYTES, stream, a);
        if (hipPeekAtLastError() != hipSuccess) break;
#ifdef MK_DEBUG_NAN
        { unsigned* flag = (unsigned*)d_ws + 2; unsigned char* w = (unsigned char*)d_ws;
          MK_DEBUG_CHECKS }
#endif
    }
#ifdef MK_DEBUG_NAN
    MK_DEBUG_REPORT
#endif
}
```

```cpp
#include <hip/hip_runtime.h>
#include <cstdio>
#include <cstdint>
#include <cmath>
namespace pg8 {
#define PG8_LAS __attribute__((address_space(3)))
typedef unsigned short bf16_t;
typedef short bf16x8 __attribute__((ext_vector_type(8)));
typedef float f32x4 __attribute__((ext_vector_type(4)));
typedef unsigned u32x4 __attribute__((ext_vector_type(4)));
constexpr int PG8_XROW_OFF = 135168;
constexpr int BM = 256, BK = 64, HALF = 128, HTB = HALF * BK * 2  , STAGE_BYTES = 8 * HTB, NXCD = 8, WGM = 8;

__host__ __device__ __forceinline__ int lds_byte(int r, int c) { const int st = (r >> 4) * 2 + (c >> 5), rr = r & 15, cc = c & 31, ob = rr * 64 + cc * 2; return st * 1024 + (ob ^ (((ob >> 9) & 1) << 5)); }
__host__ __device__ __forceinline__ void stage_rc(int b, int& R, int& C) { const int st = b / 1024, sb = b % 1024, swz = sb ^ (((sb >> 9) & 1) << 5); R = (st >> 1) * 16 + swz / 64; C = (st & 1) * 32 + (swz % 64) / 2; }
__host__ __device__ __forceinline__ int perm32(int rho) { const int n = rho >> 4, i = rho & 15; return 8 * (i >> 2) + 4 * n + (i & 3); }

struct Unit { int pm, pn; };
struct Gemm { const bf16_t* A; const bf16_t* Bt; int M, N, K; int ld; };

struct StaticOrder {
    int nM, nN, nwg, G, c, nx, sk, lim;
    __host__ __device__ void init(int M, int N, int G_, int c_) { nM = M / BM; nN = N / BM; nwg = nM * nN; G = G_; c = c_; nx = 0; sk = 0; lim = 0x7fffffff; }
    __host__ __device__ bool next(int i, Unit& u) const {
        const int ii = i + (c < nx ? sk : 0);
        const long L = ii < sk ? (long)ii * (G - nx) + (c - nx) : (long)sk * (G - nx) + (long)(ii - sk) * G + c; if (L >= nwg || L >= lim) return false;
        unit_at(L, u); return true;
    }
    __host__ __device__ void unit_at(long L, Unit& u) const {
        int wgid = (int)L; { const int q = nwg / NXCD, r = nwg % NXCD, xcd = wgid % NXCD, off = wgid / NXCD; wgid = (xcd < r ? xcd * (q + 1) : r * (q + 1) + (xcd - r) * q) + off; }
        const int nig = WGM * nN, gid = wgid / nig, fm = gid * WGM, gsz = (nM - fm) < WGM ? (nM - fm) : WGM;
        const int rem = wgid - gid * nig;
        if (gsz == WGM) { u.pm = fm + (int)((unsigned)rem & (unsigned)(WGM - 1)); u.pn = (int)((unsigned)rem >> 3); static_assert(WGM == 8, "shift"); }
        else { u.pm = fm + (rem % gsz); u.pn = rem / gsz; }
    }
    __device__ __forceinline__ void a_ready(const Unit&) const {}
    __device__ __forceinline__ void done(const Unit&) const {}
};

__device__ __forceinline__ unsigned cvt_pk_bf16(float lo, float hi) { unsigned r; asm volatile("v_cvt_pk_bf16_f32 %0, %1, %2" : "=v"(r) : "v"(lo), "v"(hi)); return r; }
typedef float f32x2 __attribute__((ext_vector_type(2)));

typedef int v8i_t __attribute__((ext_vector_type(8))); typedef int v4i_t __attribute__((ext_vector_type(4)));
template <class Epi, class Sched, bool ALIGN_EPI = false, bool SP2 = false, bool F8 = false>
__device__ __forceinline__ void gemm_phase(PG8_LAS unsigned char* lds, const Gemm g, const Sched& S, const Epi& E) {
    const int tid = threadIdx.x, wid = __builtin_amdgcn_readfirstlane(tid >> 6), lane = tid & 63, wr = wid >> 2, wc = wid & 3, fr = lane & 15, fq = lane >> 4;
    const int Kp_ = g.ld ? g.ld : g.K; const int K = F8 ? Kp_ / 2 : Kp_, nt = (F8 ? g.K / 2 : g.K) / BK;
    constexpr int NVO = F8 ? 1 : 2;
    unsigned voffA[NVO], voffB[NVO];
#pragma unroll
    for (int i = 0; i < NVO; ++i) { int R, C; stage_rc(tid * 16 + i * 8192, R, C); const int Rb = Epi::PERM ? ((R & ~31) + perm32(R & 31)) : R;
        voffA[i] = (unsigned)(R * K + C) * 2u; voffB[i] = (unsigned)(Rb * K + C) * 2u; }
    const size_t pstep = (size_t)64 * K * 2;
    const size_t kstep = (size_t)(BK * 2);
    const size_t hstep = (size_t)HALF * K * 2;
    const size_t tstep = 2 * hstep;
    const unsigned ldsbase = (unsigned)(uintptr_t)lds;
    const unsigned ldsw = (unsigned)wid * 1024u;
    const unsigned ldsw_s = (unsigned)__builtin_amdgcn_readfirstlane((int)(ldsbase + ldsw));
    const int aoff = lds_byte(wr * 64 + fr, fq * 8), boff = lds_byte(wc * 32 + fr, fq * 8);
#define PG8_SA(b, h) (((b) * 2 + (h)) * HTB)
#define PG8_SB(b, h) ((4 + (b) * 2 + (h)) * HTB)
#define PG8_STAGE(bufoff, gbase, voff) do { _Pragma("unroll") for (int _i = 0; _i < 2; ++_i) { \
        const unsigned long long gb_ = (unsigned long long)(gbase) + (unsigned long long)((F8 && _i) ? pstep : (size_t)0); const unsigned long long ub_ = ((unsigned long long)(unsigned)__builtin_amdgcn_readfirstlane((int)(gb_ >> 32)) << 32) | (unsigned)__builtin_amdgcn_readfirstlane((int)gb_); \
        asm volatile("s_add_i32 m0, %2, %3\n\ts_nop 0\n\tglobal_load_lds_dwordx4 %0, %1" : : "v"((voff)[F8 ? 0 : _i]), "s"(ub_), "s"(ldsw_s), "i"((int)(bufoff) + _i * 8192) : "memory", "scc"); } } while (0)
#define PG8_LDA(dst, b, h) do { _Pragma("unroll") for (int m = 0; m < 4; ++m) _Pragma("unroll") for (int k = 0; k < 2; ++k) dst[m][k] = *(const PG8_LAS bf16x8*)(lds + PG8_SA(b, h) + aoff + m * 2048 + k * 1024); } while (0)
#define PG8_LDB(dst, b, h) do { _Pragma("unroll") for (int n = 0; n < 2; ++n) _Pragma("unroll") for (int k = 0; k < 2; ++k) dst[n][k] = *(const PG8_LAS bf16x8*)(lds + PG8_SB(b, h) + boff + n * 2048 + k * 1024); } while (0)
#define PG8_MMA(ai, bj, At, Bt) do { __builtin_amdgcn_s_setprio(1); _Pragma("unroll") for (int m = 0; m < 4; ++m) _Pragma("unroll") for (int n = 0; n < 2; ++n) _Pragma("unroll") for (int k = 0; k < 2; ++k) \
        acc[ai][bj][m][n] = __builtin_amdgcn_mfma_f32_16x16x32_bf16(Bt[n][k], At[m][k], acc[ai][bj][m][n], 0, 0, 0); __builtin_amdgcn_s_setprio(0); } while (0)
#define PG8_MMA8(ai, bj, At, Bt) do { __builtin_amdgcn_s_setprio(1); _Pragma("unroll") for (int m = 0; m < 4; ++m) _Pragma("unroll") for (int n = 0; n < 2; ++n) \
        acc[ai][bj][m][n] = __builtin_amdgcn_mfma_scale_f32_16x16x128_f8f6f4(__builtin_shufflevector(__builtin_bit_cast(v4i_t, Bt[n][0]), __builtin_bit_cast(v4i_t, Bt[n][1]), 0, 1, 2, 3, 4, 5, 6, 7), \
            __builtin_shufflevector(__builtin_bit_cast(v4i_t, At[m][0]), __builtin_bit_cast(v4i_t, At[m][1]), 0, 1, 2, 3, 4, 5, 6, 7), acc[ai][bj][m][n], 0, 0, 0, 0, 0, 0); __builtin_amdgcn_s_setprio(0); } while (0)
#define PG8_MM(ai, bj, At, Bt) do { if constexpr (F8) PG8_MMA8(ai, bj, At, Bt); else PG8_MMA(ai, bj, At, Bt); } while (0)
#define PG8_WAIT_V(n) asm volatile("s_waitcnt vmcnt(" #n ")" ::: "memory")
#define PG8_WAIT_L(n) asm volatile("s_waitcnt lgkmcnt(" #n ")" ::: "memory")
#define PG8_BAR __builtin_amdgcn_s_barrier()
#define PG8_SCHED __builtin_amdgcn_sched_barrier(0)
#ifdef MK_GEMM_PROF
    unsigned long long gprof_[3] = {0, 0, 0}, gprev_ = 0;
#endif
    Unit cur, nxt; int ui = 0;
    if (!S.next(0, cur)) return;
    f32x4 acc[2][2][4][2];
#pragma unroll
    for (int a = 0; a < 2; ++a)
#pragma unroll
        for (int b = 0; b < 2; ++b)
#pragma unroll
            for (int m = 0; m < 4; ++m)
#pragma unroll
                for (int n = 0; n < 2; ++n) { acc[a][b][m][n] = (f32x4){0.f, 0.f, 0.f, 0.f}; if constexpr (F8) asm volatile("" : "+v"(acc[a][b][m][n])); }
    bf16x8 At[4][2], B0[2][2], B1[2][2];
    const char* cA = (const char*)g.A + (size_t)cur.pm * tstep; const char* cB = (const char*)g.Bt + (size_t)cur.pn * tstep;
    S.a_ready(cur);
    if constexpr (SP2) {
        PG8_STAGE(PG8_SB(0, 0), cB, voffB); PG8_STAGE(PG8_SB(0, 1), cB + hstep, voffB); PG8_STAGE(PG8_SA(0, 0), cA, voffA); PG8_STAGE(PG8_SA(0, 1), cA + hstep, voffA);
        if (wr == 1) PG8_BAR;
        PG8_WAIT_V(2); PG8_BAR;
        PG8_STAGE(PG8_SB(1, 0), cB + kstep, voffB); PG8_STAGE(PG8_SA(1, 0), cA + kstep, voffA); PG8_STAGE(PG8_SB(1, 1), cB + hstep + kstep, voffB);
        PG8_WAIT_V(6); PG8_BAR;
    } else {
        PG8_STAGE(PG8_SB(0, 0), cB, voffB); PG8_STAGE(PG8_SA(0, 0), cA, voffA); PG8_STAGE(PG8_SB(0, 1), cB + hstep, voffB); PG8_STAGE(PG8_SA(0, 1), cA + hstep, voffA);
        if (wr == 1) PG8_BAR;
        PG8_WAIT_V(4); PG8_BAR;
        PG8_STAGE(PG8_SB(1, 0), cB + kstep, voffB); PG8_STAGE(PG8_SA(1, 0), cA + kstep, voffA); PG8_STAGE(PG8_SB(1, 1), cB + hstep + kstep, voffB);
        PG8_WAIT_V(6); PG8_BAR;
    }
    for (;;) {
        const bool has_next = S.next(ui + 1, nxt);
#ifdef MK_GEMM_PROF
        unsigned long long gt0_ = 0; if constexpr (Epi::PROF) { gt0_ = __builtin_amdgcn_s_memtime(); if (gprev_) gprof_[2] += gt0_ - gprev_; }
#endif
        typename Epi::Pre pre; E.prefetch(pre, cur, wr, fr);
        if constexpr (Epi::NROWDMA > 0) { if (wid < 4 * Epi::NROWDMA) { unsigned keep_; const unsigned long long gb_ = (unsigned long long)E.row_src(wid >> 2, cur);
            const unsigned long long ub_ = ((unsigned long long)(unsigned)__builtin_amdgcn_readfirstlane((int)(gb_ >> 32)) << 32) | (unsigned)__builtin_amdgcn_readfirstlane((int)gb_);
            asm volatile("s_mov_b32 %0, m0\n\ts_mov_b32 m0, %3\n\ts_nop 0\n\tglobal_load_lds_dword %1, %2\n\ts_mov_b32 m0, %0" : "=&s"(keep_) : "v"((unsigned)((tid & 255) * 4)), "s"(ub_),
                "s"((unsigned)__builtin_amdgcn_readfirstlane((int)(ldsbase + PG8_XROW_OFF + (unsigned)(ui & 1) * 2048u + (unsigned)wid * 256u))) : "memory"); } }
        const char* nA = has_next ? (const char*)g.A + (size_t)nxt.pm * tstep : cA; const char* nB = has_next ? (const char*)g.Bt + (size_t)nxt.pn * tstep : cB;
        for (int t = 0; t < nt; t += 2) {
            const bool last = (t == nt - 2);
            const char* a1 = cA + (size_t)(t + 1) * kstep;
            const char* a2 = last ? nA : cA + (size_t)(t + 2) * kstep; const char* b2 = last ? nB : cB + (size_t)(t + 2) * kstep;
            const char* a3 = a2 + kstep; const char* b3 = b2 + kstep;
            if (last && has_next) S.a_ready(nxt);
            if constexpr (SP2) {
            PG8_LDB(B0, 0, 0); PG8_LDB(B1, 0, 1); PG8_SCHED; PG8_LDA(At, 0, 0); PG8_STAGE(PG8_SA(1, 1), a1 + hstep, voffA);
            PG8_WAIT_V(8); PG8_WAIT_L(0); PG8_BAR; PG8_MM(0, 0, At, B0); PG8_MM(0, 1, At, B1); PG8_BAR; PG8_SCHED;
            PG8_LDA(At, 0, 1); PG8_STAGE(PG8_SB(0, 0), b2, voffB); PG8_STAGE(PG8_SB(0, 1), b2 + hstep, voffB); PG8_STAGE(PG8_SA(0, 0), a2, voffA);
            PG8_WAIT_V(8); PG8_WAIT_L(0); PG8_BAR; PG8_MM(1, 0, At, B0); PG8_MM(1, 1, At, B1); PG8_BAR; PG8_SCHED;
            PG8_LDB(B0, 1, 0); PG8_LDB(B1, 1, 1); PG8_SCHED; PG8_LDA(At, 1, 0); PG8_STAGE(PG8_SA(0, 1), a2 + hstep, voffA);
            PG8_WAIT_V(8); PG8_WAIT_L(0); PG8_BAR; PG8_MM(0, 0, At, B0); PG8_MM(0, 1, At, B1); PG8_BAR; PG8_SCHED;
            PG8_LDA(At, 1, 1); PG8_STAGE(PG8_SB(1, 0), b3, voffB); PG8_STAGE(PG8_SB(1, 1), b3 + hstep, voffB); PG8_STAGE(PG8_SA(1, 0), a3, voffA);
            PG8_WAIT_V(8); PG8_WAIT_L(0); PG8_BAR; PG8_MM(1, 0, At, B0); PG8_MM(1, 1, At, B1); PG8_BAR; PG8_SCHED;
            } else {
            PG8_LDB(B0, 0, 0); PG8_SCHED; PG8_LDA(At, 0, 0); PG8_STAGE(PG8_SA(1, 1), a1 + hstep, voffA);
            PG8_WAIT_L(8); PG8_BAR; PG8_WAIT_L(0); PG8_MM(0, 0, At, B0); PG8_BAR; PG8_SCHED;
            PG8_LDB(B1, 0, 1); PG8_STAGE(PG8_SB(0, 0), b2, voffB);
            PG8_BAR; PG8_WAIT_L(0); PG8_MM(0, 1, At, B1); PG8_BAR;
            PG8_LDA(At, 0, 1); PG8_STAGE(PG8_SA(0, 0), a2, voffA);
            PG8_BAR; PG8_WAIT_L(0); PG8_MM(1, 0, At, B0); PG8_BAR; PG8_SCHED;
            PG8_STAGE(PG8_SB(0, 1), b2 + hstep, voffB);
            PG8_WAIT_V(6); PG8_BAR; PG8_MM(1, 1, At, B1); PG8_BAR;
            PG8_LDB(B0, 1, 0); PG8_SCHED; PG8_LDA(At, 1, 0); PG8_STAGE(PG8_SA(0, 1), a2 + hstep, voffA);
            PG8_WAIT_L(8); PG8_BAR; PG8_WAIT_L(0); PG8_MM(0, 0, At, B0); PG8_BAR; PG8_SCHED;
            PG8_LDB(B1, 1, 1); PG8_STAGE(PG8_SB(1, 0), b3, voffB);
            PG8_BAR; PG8_WAIT_L(0); PG8_MM(0, 1, At, B1); PG8_BAR;
            PG8_LDA(At, 1, 1); PG8_STAGE(PG8_SA(1, 0), a3, voffA);
            PG8_BAR; PG8_WAIT_L(0); PG8_MM(1, 0, At, B0); PG8_BAR; PG8_SCHED;
            PG8_STAGE(PG8_SB(1, 1), b3 + hstep, voffB);
            PG8_WAIT_V(6); PG8_BAR; PG8_MM(1, 1, At, B1); PG8_BAR;
            }
        }
#ifdef MK_GEMM_PROF
        unsigned long long gt1_ = 0; if constexpr (Epi::PROF) { gt1_ = __builtin_amdgcn_s_memtime(); gprof_[0] += gt1_ - gt0_; }
#endif
        if constexpr (ALIGN_EPI) { if (wr == 0) PG8_BAR; }
        if constexpr (!Epi::AFTER_DRAIN) { E(acc, cur, wr, wc, fr, fq, pre, (const PG8_LAS unsigned*)(lds + PG8_XROW_OFF + (ui & 1) * 2048)); S.done(cur); }
#ifdef MK_GEMM_PROF
        if constexpr (Epi::PROF) { gprev_ = __builtin_amdgcn_s_memtime(); gprof_[1] += gprev_ - gt1_; }
#endif
        if (!has_next) break;
#pragma unroll
        for (int a = 0; a < 2; ++a)
#pragma unroll
            for (int b = 0; b < 2; ++b)
#pragma unroll
                for (int m = 0; m < 4; ++m)
#pragma unroll
                    for (int n = 0; n < 2; ++n) { acc[a][b][m][n] = (f32x4){0.f, 0.f, 0.f, 0.f}; if constexpr (F8) asm volatile("" : "+v"(acc[a][b][m][n])); }
        cur = nxt; cA = nA; cB = nB; ++ui;
        if constexpr (ALIGN_EPI) { if (wr == 1) PG8_BAR; }
    }
#ifdef MK_GEMM_PROF
    if constexpr (Epi::PROF) { if (threadIdx.x == 0) { unsigned long long* g_ = (unsigned long long*)E.profbuf(); atomicAdd(g_ + 0, gprof_[0]); atomicAdd(g_ + 1, gprof_[1]); atomicAdd(g_ + 2, gprof_[2]); } }
#endif
    PG8_WAIT_V(0);
    if constexpr (!ALIGN_EPI) { if (wr == 0) PG8_BAR; }
    PG8_BAR;
    if constexpr (Epi::AFTER_DRAIN) { E.fused(acc, cur, wr, wc, fr, fq, lds, wid, lane); S.done(cur); }
#undef PG8_SA
#undef PG8_SB
#undef PG8_STAGE
#undef PG8_LDA
#undef PG8_LDB
#undef PG8_MMA
#undef PG8_MMA8
#undef PG8_MM
#undef PG8_WAIT_V
#undef PG8_WAIT_L
#undef PG8_BAR
#undef PG8_SCHED
}
}
namespace pg8 {
constexpr float LOG2E = 1.4426950408889634f;
constexpr float NORM_EPS = 1e-6f;
__device__ __forceinline__ float fast_exp2(float x) { return __builtin_amdgcn_exp2f(x); }
__device__ __forceinline__ float fast_rcp(float x) { return __builtin_amdgcn_rcpf(x); }
__device__ __forceinline__ float fast_rsq(float x) { return __builtin_amdgcn_rsqf(x); }
__device__ __forceinline__ float silu_f(float v) { return v * fast_rcp(1.f + fast_exp2(-LOG2E * v)); }
__device__ __forceinline__ float sigm_f(float v) { return fast_rcp(1.f + fast_exp2(-LOG2E * v)); }
__device__ __forceinline__ float st_rscale(const unsigned long long* st, int row) { return fast_rsq((float)st[row] * (1.f / (16777216.f * 1024.f)) + NORM_EPS); }
typedef float f32x2e __attribute__((ext_vector_type(2))); typedef __bf16 bf16x2e __attribute__((ext_vector_type(2)));
__device__ __forceinline__ unsigned cvt2(float lo, float hi) { f32x2e v = {lo, hi}; bf16x2e b = __builtin_convertvector(v, bf16x2e); return __builtin_bit_cast(unsigned, b); }
constexpr float A8S = 8.f, W8S = 256.f, ACC8 = 1.f / (A8S * W8S);
__device__ __forceinline__ float clamp8(float v) { return __builtin_amdgcn_fmed3f(v, -448.f, 448.f); }
__device__ __forceinline__ unsigned pk_fp8x4(float a, float b, float c, float d) { int w = __builtin_amdgcn_cvt_pk_fp8_f32(clamp8(a), clamp8(b), 0, false); w = __builtin_amdgcn_cvt_pk_fp8_f32(clamp8(c), clamp8(d), w, true); return (unsigned)w; }
typedef unsigned u32x2e __attribute__((ext_vector_type(2)));
__device__ __forceinline__ u32x2e pack8_fp8(const f32x4& a, const f32x4& b, float s) { u32x2e w; w.x = pk_fp8x4(a[0] * s, a[1] * s, a[2] * s, a[3] * s); w.y = pk_fp8x4(b[0] * s, b[1] * s, b[2] * s, b[3] * s); return w; }
__device__ __forceinline__ u32x4 pack8(const f32x4& a, const f32x4& b) { u32x4 w; w.x = cvt2(a[0], a[1]); w.y = cvt2(a[2], a[3]); w.z = cvt2(b[0], b[1]); w.w = cvt2(b[2], b[3]); return w; }

#define PG8_DPP_SHR1(x, n) __builtin_bit_cast(float, __builtin_amdgcn_update_dpp(0x3f800000, __builtin_bit_cast(int, (x)), 0x110 + (n), 0xf, 0xf, false))
#define PG8_DPP_SHR(x, n) __builtin_bit_cast(float, __builtin_amdgcn_update_dpp(0, __builtin_bit_cast(int, (x)), 0x110 + (n), 0xf, 0xf, true))
struct EpiHgrnIn {
    static constexpr bool PERM = true, AFTER_DRAIN = false, PROF = false; static constexpr int NROWDMA = 0;
    bf16_t* O; const float* st; const float* lb; float* dend;
    struct Pre { float s[2][4]; };
    __device__ __forceinline__ void prefetch(Pre& p, const Unit& u, int wr, int fr) const {
        const int row0 = u.pm * BM + wr * 64 + fr;
#pragma unroll
        for (int ai = 0; ai < 2; ++ai)
#pragma unroll
            for (int m = 0; m < 4; ++m) p.s[ai][m] = st[row0 + ai * HALF + m * 16];
    }
    __device__ __forceinline__ void operator()(const f32x4 (&acc)[2][2][4][2], const Unit& u, int wr, int wc, int fr, int fq, const Pre& pre, const PG8_LAS unsigned* xrow) const {
        const int row0 = u.pm * BM + wr * 64 + fr;
        float rsc[2][4];
#pragma unroll
        for (int ai = 0; ai < 2; ++ai)
#pragma unroll
            for (int m = 0; m < 4; ++m) rsc[ai][m] = fast_rsq(pre.s[ai][m] * (1.f / 1024.f) + NORM_EPS);
        if (u.pn < 8) {
            const int cq = 128 * u.pn + wc * 32 + 8 * fq;
            const int lane15 = ((int)(threadIdx.x & 48u)) | 15;
#pragma unroll
            for (int n = 0; n < 2; ++n) {
                const f32x4 lbv = *(const f32x4*)(lb + cq + 4 * n);
#pragma unroll
                for (int ai = 0; ai < 2; ++ai) {
                    f32x4 qv[4], kv[4]; f32x4 tot4;
#pragma unroll
                    for (int jp = 0; jp < 2; ++jp) {
                        const f32x2e l = {lbv[2 * jp], lbv[2 * jp + 1]}, oml = 1.f - l; f32x2e pf[4], om[4];
#pragma unroll
                        for (int m = 0; m < 4; ++m) {
                            const f32x2e fa = {acc[ai][1][m][n][2 * jp], acc[ai][1][m][n][2 * jp + 1]};
                            const f32x2e t = fa * (rsc[ai][m] * -LOG2E);
                            const f32x2e ex = {fminf(fast_exp2(t.x), 1e30f), fminf(fast_exp2(t.y), 1e30f)};
                            const f32x2e d = ex + 1.f;
                            const f32x2e sg = {fast_rcp(d.x), fast_rcp(d.y)};
                            om[m] = (oml * ex) * sg;
                            pf[m] = l + oml * sg;
                        }
#define PG8_PPSTEP(N) "v_mul_f32_dpp %0, %0, %0 row_shr:" #N " row_mask:0xf bank_mask:0xf\n v_mul_f32_dpp %1, %1, %1 row_shr:" #N " row_mask:0xf bank_mask:0xf\n v_mul_f32_dpp %2, %2, %2 row_shr:" #N " row_mask:0xf bank_mask:0xf\n v_mul_f32_dpp %3, %3, %3 row_shr:" #N " row_mask:0xf bank_mask:0xf\n" \
                      "v_mul_f32_dpp %4, %4, %4 row_shr:" #N " row_mask:0xf bank_mask:0xf\n v_mul_f32_dpp %5, %5, %5 row_shr:" #N " row_mask:0xf bank_mask:0xf\n v_mul_f32_dpp %6, %6, %6 row_shr:" #N " row_mask:0xf bank_mask:0xf\n v_mul_f32_dpp %7, %7, %7 row_shr:" #N " row_mask:0xf bank_mask:0xf\n"
                        { float p0 = pf[0].x, p1 = pf[0].y, p2 = pf[1].x, p3 = pf[1].y, p4 = pf[2].x, p5 = pf[2].y, p6 = pf[3].x, p7 = pf[3].y;
                          asm("s_nop 1\n" PG8_PPSTEP(1) PG8_PPSTEP(2) PG8_PPSTEP(4) PG8_PPSTEP(8) "s_nop 1\n" : "+v"(p0), "+v"(p1), "+v"(p2), "+v"(p3), "+v"(p4), "+v"(p5), "+v"(p6), "+v"(p7));
                          pf[0] = (f32x2e){p0, p1}; pf[1] = (f32x2e){p2, p3}; pf[2] = (f32x2e){p4, p5}; pf[3] = (f32x2e){p6, p7}; }
#undef PG8_PPSTEP
                        f32x2e off = {1.f, 1.f};
#pragma unroll
                        for (int m = 0; m < 4; ++m) {
                            const f32x2e t = {__shfl(pf[m].x, lane15), __shfl(pf[m].y, lane15)};
                            f32x2e F = pf[m] * off; off = off * t; F.x = fmaxf(F.x, 1e-36f); F.y = fmaxf(F.y, 1e-36f);
                            const f32x2e qa = {acc[ai][0][m][n][2 * jp], acc[ai][0][m][n][2 * jp + 1]};
                            const f32x2e tq = qa * (rsc[ai][m] * -LOG2E);
                            const f32x2e dq = (f32x2e){fast_exp2(tq.x), fast_exp2(tq.y)} + 1.f;
                            const f32x2e rq = {fast_rcp(dq.x), fast_rcp(dq.y)}, rF = {fast_rcp(F.x), fast_rcp(F.y)};
                            const f32x2e qo = ((qa * rsc[ai][m]) * F) * rq, ko = om[m] * rF;
                            qv[m][2 * jp] = qo.x; qv[m][2 * jp + 1] = qo.y; kv[m][2 * jp] = ko.x; kv[m][2 * jp + 1] = ko.y;
                        }
                        tot4[2 * jp] = fmaxf(off.x, 1e-36f); tot4[2 * jp + 1] = fmaxf(off.y, 1e-36f);
                    }
#pragma unroll
                    for (int m = 0; m < 4; ++m) {
                        bf16_t* rowp = O + (size_t)(row0 + ai * HALF + m * 16) * 4096 + cq + 4 * n;
                        u32x2e wq, wk; wq.x = cvt2(qv[m][0], qv[m][1]); wq.y = cvt2(qv[m][2], qv[m][3]); wk.x = cvt2(kv[m][0], kv[m][1]); wk.y = cvt2(kv[m][2], kv[m][3]);
                        *(u32x2e*)rowp = wq; *(u32x2e*)(rowp + 1024) = wk;
                    }
                    if (fr == 15) *(f32x4*)(dend + (size_t)(u.pm * 4 + ai * 2 + wr) * 1024 + cq + 4 * n) = tot4;
                }
            }
        } else {
            const int type = u.pn >> 2, col0 = u.pn * BM + wc * 32 + 8 * fq;
#pragma unroll
            for (int ai = 0; ai < 2; ++ai)
#pragma unroll
                for (int m = 0; m < 4; ++m) {
                    const int row = row0 + ai * HALF + m * 16; const float r = rsc[ai][m];
                    bf16_t* rowp = O + (size_t)row * 4096 + col0;
#pragma unroll
                    for (int bj = 0; bj < 2; ++bj) {
                        f32x4 v[2];
#pragma unroll
                        for (int n = 0; n < 2; ++n) {
                            v[n] = acc[ai][bj][m][n] * r;
                            if (type == 3) {
#pragma unroll
                                for (int jp = 0; jp < 2; ++jp) { const f32x2e x = {v[n][2 * jp], v[n][2 * jp + 1]}; const f32x2e t = x * -LOG2E;
                                    const f32x2e d = (f32x2e){fast_exp2(t.x), fast_exp2(t.y)} + 1.f; const f32x2e y = x * (f32x2e){fast_rcp(d.x), fast_rcp(d.y)}; v[n][2 * jp] = y.x; v[n][2 * jp + 1] = y.y; }
                            }
                        }
                        *(u32x4*)(rowp + bj * HALF) = pack8(v[0], v[1]);
                    }
                }
        }
    }
};

template <bool RES32> struct EpiRes {
    static constexpr bool PERM = true, AFTER_DRAIN = false, PROF = false; static constexpr int NROWDMA = 0;
    const float* res; bf16_t* ob; unsigned long long* st; float asc;
    struct Pre {}; __device__ __forceinline__ void prefetch(Pre&, const Unit&, int, int) const {}
    __device__ __forceinline__ void operator()(const f32x4 (&acc)[2][2][4][2], const Unit& u, int wr, int wc, int fr, int fq, const Pre&, const PG8_LAS unsigned* xrow) const {
        const int row0 = u.pm * BM + wr * 64 + fr, col0 = u.pn * BM + wc * 32 + 8 * fq;
#pragma unroll
        for (int ai = 0; ai < 2; ++ai)
#pragma unroll
            for (int m = 0; m < 4; ++m) {
                const int row = row0 + ai * HALF + m * 16; const size_t off = (size_t)row * 1024 + col0;
                float ss = 0.f;
#pragma unroll
                for (int bj = 0; bj < 2; ++bj) {
                    f32x4 r0, r1;
                    if constexpr (RES32) { r0 = *(const f32x4*)(res + off + bj * HALF); r1 = *(const f32x4*)(res + off + bj * HALF + 4); }
                    else { const u32x4 w = *(const u32x4*)(ob + off + bj * HALF);
                        r0 = (f32x4){__builtin_bit_cast(float, w.x << 16), __builtin_bit_cast(float, w.x & 0xffff0000u), __builtin_bit_cast(float, w.y << 16), __builtin_bit_cast(float, w.y & 0xffff0000u)};
                        r1 = (f32x4){__builtin_bit_cast(float, w.z << 16), __builtin_bit_cast(float, w.z & 0xffff0000u), __builtin_bit_cast(float, w.w << 16), __builtin_bit_cast(float, w.w & 0xffff0000u)}; }
                    const f32x4 v0 = acc[ai][bj][m][0] * asc + r0, v1 = acc[ai][bj][m][1] * asc + r1;
                    *(u32x4*)(ob + off + bj * HALF) = pack8(v0, v1);
                    ss += (v0[0] * v0[0] + v0[1] * v0[1]) + (v0[2] * v0[2] + v0[3] * v0[3]) + (v1[0] * v1[0] + v1[1] * v1[1]) + (v1[2] * v1[2] + v1[3] * v1[3]);
                }
                ss += __shfl_xor(ss, 16); ss += __shfl_xor(ss, 32);
                if (fq == 0) __hip_atomic_fetch_add(st + row, (unsigned long long)(ss * 16777216.f + 0.5f), __ATOMIC_RELAXED, __HIP_MEMORY_SCOPE_AGENT);
            }
    }
};

template <bool OUT8, bool PREF = true> struct EpiSwiGLU {
    static constexpr bool PERM = true, AFTER_DRAIN = false, PROF = !PREF; static constexpr int NROWDMA = PREF ? 0 : 1; void* pb; __device__ __forceinline__ void* profbuf() const { return pb; }
    __device__ __forceinline__ const void* row_src(int, const Unit& u) const { return sc + (size_t)u.pm * BM; }
    bf16_t* O; int ldc; const unsigned long long* st; const float* sc; int nNloc; float rs;
    struct Pre { float s[2][4]; };
    __device__ __forceinline__ void prefetch(Pre& p, const Unit& u, int wr, int fr) const {
        const int row0 = u.pm * BM + wr * 64 + fr;
#pragma unroll
        for (int ai = 0; ai < 2; ++ai)
#pragma unroll
            for (int m = 0; m < 4; ++m) { const int row = row0 + ai * HALF + m * 16; p.s[ai][m] = PREF ? (sc ? sc[row] : (float)st[row]) : 0.f; }
    }
    __device__ __forceinline__ void operator()(const f32x4 (&acc)[2][2][4][2], const Unit& u, int wr, int wc, int fr, int fq, const Pre& pre, const PG8_LAS unsigned* xrow) const {
        const int row0 = u.pm * BM + wr * 64 + fr, col0 = (u.pn % nNloc) * HALF + wc * 32 + 8 * fq;
        float rsc[2][4];
#pragma unroll
        for (int ai = 0; ai < 2; ++ai)
#pragma unroll
            for (int m = 0; m < 4; ++m) { const int row = row0 + ai * HALF + m * 16; rsc[ai][m] = PREF ? pre.s[ai][m] : __builtin_bit_cast(float, xrow[row - u.pm * BM]); }
#pragma unroll
        for (int ai = 0; ai < 2; ++ai)
#pragma unroll
            for (int m = 0; m < 4; ++m) {
                const int row = row0 + ai * HALF + m * 16;
                const float r = (sc ? rsc[ai][m] : fast_rsq(rsc[ai][m] * (1.f / (16777216.f * 1024.f)) + NORM_EPS)) * rs;
                const float rn = -LOG2E * r, cinv = fast_rcp(r * r * (OUT8 ? A8S : 1.f));
                f32x4 h[2];
#pragma unroll
                for (int n = 0; n < 2; ++n)
#pragma unroll
                    for (int jp = 0; jp < 2; ++jp) {
                        const f32x2e g = {acc[ai][0][m][n][2 * jp], acc[ai][0][m][n][2 * jp + 1]}, uu = {acc[ai][1][m][n][2 * jp], acc[ai][1][m][n][2 * jp + 1]};
                        const f32x2e t = g * rn;
                        const f32x2e d = (f32x2e){fast_exp2(t.x), fast_exp2(t.y)} * cinv + cinv;
                        const f32x2e q = {fast_rcp(d.x), fast_rcp(d.y)};
                        const f32x2e hv = (g * uu) * q;
                        h[n][2 * jp] = hv.x; h[n][2 * jp + 1] = hv.y; }
                if constexpr (OUT8) { u32x2e w; w.x = pk_fp8x4(h[0][0], h[0][1], h[0][2], h[0][3]); w.y = pk_fp8x4(h[1][0], h[1][1], h[1][2], h[1][3]); *(u32x2e*)((unsigned char*)O + (size_t)row * ldc + col0) = w; }
                else *(u32x4*)(O + (size_t)row * ldc + col0) = pack8(h[0], h[1]);
            }
    }
};

struct EpiQKV {
    static constexpr bool PERM = true, AFTER_DRAIN = false, PROF = false; static constexpr int NROWDMA = 0;
    bf16_t* O; const unsigned long long* st; const float* qg; const float* kg;
    struct Pre { float s[2][4]; };
    __device__ __forceinline__ void prefetch(Pre& p, const Unit& u, int wr, int fr) const {
        const int row0 = u.pm * BM + wr * 64 + fr;
#pragma unroll
        for (int ai = 0; ai < 2; ++ai)
#pragma unroll
            for (int m = 0; m < 4; ++m) p.s[ai][m] = (float)st[row0 + ai * HALF + m * 16];
    }
    __device__ __forceinline__ void operator()(const f32x4 (&acc)[2][2][4][2], const Unit& u, int wr, int wc, int fr, int fq, const Pre& pre, const PG8_LAS unsigned* xrow) const {
        const int row0 = u.pm * BM + wr * 64 + fr, type = u.pn >> 2, lc0 = u.pn * BM + 64 * wc + 8 * fq;
        const float* gp = (type == 0) ? qg : kg;
        f32x4 gv[2][2];
#pragma unroll
        for (int bj = 0; bj < 2; ++bj)
#pragma unroll
            for (int n = 0; n < 2; ++n) gv[bj][n] = (type < 2) ? *(const f32x4*)(gp + 32 * bj + 8 * fq + 4 * n) : (f32x4){1.f, 1.f, 1.f, 1.f};
        const float qs = (type == 0) ? 0.125f * LOG2E : 1.f;
        float rsc[2][4];
#pragma unroll
        for (int ai = 0; ai < 2; ++ai)
#pragma unroll
            for (int m = 0; m < 4; ++m) rsc[ai][m] = pre.s[ai][m];
#pragma unroll
        for (int ai = 0; ai < 2; ++ai)
#pragma unroll
            for (int m = 0; m < 4; ++m) {
                const int row = row0 + ai * HALF + m * 16;
                const float r = fast_rsq(rsc[ai][m] * (1.f / (16777216.f * 1024.f)) + NORM_EPS);
                f32x4 v[2][2]; float ss = 0.f;
#pragma unroll
                for (int bj = 0; bj < 2; ++bj)
#pragma unroll
                    for (int n = 0; n < 2; ++n) { v[bj][n] = acc[ai][bj][m][n] * r; const f32x4 x = v[bj][n]; ss += (x[0] * x[0] + x[1] * x[1]) + (x[2] * x[2] + x[3] * x[3]); }
                if (type < 2) {
                    ss += __shfl_xor(ss, 16); ss += __shfl_xor(ss, 32);
                    const float rr = fast_rsq(ss * (1.f / 64.f) + NORM_EPS) * qs;
#pragma unroll
                    for (int bj = 0; bj < 2; ++bj)
#pragma unroll
                        for (int n = 0; n < 2; ++n) v[bj][n] = v[bj][n] * gv[bj][n] * rr;
                }
#pragma unroll
                for (int bj = 0; bj < 2; ++bj) *(u32x4*)(O + (size_t)row * 3072 + lc0 + 32 * bj) = pack8(v[bj][0], v[bj][1]);
            }
    }
};

template <bool FINAL> struct EpiMoeDown {
    static constexpr bool PERM = true, AFTER_DRAIN = false, PROF = false; static constexpr int NROWDMA = 2;
    __device__ __forceinline__ const void* row_src(int k, const Unit& u) const { return k == 0 ? (const void*)(s2t + (size_t)u.pm * BM) : (const void*)(sg + (size_t)u.pm * BM); }
    float* out; bf16_t* hb; const int* s2t; const float* sg; int nNloc;
    struct Pre {}; __device__ __forceinline__ void prefetch(Pre&, const Unit&, int, int) const {}
    __device__ __forceinline__ void operator()(const f32x4 (&acc)[2][2][4][2], const Unit& u, int wr, int wc, int fr, int fq, const Pre&, const PG8_LAS unsigned* xrow) const {
        const int row0 = u.pm * BM + wr * 64 + fr, col0 = (u.pn % nNloc) * BM + wc * 32 + 8 * fq;
#pragma unroll
        for (int ai = 0; ai < 2; ++ai) {
            int tk[4]; float gt[4];
#pragma unroll
            for (int m = 0; m < 4; ++m) { const int r = wr * 64 + fr + ai * HALF + m * 16; tk[m] = (int)xrow[r]; gt[m] = __builtin_bit_cast(float, xrow[256 + r]); }
#pragma unroll
            for (int m = 0; m < 4; ++m) {
                const int tok = tk[m];
                if (tok >= 0) {
                    const float g = gt[m] * ACC8; const size_t off = (size_t)tok * 1024 + col0;
#pragma unroll
                    for (int bj = 0; bj < 2; ++bj) {
                        const u32x4 w = *(const u32x4*)(hb + off + bj * HALF);
                        const f32x4 r0 = (f32x4){__builtin_bit_cast(float, w.x << 16), __builtin_bit_cast(float, w.x & 0xffff0000u), __builtin_bit_cast(float, w.y << 16), __builtin_bit_cast(float, w.y & 0xffff0000u)};
                        const f32x4 r1 = (f32x4){__builtin_bit_cast(float, w.z << 16), __builtin_bit_cast(float, w.z & 0xffff0000u), __builtin_bit_cast(float, w.w << 16), __builtin_bit_cast(float, w.w & 0xffff0000u)};
                        const f32x4 v0 = acc[ai][bj][m][0] * g + r0, v1 = acc[ai][bj][m][1] * g + r1;
                        if constexpr (FINAL) { *(f32x4*)(out + off + bj * HALF) = v0; *(f32x4*)(out + off + bj * HALF + 4) = v1; }
                        else *(u32x4*)(hb + off + bj * HALF) = pack8(v0, v1);
                    }
                }
            }
        }
    }
};

struct GroupedOrder {
    StaticOrder so; int r1, r2, r3, r4, r5, r6, r7; int nNloc;
    __device__ __forceinline__ void init(const int* rts_, int nNloc_, int G, int c) { nNloc = nNloc_;
        r1 = __builtin_amdgcn_readfirstlane(rts_[1]); r2 = __builtin_amdgcn_readfirstlane(rts_[2]); r3 = __builtin_amdgcn_readfirstlane(rts_[3]); r4 = __builtin_amdgcn_readfirstlane(rts_[4]);
        r5 = __builtin_amdgcn_readfirstlane(rts_[5]); r6 = __builtin_amdgcn_readfirstlane(rts_[6]); r7 = __builtin_amdgcn_readfirstlane(rts_[7]);
        so.init(__builtin_amdgcn_readfirstlane(rts_[8]) * BM, nNloc_ * BM, G, c); }
    __device__ __forceinline__ void unit_at_v(long L, Unit& u) const { so.unit_at(L, u); const int pm = u.pm;
        const int e = (pm >= r1) + (pm >= r2) + (pm >= r3) + (pm >= r4) + (pm >= r5) + (pm >= r6) + (pm >= r7); u.pn += e * nNloc; }
    __device__ __forceinline__ void unit_at(long L, Unit& u) const { so.unit_at(L, u); const int pm = u.pm;
        const int e = (pm >= r1) + (pm >= r2) + (pm >= r3) + (pm >= r4) + (pm >= r5) + (pm >= r6) + (pm >= r7); u.pn = __builtin_amdgcn_readfirstlane(u.pn + e * nNloc); u.pm = __builtin_amdgcn_readfirstlane(pm); }
    __device__ __forceinline__ bool next(int i, Unit& u) const {
        if (!so.next(i, u)) return false;
        const int pm = u.pm;
        const int e = (pm >= r1) + (pm >= r2) + (pm >= r3) + (pm >= r4) + (pm >= r5) + (pm >= r6) + (pm >= r7);
        u.pn = __builtin_amdgcn_readfirstlane(u.pn + e * nNloc); u.pm = __builtin_amdgcn_readfirstlane(pm); return true;
    }
    __device__ __forceinline__ void a_ready(const Unit&) const {}
    __device__ __forceinline__ void done(const Unit&) const {}
};
struct EpiPartial {
    static constexpr bool PERM = true, AFTER_DRAIN = false, PROF = false; static constexpr int NROWDMA = 0;
    float* P;
    struct Pre {}; __device__ __forceinline__ void prefetch(Pre&, const Unit&, int, int) const {}
    __device__ __forceinline__ void operator()(const f32x4 (&acc)[2][2][4][2], const Unit&, int, int, int, int, const Pre&, const PG8_LAS unsigned*) const {
        int t_ = (int)threadIdx.x; asm volatile("" : "+v"(t_));
        const int wid = t_ >> 6, wr = wid >> 2, wc = wid & 3, fr = t_ & 15, fq = (t_ >> 4) & 3;
#pragma unroll
        for (int ai = 0; ai < 2; ++ai)
#pragma unroll
            for (int m = 0; m < 4; ++m) { float* rp = P + (size_t)(wr * 64 + fr + ai * HALF + m * 16) * BM + wc * 32 + 8 * fq;
#pragma unroll
                for (int bj = 0; bj < 2; ++bj) { *(f32x4*)(rp + bj * HALF) = acc[ai][bj][m][0]; *(f32x4*)(rp + bj * HALF + 4) = acc[ai][bj][m][1]; } }
    }
};
struct PieceOrder {
    Unit u; int has;
    __device__ __forceinline__ bool next(int i, Unit& uu) const { if (i != 0 || !has) return false; uu = u; return true; }
    __device__ __forceinline__ void a_ready(const Unit&) const {}
    __device__ __forceinline__ void done(const Unit&) const {}
};
}
#define GAS __attribute__((address_space(1)))
#define LAS __attribute__((address_space(3)))
typedef unsigned short bf16;
typedef unsigned v4u __attribute__((ext_vector_type(4)));
typedef float f32x4 __attribute__((ext_vector_type(4)));
typedef short bf16x8 __attribute__((ext_vector_type(8)));
typedef GAS unsigned gu32;
typedef GAS unsigned long long gu64;
#define RLX_AGENT __ATOMIC_RELAXED, __HIP_MEMORY_SCOPE_AGENT
#define LDS_WAIT() asm volatile("s_waitcnt lgkmcnt(0)" ::: "memory")
#define VM_WAIT() asm volatile("s_waitcnt vmcnt(0)" ::: "memory")
__device__ __forceinline__ unsigned long long rt() { return __builtin_amdgcn_s_memrealtime(); }
__device__ __forceinline__ unsigned f2bf(float f) { unsigned u = __builtin_bit_cast(unsigned, f); return (u + 0x7fffu + ((u >> 16) & 1u)) >> 16; }
__device__ __forceinline__ unsigned pk2(float lo, float hi) { return f2bf(lo) | (f2bf(hi) << 16); }
#define XB_TMO      128
#define XB_XCNT(j)  (256  + 64 * (j))
#define XB_XSUB(j)  (1280 + 64 * (j))
#define XB_XGEN(j)  (2304 + 64 * (j))
#define XB_TOP      3328
#define XB_TOPGEN   3392
#define XCD_BAR_WORDS 3456
#define XB_SPIN_CAP (1u << 18)

__device__ __forceinline__ unsigned xb_ld(unsigned* p)              { return __hip_atomic_load(p, __ATOMIC_RELAXED, __HIP_MEMORY_SCOPE_AGENT); }
__device__ __forceinline__ unsigned xb_add(unsigned* p, unsigned v) { return __hip_atomic_fetch_add(p, v, __ATOMIC_RELAXED, __HIP_MEMORY_SCOPE_AGENT); }
__device__ __forceinline__ unsigned xb_xcc_id() { return (unsigned)__builtin_amdgcn_s_getreg((3 << 11) | 20) & 0xFu; }
#define XB_SPIN(cond, bar) do { unsigned _sp = 0; while (cond) { __builtin_amdgcn_s_sleep(1); \
    if ((++_sp & 255u) == 0u) { if (xb_ld(&(bar)[XB_TMO])) break; if (_sp > XB_SPIN_CAP) { atomicAdd(&(bar)[XB_TMO], 1u); break; } } } } while (0)

struct XcdBarrier {
    unsigned* bar; unsigned x;
    volatile LAS unsigned* st;
};

__device__ __forceinline__ XcdBarrier xcd_barrier_post(unsigned* bar, volatile LAS unsigned* st) {
    XcdBarrier b; b.bar = bar; b.x = xb_xcc_id(); b.st = st;
    if (threadIdx.x == 0) (void)xb_add(&bar[XB_XCNT(b.x)], 1u);
    return b;
}
__device__ __forceinline__ void xcd_barrier_complete(unsigned* bar, unsigned x, unsigned& nloc, unsigned& nx) {
    const unsigned G = gridDim.x * gridDim.y * gridDim.z;
    unsigned sum, cnt, mine, sp = 0u;
    for (;;) {
        sum = 0u; cnt = 0u; mine = 0u;
#pragma unroll
        for (unsigned j = 0; j < 16; ++j) { const unsigned c = xb_ld(&bar[XB_XCNT(j)]); sum += c; cnt += (c > 0u) ? 1u : 0u; mine = (j == x) ? c : mine; }
        if (sum == G) break;
        __builtin_amdgcn_s_sleep(1);
        if ((++sp & 255u) == 0u) { if (xb_ld(&bar[XB_TMO])) break; if (sp > XB_SPIN_CAP) { atomicAdd(&bar[XB_TMO], 1u); break; } }
    }
    nloc = mine > 0u ? mine : 1u; nx = cnt > 0u ? cnt : 1u;
}

__device__ __forceinline__ void xcd_barrier(const XcdBarrier& b) {
    asm volatile("s_waitcnt vmcnt(0)" ::: "memory");
    __syncthreads();
    if (threadIdx.x == 0) {
        unsigned* bar = b.bar;
        __builtin_amdgcn_s_waitcnt(0);
        unsigned nloc = b.st[0], nx = b.st[1];
        if (nloc == 0u) { xcd_barrier_complete(bar, b.x, nloc, nx); b.st[0] = nloc; b.st[1] = nx; }
        const unsigned old = xb_add(&bar[XB_XSUB(b.x)], 1u);
        const unsigned gen = old / nloc;
        if (old + 1u == (gen + 1u) * nloc) {
            __builtin_amdgcn_fence(__ATOMIC_RELEASE, "agent");
            asm volatile("s_waitcnt vmcnt(0)" ::: "memory");
            const unsigned og = xb_add(&bar[XB_TOP], 1u);
            const unsigned tg = og / nx;
            if (og + 1u == (tg + 1u) * nx) xb_add(&bar[XB_TOPGEN], 1u);
            else XB_SPIN(xb_ld(&bar[XB_TOPGEN]) == tg, bar);
            __builtin_amdgcn_fence(__ATOMIC_ACQUIRE, "agent");
            xb_add(&bar[XB_XGEN(b.x)], 1u);
            asm volatile("s_waitcnt vmcnt(0)" ::: "memory");
        } else {
            XB_SPIN(xb_ld(&bar[XB_XGEN(b.x)]) == gen, bar);
            __builtin_amdgcn_fence(__ATOMIC_ACQUIRE, "agent");
            asm volatile("s_waitcnt vmcnt(0)" ::: "memory");
        }
    }
    __syncthreads();
}
constexpr int NWAVES = 8;
constexpr int BATCH = 8, T = 8192, D = 1024, M = BATCH * T;
constexpr int NH = 8, HDK = 128;
constexpr int FF = 2816, NE = 8, EF = 3584;
constexpr int SLOTS_MAX = M + NE * 256;
constexpr float LAMBDA_INIT = 0.35550906759f;
constexpr float EPS = 1e-6f;
constexpr float LOG2E = 1.4426950408889634f;
#ifndef MK_N_LAUNCHES
#define MK_N_LAUNCHES 1
#endif
constexpr int N_PHASES = 17;
constexpr int N_LAUNCHES = MK_N_LAUNCHES;

constexpr size_t MiB = 1u << 20, KiB = 1u << 10;
constexpr size_t WS_CTL = 0, CTL_ZERO_BYTES = 2 * MiB;
constexpr size_t WS_ST1 = 512 * KiB, WS_ST2 = 1 * MiB, WS_ST3 = 1 * MiB + 512 * KiB;
constexpr size_t WS_ST0 = 2 * MiB;
constexpr size_t WS_WGCNT = 2 * MiB + 256 * KiB;
constexpr size_t WS_RTS = WS_WGCNT + 16 * KiB;
constexpr size_t WS_UORDER = WS_RTS + 1 * KiB;
constexpr size_t WS_LB = WS_UORDER + 2 * KiB;
constexpr size_t WS_ROUTER = 2 * MiB + 512 * KiB;
constexpr size_t WS_TOKE = 3 * MiB, WS_TOKG = 3 * MiB + 512 * KiB;
constexpr size_t WS_TOKS = 4 * MiB;
constexpr size_t WS_S2T = 5 * MiB, WS_SG = 6 * MiB, WS_SR = 7 * MiB;
constexpr size_t WS_W1 = 8 * MiB, WS_W2 = 16 * MiB, WS_W3 = 18 * MiB, WS_W4 = 29 * MiB, WS_W5 = 35 * MiB, WS_W6 = 41 * MiB, WS_W7 = 43 * MiB, WS_W8 = 155 * MiB;
constexpr size_t WS_ACT0 = 212 * MiB, WS_ACT1 = 340 * MiB, WS_BIG = 474 * MiB, WS_DEND = 986 * MiB, WS_END = 1024 * MiB;
static_assert(WS_W4 + (size_t)FF * D * 2 <= WS_W5 && WS_W8 + (size_t)NE * D * EF * 2 <= WS_ACT0 && WS_ACT1 + (size_t)2 * SLOTS_MAX * D <= WS_BIG, "d_ws map");
static_assert(WS_BIG + (size_t)M * 4096 * 2 <= WS_END && WS_BIG + (size_t)SLOTS_MAX * EF * 2 <= WS_END && 2 * SLOTS_MAX * 4 <= (int)MiB, "d_ws map");
constexpr int CW_TMO = 0, CW_CODE = 1, CW_BAR = 4096, CW_ATTQ = 8192;

constexpr int RING_OFF = 0, RING_BYTES = 131072;
constexpr int LDSCTL_OFF = RING_BYTES, MISC_OFF = LDSCTL_OFF + 320;
constexpr int LDS_BYTES = 147456;

struct Frame {
    LAS unsigned char* lds;
    volatile LAS unsigned* MISC;
    gu32* ctl;
    unsigned char* ws;
    int tid, lane, wave, vcu, G;
};

__device__ __forceinline__ float wave_sum(float v) {
#pragma unroll
    for (int o = 1; o < 64; o <<= 1) v += __shfl_xor(v, o);
    return v;
}
typedef float f32x2 __attribute__((ext_vector_type(2)));
typedef unsigned u32x2 __attribute__((ext_vector_type(2)));
__device__ __forceinline__ unsigned lds_add(LAS unsigned* p, unsigned v) { return __hip_atomic_fetch_add(p, v, __ATOMIC_RELAXED, __HIP_MEMORY_SCOPE_WORKGROUP); }
__device__ __forceinline__ void lds_inc(LAS unsigned* p) { (void)lds_add(p, 1u); }
__device__ __forceinline__ float bf2f(unsigned short b) { return __builtin_bit_cast(float, (unsigned)b << 16); }
__device__ __forceinline__ float bflo(unsigned u) { return __builtin_bit_cast(float, u << 16); }
__device__ __forceinline__ float bfhi(unsigned u) { return __builtin_bit_cast(float, u & 0xffff0000u); }
typedef float f32x2_t __attribute__((ext_vector_type(2))); typedef __bf16 bf16x2_t __attribute__((ext_vector_type(2)));
__device__ __forceinline__ unsigned cvtpk(float lo, float hi) { f32x2_t v = {lo, hi}; bf16x2_t b = __builtin_convertvector(v, bf16x2_t); return __builtin_bit_cast(unsigned, b); }

template <int MODE>
__device__ __forceinline__ void tr_item(const float* W, int K, int N, bf16* WT, int FFD, const float* gain, int gmask, float gscale, LAS float* scr, int item, int lane) {
    const int nblk = N / 32, kb = item / nblk, nb = item % nblk, k0 = 64 * kb, n0 = 32 * nb;
    int src = n0;
    if (MODE != 0) { const int pn = n0 >> 8, rem = n0 & 255, bj = rem >> 7, wc = (rem >> 5) & 3; src = (MODE == 1) ? bj * FFD + 128 * pn + 32 * wc : (MODE == 2) ? 256 * pn + 64 * wc + 32 * bj : (pn < 8 ? bj * 1024 + 128 * pn + 32 * wc : n0); }
    { f32x4 v[8];
#pragma unroll
        for (int i = 0; i < 8; ++i) v[i] = *(const GAS f32x4*)(W + (size_t)(k0 + 8 * i + (lane >> 3)) * N + src + 4 * (lane & 7));
#pragma unroll
        for (int i = 0; i < 8; ++i) { LAS float* d = scr + (8 * i + (lane >> 3)) * 33 + 4 * (lane & 7); d[0] = v[i].x; d[1] = v[i].y; d[2] = v[i].z; d[3] = v[i].w; } }
    LDS_WAIT(); asm volatile("" ::: "memory");
    const int c = lane & 7;
    float g[8];
#pragma unroll
    for (int i = 0; i < 8; ++i) g[i] = gain ? gain[(k0 + 8 * c + i) & gmask] * gscale : 1.f;
#pragma unroll
    for (int j = 0; j < 4; ++j) { const int n = (lane >> 3) + 8 * j; const LAS float* s = scr + (8 * c) * 33 + n;
        v4u o; o.x = cvtpk(s[0 * 33] * g[0], s[1 * 33] * g[1]); o.y = cvtpk(s[2 * 33] * g[2], s[3 * 33] * g[3]); o.z = cvtpk(s[4 * 33] * g[4], s[5 * 33] * g[5]); o.w = cvtpk(s[6 * 33] * g[6], s[7 * 33] * g[7]);
        *(GAS v4u*)(WT + (size_t)(n0 + n) * K + k0 + 8 * c) = o; }
    LDS_WAIT(); asm volatile("" ::: "memory");
}

template <int MODE>
__device__ __forceinline__ void tr_item8(const float* W, int K, int N, unsigned char* WT, int FFD, const float* gain, int gmask, LAS float* scr, int item, int lane) {
    const int nblk = N / 32, kb = item / nblk, nb = item % nblk, k0 = 64 * kb, n0 = 32 * nb;
    int src = n0;
    if (MODE != 0) { const int pn = n0 >> 8, rem = n0 & 255, bj = rem >> 7, wc = (rem >> 5) & 3; src = (MODE == 1) ? bj * FFD + 128 * pn + 32 * wc : (MODE == 2) ? 256 * pn + 64 * wc + 32 * bj : (pn < 8 ? bj * 1024 + 128 * pn + 32 * wc : n0); }
    { f32x4 v[8];
#pragma unroll
        for (int i = 0; i < 8; ++i) v[i] = *(const GAS f32x4*)(W + (size_t)(k0 + 8 * i + (lane >> 3)) * N + src + 4 * (lane & 7));
#pragma unroll
        for (int i = 0; i < 8; ++i) { LAS float* d = scr + (8 * i + (lane >> 3)) * 33 + 4 * (lane & 7); d[0] = v[i].x; d[1] = v[i].y; d[2] = v[i].z; d[3] = v[i].w; } }
    LDS_WAIT(); asm volatile("" ::: "memory");
    const int c = lane & 7;
    float g[8];
#pragma unroll
    for (int i = 0; i < 8; ++i) g[i] = (gain ? gain[(k0 + 8 * c + i) & gmask] : 1.f) * pg8::W8S;
#pragma unroll
    for (int j = 0; j < 4; ++j) { const int n = (lane >> 3) + 8 * j; const LAS float* s = scr + (8 * c) * 33 + n;
        u32x2 o; o.x = pg8::pk_fp8x4(s[0 * 33] * g[0], s[1 * 33] * g[1], s[2 * 33] * g[2], s[3 * 33] * g[3]); o.y = pg8::pk_fp8x4(s[4 * 33] * g[4], s[5 * 33] * g[5], s[6 * 33] * g[6], s[7 * 33] * g[7]);
        *(GAS u32x2*)(WT + (size_t)(n0 + n) * K + k0 + 8 * c) = o; }
    LDS_WAIT(); asm volatile("" ::: "memory");
}

__device__ __forceinline__ int attn_jlo(int h, int qt, float XB) {
    const float sl = LOG2E * __builtin_ldexpf(1.f, -(h + 1)); const float XT = XB + 25.1f;
    const int Wk = (int)(XT / sl) + 1; const int d = 128 * qt - Wk; return d > 0 ? (d >> 6) : 0; }
__device__ __forceinline__ float attn_b2(const float* qg, const float* kg, int lane) {
    float gm = fabsf(qg[lane] * kg[lane]);
#pragma unroll
    for (int o = 1; o < 64; o <<= 1) gm = fmaxf(gm, __shfl_xor(gm, o));
    return 8.f * gm * LOG2E * 1.02f + 0.05f;
}

__device__ __forceinline__ void p0_prologue(Frame& F, const float* const* in) {
    LAS float* scr = (LAS float*)(F.lds + RING_OFF + F.wave * 16384);
    const int gw = F.vcu * NWAVES + F.wave, NGW = F.G * NWAVES;
    constexpr int I1 = (D / 64) * (4096 / 32), I2 = (D / 64) * (D / 32), I3 = (D / 64) * (2 * FF / 32), I4 = (FF / 64) * (D / 32), I5 = (D / 64) * (3 * D / 32), I6 = I2;
    constexpr int I7 = (D / 64) * (2 * EF / 32), I8 = (EF / 64) * (D / 32);
    constexpr int NITEMS = I1 + I2 + I3 + I4 + I5 + I6 + NE * I7 + NE * I8;
    unsigned char* ws = F.ws;
    auto do_item = [&](int it) {
        int r = it;
        if (r < I1) { tr_item<3>(in[3], D, 4096, (bf16*)(ws + WS_W1), 0, in[2], 1023, 1.f, scr, r, F.lane); return; } r -= I1;
        if (r < I2) { tr_item<0>(in[5], D, D, (bf16*)(ws + WS_W2), 0, in[4], 1023, 1.f, scr, r, F.lane); return; } r -= I2;
        if (r < I3) { tr_item<1>(in[7], D, 2 * FF, (bf16*)(ws + WS_W3), FF, in[6], 1023, 1.f, scr, r, F.lane); return; } r -= I3;
        if (r < I4) { tr_item8<0>(in[8], FF, D, ws + WS_W4, 0, nullptr, 0, scr, r, F.lane); return; } r -= I4;
        if (r < I5) { tr_item<2>(in[10], D, 3 * D, (bf16*)(ws + WS_W5), 0, in[9], 1023, 1.f, scr, r, F.lane); return; } r -= I5;
        if (r < I6) { tr_item<0>(in[18], D, D, (bf16*)(ws + WS_W6), 0, in[17], 127, 1.f - LAMBDA_INIT, scr, r, F.lane); return; } r -= I6;
        if (r < NE * I7) { const int e = r / I7; tr_item8<1>(in[21] + (size_t)e * D * 2 * EF, D, 2 * EF, ws + WS_W7 + (size_t)e * 2 * EF * D, EF, in[19], 1023, scr, r % I7, F.lane); return; } r -= NE * I7;
        { const int e = r / I8; tr_item8<0>(in[22] + (size_t)e * EF * D, EF, D, ws + WS_W8 + (size_t)e * D * EF, 0, nullptr, 0, scr, r % I8, F.lane); }
    };
    const float* x = in[0]; bf16* xb = (bf16*)(ws + WS_ACT0); float* st0 = (float*)(ws + WS_ST0);
    static_assert((M / (256 * NWAVES)) % 4 == 0, "four rows per trip");
    int it = gw;
    for (int m = gw; m < M; m += 4 * NGW) {
        f32x4 v[4][4];
#pragma unroll
        for (int q = 0; q < 4; ++q) { const GAS f32x4* xr = (const GAS f32x4*)(x + (size_t)(m + q * NGW) * D) + F.lane;
#pragma unroll
            for (int j = 0; j < 4; ++j) v[q][j] = xr[64 * j]; }
        for (int r4 = 0; r4 < 4 && it < NITEMS; ++r4, it += NGW) do_item(it);
#pragma unroll
        for (int q = 0; q < 4; ++q) { GAS unsigned long long* o8 = (GAS unsigned long long*)(xb + (size_t)(m + q * NGW) * D) + F.lane;
            float s = 0.f;
#pragma unroll
            for (int j = 0; j < 4; ++j) { const f32x4 t = v[q][j]; s += (t.x * t.x + t.y * t.y) + (t.z * t.z + t.w * t.w); o8[64 * j] = (unsigned long long)cvtpk(t.x, t.y) | ((unsigned long long)cvtpk(t.z, t.w) << 32); }
            s = wave_sum(s); if (F.lane == 0) st0[m + q * NGW] = s; }
    }
    for (; it < NITEMS; it += NGW) do_item(it);
    if (blockIdx.x == 0) {
        const float* lbp = in[1]; float* LB = (float*)(ws + WS_LB);
        for (int c = F.tid; c < D; c += NWAVES * 64) { const float a0 = lbp[c], a1 = lbp[D + c], a2 = lbp[2 * D + c]; const float mx = fmaxf(a0, fmaxf(a1, a2));
            const float e0 = __expf(a0 - mx), e1 = __expf(a1 - mx), e2 = __expf(a2 - mx); LB[c] = e0 / (e0 + e1 + e2); }
    }
    if (blockIdx.x == 1) {
        const float* rp = in[20]; const float* gp = in[19]; float* R = (float*)(ws + WS_ROUTER);
        for (int i = F.tid; i < D * NE; i += NWAVES * 64) R[i] = rp[i] * gp[i >> 3];
    }
    {
        if (F.wave < 2) {
            const float XT = 2.f * attn_b2(in[11], in[12], F.lane);
            const int i = 2 * (int)blockIdx.x + F.wave; const int c = 2 * (i & 63) + 2 - attn_jlo(i >> 6, i & 63, XT);
            int rank = 0;
#pragma unroll
            for (int k = 0; k < 8; ++k) { const int j = F.lane + 64 * k; const int cj = 2 * (j & 63) + 2 - attn_jlo(j >> 6, j & 63, XT); rank += (cj > c || (cj == c && j < i)) ? 1 : 0; }
#pragma unroll
            for (int o = 1; o < 64; o <<= 1) rank += __shfl_xor(rank, o);
            if (F.lane == 0) ((int*)(ws + WS_UORDER))[rank] = i;
        }
    }
}

namespace scan {
constexpr int QS = 136, SS = 72;
constexpr int SG_Q = 0, SG_K = 16384, SG_V = 32768, SG_DEND = 36864, SG_BYTES = 37888;
constexpr int NSTG = 3, L_ST = NSTG * SG_BYTES, L_END = L_ST + 2 * 32 * QS * 2;
static_assert(L_END <= RING_BYTES, "scan LDS");
typedef float f32x4 __attribute__((ext_vector_type(4)));
}
__device__ __forceinline__ void scan_glds16(const void* gsrc, unsigned lds_dst) { unsigned keep;
    asm volatile("s_mov_b32 %0, m0\n\ts_mov_b32 m0, %2\n\ts_nop 0\n\tglobal_load_lds_dwordx4 %1, off\n\ts_mov_b32 m0, %0" : "=&s"(keep) : "v"(gsrc), "s"(lds_dst) : "memory"); }
typedef short scan_s16x4 __attribute__((ext_vector_type(4)));
__device__ __forceinline__ scan_s16x4 scan_tr8(unsigned addr) { scan_s16x4 r; asm volatile("ds_read_b64_tr_b16 %0, %1" : "=&v"(r) : "v"(addr) : "memory"); return r; }
#define SCAN_CAT(lo, hi) ((bf16x8){lo[0], lo[1], lo[2], lo[3], hi[0], hi[1], hi[2], hi[3]})
__device__ __forceinline__ void scan_phase(Frame& F) {
    using namespace scan;
    if (F.vcu >= BATCH * NH * 4) return;
    const int lane = F.lane, wid = F.wave, fr = lane & 15, fq = lane >> 4;
    const int b = F.vcu >> 5, h = (F.vcu >> 2) & 7, vs = F.vcu & 3;
    LAS unsigned char* L = F.lds + RING_OFF; LAS bf16* ST = (LAS bf16*)(L + L_ST);
    const bf16* qfvg = (const bf16*)(F.ws + WS_BIG); bf16* obuf = (bf16*)(F.ws + WS_ACT1); const float* dendg = (const float*)(F.ws + WS_DEND);
    const unsigned lds0 = (unsigned)(uintptr_t)L;
    const bf16* src[5]; unsigned dst[5];
#pragma unroll
    for (int j = 0; j < 4; ++j) { const int pc = 4 * wid + j, isK = pc >> 4, R = 4 * (pc & 15) + (lane >> 4), pp = lane & 15;
        src[j] = qfvg + (size_t)(b * T + R) * 4096 + isK * 1024 + h * 128 + ((pp ^ (R & 15)) * 8); dst[j] = (unsigned)(pc * 1024); }
    { const int pv = wid & 3, R = 16 * pv + (lane >> 2), pp = lane & 3;
      src[4] = (wid == 4) ? (const bf16*)(dendg + (size_t)(b * (T / 64)) * 1024 + h * 128 + lane * 4) : qfvg + (size_t)(b * T + R) * 4096 + 2048 + h * 128 + vs * 32 + pp * 8;
      dst[4] = (wid == 4) ? (unsigned)SG_DEND : (unsigned)(SG_V + pv * 1024); }
    const size_t adv4 = (wid == 4) ? (size_t)1024 * 2 : (size_t)64 * 4096;
#define SCAN_DMA(cc, stg) do { const int cl_ = (cc) < T / 64 ? (cc) : T / 64 - 1; const unsigned sb_ = lds0 + (unsigned)((stg) * SG_BYTES); \
        _Pragma("unroll") for (int j = 0; j < 4; ++j) scan_glds16(src[j] + (size_t)cl_ * 64 * 4096, (unsigned)__builtin_amdgcn_readfirstlane((int)(sb_ + dst[j]))); \
        scan_glds16(src[4] + (size_t)cl_ * adv4, (unsigned)__builtin_amdgcn_readfirstlane((int)(sb_ + dst[4]))); } while (0)
    for (int i = F.tid; i < 2 * 32 * QS / 2; i += NWAVES * 64) ((LAS unsigned*)ST)[i] = 0u;
    f32x4 sacc[2]; sacc[0] = (f32x4){0.f, 0.f, 0.f, 0.f}; sacc[1] = sacc[0];
    const int ti = wid >> 1, vi = wid & 1, q4 = fr >> 2, p4 = fr & 3;
    SCAN_DMA(0, 0); SCAN_DMA(1, 1);
    int stg = 0, stg2 = 2;
    for (int c = 0; c < T / 64; ++c) {
        const int cur = c & 1, nxt = cur ^ 1;
        if (c == 0) asm volatile("s_waitcnt vmcnt(5)" ::: "memory"); else if (c == 1) asm volatile("s_waitcnt vmcnt(6)" ::: "memory"); else asm volatile("s_waitcnt vmcnt(7)" ::: "memory");
        __syncthreads();
        SCAN_DMA(c + 2, stg2);
        LAS unsigned char* SG = L + stg * SG_BYTES; const unsigned sg0 = lds0 + (unsigned)(stg * SG_BYTES);
        bf16x8 qb[4];
#pragma unroll
        for (int kk = 0; kk < 4; ++kk) qb[kk] = *(const LAS bf16x8*)(SG + SG_Q + (16 * ti + fr) * 256 + (((4 * kk + fq) ^ fr) * 16));
        scan_s16x4 ka[2][2][2], vb[2][2], va[2][2];
#pragma unroll
        for (int ss = 0; ss < 2; ++ss)
#pragma unroll
            for (int hh = 0; hh < 2; ++hh) {
                const int srow = 32 * ss + 8 * fq + 4 * hh + q4;
#pragma unroll
                for (int s2 = 0; s2 < 2; ++s2) { const int ki = (wid >> 1) + 4 * s2; ka[s2][ss][hh] = scan_tr8(sg0 + SG_K + srow * 256 + (((2 * ki + (p4 >> 1)) ^ (srow & 15)) * 16) + (p4 & 1) * 8); }
                vb[ss][hh] = scan_tr8(sg0 + SG_V + srow * 64 + 32 * vi + p4 * 8);
            }
#pragma unroll
        for (int m = 0; m < 2; ++m)
#pragma unroll
            for (int hh = 0; hh < 2; ++hh) va[m][hh] = scan_tr8(sg0 + SG_V + (32 * m + 16 * hh + 4 * fq + q4) * 64 + 32 * vi + p4 * 8);
        asm volatile("s_waitcnt lgkmcnt(0)" ::: "memory"); __builtin_amdgcn_sched_barrier(0);
#pragma unroll
        for (int s2 = 0; s2 < 2; ++s2) {
            const int ki = (wid >> 1) + 4 * s2;
#pragma unroll
            for (int ss = 0; ss < 2; ++ss) sacc[s2] = __builtin_amdgcn_mfma_f32_16x16x32_bf16(SCAN_CAT(ka[s2][ss][0], ka[s2][ss][1]), SCAN_CAT(vb[ss][0], vb[ss][1]), sacc[s2], 0, 0, 0);
            sacc[s2] = sacc[s2] * *(const LAS f32x4*)(SG + SG_DEND + (16 * ki + 4 * fq) * 4);
            *(LAS u32x2*)(ST + nxt * 32 * QS + (16 * vi + fr) * QS + 16 * ki + 4 * fq) = (u32x2){cvtpk(sacc[s2][0], sacc[s2][1]), cvtpk(sacc[s2][2], sacc[s2][3])};
        }
        f32x4 oacc = (f32x4){0.f, 0.f, 0.f, 0.f};
        { bf16x8 sr[4];
#pragma unroll
          for (int kk = 0; kk < 4; ++kk) sr[kk] = *(const LAS bf16x8*)(ST + cur * 32 * QS + (16 * vi + fr) * QS + 32 * kk + 8 * fq);
#pragma unroll
          for (int kk = 0; kk < 4; ++kk) asm volatile("" : "+v"(sr[kk]));
#pragma unroll
          for (int kk = 0; kk < 4; ++kk) oacc = __builtin_amdgcn_mfma_f32_16x16x32_bf16(sr[kk], qb[kk], oacc, 0, 0, 0); }
#define SCAN_KROW(sb, kk) (*(const LAS bf16x8*)(SG + SG_K + (16 * (sb) + fr) * 256 + (((4 * (kk) + fq) ^ fr) * 16)))
#pragma unroll
        for (int m = 0; m < 2; ++m) {
            if (2 * m <= ti) {
                f32x4 pt0 = (f32x4){0.f, 0.f, 0.f, 0.f}, pt1 = pt0;
                if (2 * m + 1 <= ti) {
                    bf16x8 k0[4], k1[4];
#pragma unroll
                    for (int kk = 0; kk < 4; ++kk) { k0[kk] = SCAN_KROW(2 * m, kk); k1[kk] = SCAN_KROW(2 * m + 1, kk); }
#pragma unroll
                    for (int kk = 0; kk < 4; ++kk) { asm volatile("" : "+v"(k0[kk])); asm volatile("" : "+v"(k1[kk])); }
#pragma unroll
                    for (int kk = 0; kk < 4; ++kk) { pt0 = __builtin_amdgcn_mfma_f32_16x16x32_bf16(k0[kk], qb[kk], pt0, 0, 0, 0); pt1 = __builtin_amdgcn_mfma_f32_16x16x32_bf16(k1[kk], qb[kk], pt1, 0, 0, 0); }
                    if (2 * m + 1 == ti) {
#pragma unroll
                        for (int j = 0; j < 4; ++j) if (4 * fq + j > fr) pt1[j] = 0.f;
                    }
                } else {
                    bf16x8 k0[4];
#pragma unroll
                    for (int kk = 0; kk < 4; ++kk) k0[kk] = SCAN_KROW(2 * m, kk);
#pragma unroll
                    for (int kk = 0; kk < 4; ++kk) asm volatile("" : "+v"(k0[kk]));
#pragma unroll
                    for (int kk = 0; kk < 4; ++kk) pt0 = __builtin_amdgcn_mfma_f32_16x16x32_bf16(k0[kk], qb[kk], pt0, 0, 0, 0);
#pragma unroll
                    for (int j = 0; j < 4; ++j) if (4 * fq + j > fr) pt0[j] = 0.f;
                }
                const v4u pw = (v4u){cvtpk(pt0[0], pt0[1]), cvtpk(pt0[2], pt0[3]), cvtpk(pt1[0], pt1[1]), cvtpk(pt1[2], pt1[3])};
                oacc = __builtin_amdgcn_mfma_f32_16x16x32_bf16(SCAN_CAT(va[m][0], va[m][1]), __builtin_bit_cast(bf16x8, pw), oacc, 0, 0, 0);
            }
        }
#undef SCAN_KROW
        *(u32x2*)(obuf + (size_t)(b * T + c * 64 + 16 * ti + fr) * D + h * 128 + vs * 32 + 16 * vi + 4 * fq) = (u32x2){cvtpk(oacc[0], oacc[1]), cvtpk(oacc[2], oacc[3])};
        stg2 = stg; stg = (stg == 2) ? 0 : stg + 1;
    }
    asm volatile("s_waitcnt vmcnt(0)" ::: "memory");
    __syncthreads();
#undef SCAN_DMA
}
#undef SCAN_CAT

__device__ __forceinline__ void hgrn_gate_phase(Frame& F) {
    const int gw = F.vcu * NWAVES + F.wave, NGW = F.G * NWAVES;
    bf16* obuf = (bf16*)(F.ws + WS_ACT1); const bf16* qfvg = (const bf16*)(F.ws + WS_BIG);
    for (int m = gw; m < M; m += NGW) {
        v4u o[2], g[2];
        GAS v4u* op = (GAS v4u*)(obuf + (size_t)m * D + 16 * F.lane); const GAS v4u* gp = (const GAS v4u*)(qfvg + (size_t)m * 4096 + 3072 + 16 * F.lane);
        o[0] = op[0]; o[1] = op[1]; g[0] = gp[0]; g[1] = gp[1];
        float v[16]; float ss = 0.f;
#pragma unroll
        for (int i = 0; i < 8; ++i) { const unsigned w = o[i >> 2][i & 3]; v[2 * i] = bflo(w); v[2 * i + 1] = bfhi(w); ss += v[2 * i] * v[2 * i] + v[2 * i + 1] * v[2 * i + 1]; }
        ss += __shfl_xor(ss, 1); ss += __shfl_xor(ss, 2); ss += __shfl_xor(ss, 4);
        const float r = pg8::fast_rsq(ss * (1.f / 128.f) + EPS);
        v4u w[2];
#pragma unroll
        for (int i = 0; i < 8; ++i) { const unsigned gw2 = g[i >> 2][i & 3]; w[i >> 2][i & 3] = cvtpk(v[2 * i] * r * bflo(gw2), v[2 * i + 1] * r * bfhi(gw2)); }
        op[0] = w[0]; op[1] = w[1];
    }
}

namespace att {
using f32x16 = __attribute__((ext_vector_type(16))) float;
using s16x4 = __attribute__((ext_vector_type(4))) short;
typedef __bf16 bf2_t __attribute__((ext_vector_type(2)));
typedef short v4i16_t __attribute__((ext_vector_type(4)));
typedef __attribute__((address_space(3))) const char* lds_cptr;
constexpr int KSLOT = 16384, NKS = 3, VSLOT = 16384, NVS = 4, L_K0 = 0, L_K1 = 8192, L_V = NKS * KSLOT, L_WS = L_V + NVS * VSLOT, L_XO = 0, XOS = 132, PITCH = 3072;
static_assert(L_WS + NWAVES * 256 <= RING_BYTES && 128 * XOS * 4 <= L_WS, "attention LDS");
__device__ __forceinline__ int crow(int r, int hi) { return (r & 3) + 8 * (r >> 2) + 4 * hi; }
__device__ __forceinline__ void glds16(const void* gsrc, unsigned lds_dst) { unsigned keep;
    asm volatile("s_mov_b32 %0, m0\n\ts_mov_b32 m0, %2\n\ts_nop 0\n\tglobal_load_lds_dwordx4 %1, off\n\ts_mov_b32 m0, %0" : "=&s"(keep) : "v"(gsrc), "s"(lds_dst) : "memory"); }
__device__ __forceinline__ void qkt(f32x16& p0, f32x16& p1, lds_cptr Kslot, const bf16x8* qr, f32x16& cin, bf16x8 ones, bf16x8 b32, bf16x8 b64, int r32, int hi) {
    lds_cptr kb = Kslot + hi * 1024 + r32 * 16;
    bf16x8 kf[8];
#pragma unroll
    for (int d0 = 0; d0 < 4; ++d0) { kf[2 * d0] = *(const LAS bf16x8*)(kb + d0 * 2048); kf[2 * d0 + 1] = *(const LAS bf16x8*)(kb + d0 * 2048 + 512); }
#pragma unroll
    for (int i = 0; i < 8; ++i) asm volatile("" : "+v"(kf[i]));
    p0 = __builtin_amdgcn_mfma_f32_32x32x16_bf16(kf[0], qr[0], cin, 0, 0, 0); p1 = __builtin_amdgcn_mfma_f32_32x32x16_bf16(kf[1], qr[0], cin, 0, 0, 0);
    __builtin_amdgcn_sched_barrier(0);
#pragma unroll
    for (int d0 = 1; d0 < 4; ++d0) {
        p0 = __builtin_amdgcn_mfma_f32_32x32x16_bf16(kf[2 * d0], qr[d0], p0, 0, 0, 0);
        p1 = __builtin_amdgcn_mfma_f32_32x32x16_bf16(kf[2 * d0 + 1], qr[d0], p1, 0, 0, 0);
    }
    cin = __builtin_amdgcn_mfma_f32_32x32x16_bf16(ones, b64, cin, 0, 0, 0);
    p1 = __builtin_amdgcn_mfma_f32_32x32x16_bf16(ones, b32, p1, 0, 0, 0);
    __builtin_amdgcn_sched_barrier(0);
}
__device__ __forceinline__ void pv(f32x16* o, unsigned vb, bf16x8 pa0, bf16x8 pa1, bf16x8 pa2, bf16x8 pa3) {
#pragma unroll
    for (int d0 = 0; d0 < 4; ++d0) { s16x4 lo[4], hi[4];
#pragma unroll
        for (int ks = 0; ks < 4; ++ks) {
            asm volatile("ds_read_b64_tr_b16 %0,%1 offset:%c2" : "=&v"(lo[ks]) : "v"(vb), "i"(d0 * 4096 + ks * 1024) : "memory");
            asm volatile("ds_read_b64_tr_b16 %0,%1 offset:%c2" : "=&v"(hi[ks]) : "v"(vb), "i"(d0 * 4096 + ks * 1024 + 512) : "memory"); }
        asm volatile("s_waitcnt lgkmcnt(0)" ::: "memory"); __builtin_amdgcn_sched_barrier(0);
#define PK(k) (bf16x8){lo[k][0], lo[k][1], lo[k][2], lo[k][3], hi[k][0], hi[k][1], hi[k][2], hi[k][3]}
        o[d0] = __builtin_amdgcn_mfma_f32_32x32x16_bf16(pa0, PK(0), o[d0], 0, 0, 0);
        o[d0] = __builtin_amdgcn_mfma_f32_32x32x16_bf16(pa1, PK(1), o[d0], 0, 0, 0);
        o[d0] = __builtin_amdgcn_mfma_f32_32x32x16_bf16(pa2, PK(2), o[d0], 0, 0, 0);
        o[d0] = __builtin_amdgcn_mfma_f32_32x32x16_bf16(pa3, PK(3), o[d0], 0, 0, 0);
#undef PK
    }
}
struct VFrag { s16x4 lo[4], hi[4]; };
template <int KS> __device__ __forceinline__ void vrd4(VFrag& f, unsigned vb) {
#pragma unroll
    for (int d0 = 0; d0 < 4; ++d0) {
        asm volatile("ds_read_b64_tr_b16 %0,%1 offset:%c2" : "=&v"(f.lo[d0]) : "v"(vb), "i"(d0 * 4096 + KS * 1024) : "memory");
        asm volatile("ds_read_b64_tr_b16 %0,%1 offset:%c2" : "=&v"(f.hi[d0]) : "v"(vb), "i"(d0 * 4096 + KS * 1024 + 512) : "memory"); }
}
__device__ __forceinline__ void pv4(f32x16* o, const VFrag& f, bf16x8 pa) {
#pragma unroll
    for (int d0 = 0; d0 < 4; ++d0) {
        const bf16x8 vf = (bf16x8){f.lo[d0][0], f.lo[d0][1], f.lo[d0][2], f.lo[d0][3], f.hi[d0][0], f.hi[d0][1], f.hi[d0][2], f.hi[d0][3]};
        o[d0] = __builtin_amdgcn_mfma_f32_32x32x16_bf16(pa, vf, o[d0], 0, 0, 0); }
}
#ifdef MK_ATT_PROF
#define APROF(idx) do { const unsigned long long t_ = __builtin_amdgcn_s_memtime(); prof[idx] += t_ - tprev; tprev = t_; } while (0)
#else
#define APROF(idx) do {} while (0)
#endif
__device__ __forceinline__ void attn_unit(int b, int h, int qt, const bf16* QKV, bf16* Out, LAS unsigned char* shm, float lam, float slope2, float B2, unsigned long long* prof) {
#ifdef MK_ATT_PROF
    unsigned long long tprev = __builtin_amdgcn_s_memtime();
#endif
    const int tid = threadIdx.x, lane = tid & 63, r32 = lane & 31, hi = lane >> 5; const int wid = __builtin_amdgcn_readfirstlane(tid >> 6);
    const int comp = wid >> 2, wq = wid & 3;
    const long rowbase = (long)b * T; const int q0 = qt * 128; const int myq = q0 + 32 * wq + r32;
    const bf16* Qw = QKV + (rowbase + q0 + 32 * wq) * PITCH + h * 128 + comp * 64;
    const bf16* Kh = QKV + rowbase * PITCH + 1024 + h * 128; const bf16* Vh = QKV + rowbase * PITCH + 2048 + h * 128;
    const unsigned lds0 = (unsigned)(uintptr_t)shm;
    const int pz0 = 2 * wid;
    const unsigned kvo = (unsigned)((lane * PITCH + wid * 8) * 2);
    const unsigned kvo1 = kvo + 128u;
    const unsigned vvo0 = (unsigned)(((16 * (pz0 & 3) + (lane >> 2)) * PITCH + 32 * (pz0 >> 2) + (lane & 3) * 8) * 2);
    const unsigned vvo1 = (unsigned)(((16 * ((pz0 + 1) & 3) + (lane >> 2)) * PITCH + 32 * ((pz0 + 1) >> 2) + (lane & 3) * 8) * 2);
    const unsigned kls = (unsigned)__builtin_amdgcn_readfirstlane((int)(lds0 + L_K0 + wid * 1024)), vls = (unsigned)__builtin_amdgcn_readfirstlane((int)(lds0 + L_V + pz0 * 1024));
#define ATT_SB64(p_) (((unsigned long long)(unsigned)__builtin_amdgcn_readfirstlane((int)((unsigned long long)(p_) >> 32)) << 32) | (unsigned)__builtin_amdgcn_readfirstlane((int)(unsigned long long)(p_)))
#define ATT_GLDS(voff_, sbase_, mbase_, mimm_, ioff_) asm volatile("s_add_i32 m0, %2, %3\n\ts_nop 0\n\tglobal_load_lds_dwordx4 %0, %1 offset:" #ioff_ : : "v"(voff_), "s"(sbase_), "s"(mbase_), "i"(mimm_) : "memory", "scc")
#define DMA_TILE(t, koff, voff) do { const unsigned long long kb64_ = kb0_ + (unsigned long long)(unsigned)((t) - jlo) * (unsigned long long)(64 * PITCH * 2), vb64_ = vb0_ + (unsigned long long)(unsigned)((t) - jlo) * (unsigned long long)(64 * PITCH * 2); \
        const unsigned km_ = kls + (unsigned)(koff), vm_ = vls + (unsigned)(voff); \
        ATT_GLDS(kvo, kb64_, km_, 0, 0); ATT_GLDS(kvo1, kb64_, km_, L_K1 - L_K0, 0); \
        ATT_GLDS(vvo0, vb64_, vm_, 0, 0); ATT_GLDS(vvo1, vb64_, vm_, 1024, 0); } while (0)
    const int jlo = attn_jlo(h, qt, 2.f * B2), jhi = 2 * qt + 1, nt = jhi - jlo + 1;
    const unsigned long long kb0_ = ATT_SB64((const char*)Kh + (long)jlo * 64 * PITCH * 2), vb0_ = ATT_SB64((const char*)Vh + (long)jlo * 64 * PITCH * 2);
    DMA_TILE(jlo, 0, 0);
    if (nt > 1) DMA_TILE(jlo + 1, KSLOT, VSLOT);
    bf16x8 qr[4];
#pragma unroll
    for (int d0 = 0; d0 < 4; ++d0) qr[d0] = *reinterpret_cast<const bf16x8*>(&Qw[(long)r32 * PITCH + d0 * 16 + hi * 8]);
#pragma unroll
    for (int d0 = 0; d0 < 4; ++d0) asm volatile("" : "+v"(qr[d0]));
    f32x16 cin;
#pragma unroll
    for (int r = 0; r < 16; ++r) cin[r] = slope2 * (float)(64 * jlo + crow(r, hi) - myq) - B2;
    const float d32 = 32.f * slope2, d64 = 64.f * slope2;
    bf16x8 onesf, b32f, b64f;
    { const unsigned one2 = 0x3f803f80u; onesf = __builtin_bit_cast(bf16x8, (v4u){one2, one2, one2, one2});
      auto split = [&](float c) { const unsigned u0 = __builtin_bit_cast(unsigned, c) & 0xffff0000u; const float r1 = c - __builtin_bit_cast(float, u0);
          const unsigned u1 = __builtin_bit_cast(unsigned, r1) & 0xffff0000u; const float r2 = r1 - __builtin_bit_cast(float, u1); const unsigned u2 = __builtin_bit_cast(unsigned, r2) & 0xffff0000u;
          return (v4u){hi ? 0u : ((u0 >> 16) | u1), hi ? 0u : (u2 >> 16), 0u, 0u}; };
      b32f = __builtin_bit_cast(bf16x8, split(d32)); b64f = __builtin_bit_cast(bf16x8, split(d64)); }
    f32x16 o[4]; o[0] = f32x16{}; o[1] = f32x16{}; o[2] = f32x16{}; o[3] = f32x16{};
    float l_reg = 0.f;
    const unsigned vbl = lds0 + L_V + ((lane >> 4) & 1) * 32 + (lane & 3) * 8 + (4 * hi + ((lane & 15) >> 2)) * 64;
#define SB() __builtin_amdgcn_sched_barrier(0)
#define MASK_TILE(j) do { if (64 * (j) + 63 > q0 + 32 * wq) { const int kb_ = 64 * (j) + 4 * hi; \
        _Pragma("unroll") for (int r = 0; r < 16; ++r) { const int kv = kb_ + (r & 3) + 8 * (r >> 2); if (kv > myq) p0[r] = -INFINITY; if (kv + 32 > myq) p1[r] = -INFINITY; } } } while (0)
#define EXP2(e) do { if ((e) < 16) { p0[(e)] = __builtin_amdgcn_exp2f(p0[(e)]); p0[(e) + 1] = __builtin_amdgcn_exp2f(p0[(e) + 1]); } \
        else { p1[(e) - 16] = __builtin_amdgcn_exp2f(p1[(e) - 16]); p1[(e) - 15] = __builtin_amdgcn_exp2f(p1[(e) - 15]); } } while (0)
#define PSUM(w) sacc = __builtin_amdgcn_fdot2_f32_bf16(__builtin_bit_cast(att::bf2_t, (unsigned)(w)), (att::bf2_t){(__bf16)1.0f, (__bf16)1.0f}, sacc, false)
#define PSUM4(W) do { PSUM((W)[0]); PSUM((W)[1]); PSUM((W)[2]); PSUM((W)[3]); } while (0)
#define PACK_P() do { pw0 = (v4u){cvtpk(p0[0], p0[1]), cvtpk(p0[2], p0[3]), cvtpk(p0[4], p0[5]), cvtpk(p0[6], p0[7])}; pw1 = (v4u){cvtpk(p0[8], p0[9]), cvtpk(p0[10], p0[11]), cvtpk(p0[12], p0[13]), cvtpk(p0[14], p0[15])}; \
        pw2 = (v4u){cvtpk(p1[0], p1[1]), cvtpk(p1[2], p1[3]), cvtpk(p1[4], p1[5]), cvtpk(p1[6], p1[7])}; pw3 = (v4u){cvtpk(p1[8], p1[9]), cvtpk(p1[10], p1[11]), cvtpk(p1[12], p1[13]), cvtpk(p1[14], p1[15])}; \
        PSUM4(pw0); PSUM4(pw1); PSUM4(pw2); PSUM4(pw3); } while (0)
#define PV_STEP(VF, W, e0, EXTRA) do { const bf16x8 pa_ = __builtin_bit_cast(bf16x8, W); \
        _Pragma("unroll") for (int d0 = 0; d0 < 4; ++d0) { const bf16x8 vf_ = (bf16x8){VF.lo[d0][0], VF.lo[d0][1], VF.lo[d0][2], VF.lo[d0][3], VF.hi[d0][0], VF.hi[d0][1], VF.hi[d0][2], VF.hi[d0][3]}; \
            o[d0] = __builtin_amdgcn_mfma_f32_32x32x16_bf16(pa_, vf_, o[d0], 0, 0, 0); EXP2((e0) + 2 * d0); EXTRA; SB(); } } while (0)
#define CIN4(d0) do { cin[4 * (d0)] += d64; cin[4 * (d0) + 1] += d64; cin[4 * (d0) + 2] += d64; cin[4 * (d0) + 3] += d64; } while (0)
#define PV_ONLY(VF, W) do { const bf16x8 pa_ = __builtin_bit_cast(bf16x8, W); \
        _Pragma("unroll") for (int d0 = 0; d0 < 4; ++d0) { const bf16x8 vf_ = (bf16x8){VF.lo[d0][0], VF.lo[d0][1], VF.lo[d0][2], VF.lo[d0][3], VF.hi[d0][0], VF.hi[d0][1], VF.hi[d0][2], VF.hi[d0][3]}; \
            o[d0] = __builtin_amdgcn_mfma_f32_32x32x16_bf16(pa_, vf_, o[d0], 0, 0, 0); } SB(); } while (0)
    v4u pw0, pw1, pw2, pw3;
    int kslot = 0, kslot2 = 2 * KSLOT;
    {
        if (nt > 1) asm volatile("s_waitcnt vmcnt(4) lgkmcnt(0)\n\ts_barrier" ::: "memory"); else asm volatile("s_waitcnt vmcnt(0) lgkmcnt(0)\n\ts_barrier" ::: "memory");
        if (nt > 2) DMA_TILE(jlo + 2, kslot2, 2 * VSLOT);
        f32x16 p0, p1;
        qkt(p0, p1, (lds_cptr)(shm + kslot + comp * 8192), qr, cin, onesf, b32f, b64f, r32, hi); SB();
        MASK_TILE(jlo);
        float sacc = 0.f;
#pragma unroll
        for (int e = 0; e < 32; e += 2) EXP2(e);
        PACK_P(); l_reg += sacc;
        kslot2 = kslot; kslot = KSLOT;
    }
    for (int it = 1; it < nt; ++it) {
        const int j = jlo + it;
        if (it + 1 < nt) asm volatile("s_waitcnt vmcnt(4) lgkmcnt(0)\n\ts_barrier" ::: "memory"); else asm volatile("s_waitcnt vmcnt(0) lgkmcnt(0)\n\ts_barrier" ::: "memory");
        APROF(0);
        if (it + 2 < nt) DMA_TILE(j + 2, kslot2, ((it + 2) & 3) * VSLOT);
        f32x16 p0, p1;
        qkt(p0, p1, (lds_cptr)(shm + kslot + comp * 8192), qr, cin, onesf, b32f, b64f, r32, hi); SB();
        APROF(1);
        MASK_TILE(j);
        float sacc = 0.f;
        { VFrag vA, vB; const unsigned vb = vbl + (unsigned)(((it - 1) & 3) * VSLOT); SB();
          vrd4<0>(vA, vb); vrd4<1>(vB, vb); asm volatile("s_waitcnt lgkmcnt(8)" ::: "memory"); SB();
          PV_STEP(vA, pw0, 0, (void)0);
          vrd4<2>(vA, vb); asm volatile("s_waitcnt lgkmcnt(8)" ::: "memory"); SB();
          PV_STEP(vB, pw1, 8, { pw0[d0] = cvtpk(p0[2 * d0], p0[2 * d0 + 1]); PSUM(pw0[d0]); });
          vrd4<3>(vB, vb); asm volatile("s_waitcnt lgkmcnt(8)" ::: "memory"); SB();
          PV_STEP(vA, pw2, 16, { pw1[d0] = cvtpk(p0[8 + 2 * d0], p0[9 + 2 * d0]); PSUM(pw1[d0]); });
          asm volatile("s_waitcnt lgkmcnt(0)" ::: "memory"); SB();
          PV_STEP(vB, pw3, 24, { pw2[d0] = cvtpk(p1[2 * d0], p1[2 * d0 + 1]); PSUM(pw2[d0]); }); }
        pw3 = (v4u){cvtpk(p1[8], p1[9]), cvtpk(p1[10], p1[11]), cvtpk(p1[12], p1[13]), cvtpk(p1[14], p1[15])}; PSUM4(pw3); l_reg += sacc;
        APROF(3);
        kslot2 = kslot; kslot = (kslot == 2 * KSLOT) ? 0 : kslot + KSLOT;
    }
    {
        VFrag vA, vB; const unsigned vb = vbl + (unsigned)(((nt - 1) & 3) * VSLOT); SB();
        vrd4<0>(vA, vb); vrd4<1>(vB, vb); asm volatile("s_waitcnt lgkmcnt(8)" ::: "memory"); SB();
        PV_ONLY(vA, pw0);
        vrd4<2>(vA, vb); asm volatile("s_waitcnt lgkmcnt(8)" ::: "memory"); SB();
        PV_ONLY(vB, pw1);
        vrd4<3>(vB, vb); asm volatile("s_waitcnt lgkmcnt(8)" ::: "memory"); SB();
        PV_ONLY(vA, pw2);
        asm volatile("s_waitcnt lgkmcnt(0)" ::: "memory"); SB();
        PV_ONLY(vB, pw3);
    }
#undef SB
#undef MASK_TILE
#undef EXP2
#undef PACK_P
#undef PSUM
#undef PSUM4
#undef PV_STEP
#undef CIN4
#undef PV_ONLY
#undef DMA_TILE
#undef ATT_GLDS
#undef ATT_SB64
    APROF(4);
    { auto rr = __builtin_amdgcn_permlane32_swap(__float_as_uint(l_reg), __float_as_uint(l_reg), false, false); l_reg = __uint_as_float(rr[0]) + __uint_as_float(rr[1]); }
    LAS float* wsf = (LAS float*)(shm + L_WS) + wid * 64;
    if (hi == 0) wsf[r32] = l_reg;
    asm volatile("s_waitcnt lgkmcnt(0)" ::: "memory");
    float rli[16];
#pragma unroll
    for (int r = 0; r < 16; ++r) rli[r] = __builtin_amdgcn_rcpf(wsf[crow(r, hi)]) * (comp ? lam : 1.f);
    asm volatile("s_waitcnt lgkmcnt(0)\n\ts_barrier" ::: "memory");
    LAS float* XO = (LAS float*)(shm + L_XO) + (32 * wq) * XOS;
    if (comp == 1) {
#pragma unroll
        for (int d0 = 0; d0 < 4; ++d0)
#pragma unroll
            for (int r = 0; r < 16; ++r) XO[crow(r, hi) * XOS + 32 * d0 + r32] = o[d0][r] * rli[r];
    }
    asm volatile("s_waitcnt lgkmcnt(0)\n\ts_barrier" ::: "memory");
    if (comp == 0) {
#pragma unroll
        for (int d0 = 0; d0 < 4; ++d0)
#pragma unroll
            for (int r = 0; r < 16; ++r) { LAS float* p = XO + crow(r, hi) * XOS + 32 * d0 + r32; *p = o[d0][r] * rli[r] - *p; }
        asm volatile("s_waitcnt lgkmcnt(0)" ::: "memory");
        const int row = lane >> 1, half = lane & 1;
        const LAS f32x4* rp = (const LAS f32x4*)(XO + row * XOS + 64 * half);
        f32x4 v[16]; float ss = 0.f;
#pragma unroll
        for (int i = 0; i < 16; ++i) { v[i] = rp[i]; ss += (v[i][0] * v[i][0] + v[i][1] * v[i][1]) + (v[i][2] * v[i][2] + v[i][3] * v[i][3]); }
        ss += __shfl_xor(ss, 1);
        const float rn = pg8::fast_rsq(ss * (1.f / 128.f) + EPS);
        bf16* op = Out + (rowbase + q0 + 32 * wq + row) * D + h * 128 + 64 * half;
#pragma unroll
        for (int i = 0; i < 8; ++i) { const f32x4 a = v[2 * i] * rn, c = v[2 * i + 1] * rn; *(v4u*)(op + 8 * i) = (v4u){cvtpk(a[0], a[1]), cvtpk(a[2], a[3]), cvtpk(c[0], c[1]), cvtpk(c[2], c[3])}; }
    }
    asm volatile("s_waitcnt lgkmcnt(0)\n\ts_barrier" ::: "memory");
    APROF(5);
}
}

__device__ __forceinline__ void attn_phase(Frame& F, const float* const* in) {
    const float a1 = wave_sum(in[13][F.lane] * in[14][F.lane]), a2 = wave_sum(in[15][F.lane] * in[16][F.lane]);
    const float lam = __expf(a1) - __expf(a2) + LAMBDA_INIT;
    const float B2 = attn_b2(in[11], in[12], F.lane);
    const int b = F.vcu >> 5, jj = F.vcu & 31;
    const int* uo = (const int*)(F.ws + WS_UORDER);
    const bf16* QKV = (const bf16*)(F.ws + WS_BIG); bf16* Out = (bf16*)(F.ws + WS_ACT1);
    if (F.vcu >= 256) return;
    if (F.wave >= 4) __builtin_amdgcn_s_setprio(1);
    unsigned long long prof[6] = {0, 0, 0, 0, 0, 0};
    gu32* qh = F.ctl + CW_ATTQ + 64 * b; volatile LAS unsigned* nxw = F.MISC + 16; (void)jj;
    if (F.tid == 0) nxw[0] = __hip_atomic_fetch_add(qh, 1u, RLX_AGENT);
    __syncthreads();
    unsigned rank = nxw[0];
    while (rank < 512u) {
        unsigned nx = 0u;
        if (F.tid == 0) nx = __hip_atomic_fetch_add(qh, 1u, RLX_AGENT);
        const int un = __builtin_amdgcn_readfirstlane(uo[rank]); const int h = un >> 6, qt = un & 63;
        const float slope2 = LOG2E * __builtin_ldexpf(1.f, -(h + 1));
        att::attn_unit(b, h, qt, QKV, Out, F.lds + RING_OFF, lam, slope2, B2, prof);
        __syncthreads();
        if (F.tid == 0) nxw[0] = nx;
        __syncthreads();
        rank = (unsigned)__builtin_amdgcn_readfirstlane((int)nxw[0]);
    }
    __builtin_amdgcn_s_setprio(0);
#ifdef MK_ATT_PROF
    if (F.tid == 0) { unsigned long long* g = (unsigned long long*)(F.ws + 65536);
#pragma unroll
        for (int i = 0; i < 6; ++i) atomicAdd(g + i, prof[i]); }
#endif
}

__device__ __forceinline__ void router_phase(Frame& F, const bf16* hb) {
    LAS unsigned* cnt = (LAS unsigned*)(F.lds + RING_OFF + 36864);
    const float* Rg = (const float*)(F.ws + WS_ROUTER);
    f32x4 rwa[16], rwb[16];
#pragma unroll
    for (int c = 0; c < 16; ++c) { rwa[c] = ((const f32x4*)Rg)[(16 * F.lane + c) * 2]; rwb[c] = ((const f32x4*)Rg)[(16 * F.lane + c) * 2 + 1]; }
    if (F.tid < 16) cnt[F.tid] = 0u;
    __syncthreads();
    const unsigned long long* st3 = (const unsigned long long*)(F.ws + WS_ST3); int* toke = (int*)(F.ws + WS_TOKE); float* tokg = (float*)(F.ws + WS_TOKG);
    const int wg = blockIdx.x;
    for (int i = 0; i < 32; ++i) {
        const int m = wg * 256 + F.wave * 32 + i;
        const GAS v4u* xr = (const GAS v4u*)(hb + (size_t)m * D) + 2 * F.lane;
        const v4u xa = xr[0], xb2 = xr[1];
        float lg[8];
#pragma unroll
        for (int e = 0; e < 8; ++e) lg[e] = 0.f;
#pragma unroll
        for (int c = 0; c < 16; ++c) { const unsigned w = (c < 8) ? xa[c >> 1] : xb2[(c - 8) >> 1]; const float v = (c & 1) ? bfhi(w) : bflo(w);
            const f32x4 ra = rwa[c], rb = rwb[c];
            lg[0] += v * ra[0]; lg[1] += v * ra[1]; lg[2] += v * ra[2]; lg[3] += v * ra[3]; lg[4] += v * rb[0]; lg[5] += v * rb[1]; lg[6] += v * rb[2]; lg[7] += v * rb[3]; }
        const float r = pg8::st_rscale(st3, m);
#pragma unroll
        for (int e = 0; e < 8; ++e) lg[e] = wave_sum(lg[e]) * r;
        int i1 = 0; float v1 = lg[0];
#pragma unroll
        for (int e = 1; e < 8; ++e) if (lg[e] > v1) { v1 = lg[e]; i1 = e; }
        int i2 = -1; float v2 = -INFINITY;
#pragma unroll
        for (int e = 0; e < 8; ++e) if (e != i1 && lg[e] > v2) { v2 = lg[e]; i2 = e; }
        if (i2 < 0) { i2 = (i1 + 1) & 7; v2 = v1; }
        const float g1 = 1.f / (1.f + __expf(v2 - v1)), g2 = 1.f - g1;
        if (F.lane == 0) { toke[2 * m] = i1; toke[2 * m + 1] = i2; tokg[2 * m] = g1; tokg[2 * m + 1] = g2; lds_inc(cnt + i1); lds_inc(cnt + 8 + i2); }
    }
    __syncthreads();
    if (F.tid < 16) ((unsigned*)(F.ws + WS_WGCNT))[wg * 16 + F.tid] = cnt[F.tid];
}

__device__ __forceinline__ void gather_rows(Frame& F) {
    const bf16* hb = (const bf16*)(F.ws + WS_ACT0); unsigned char* Xs = F.ws + WS_ACT1; const int* toks = (const int*)(F.ws + WS_TOKS);
    const int wg = blockIdx.x;
    for (int i = 0; i < 32; i += 4) {
        v4u a[4], b[4]; int s0[4], s1[4];
#pragma unroll
        for (int q = 0; q < 4; ++q) { const int m = wg * 256 + F.wave * 32 + i + q; s0[q] = toks[2 * m]; s1[q] = toks[2 * m + 1];
            const GAS v4u* s = (const GAS v4u*)(hb + (size_t)m * D) + 2 * F.lane; a[q] = s[0]; b[q] = s[1]; }
#pragma unroll
        for (int q = 0; q < 4; ++q) {
            v4u o;
            o.x = pg8::pk_fp8x4(bflo(a[q].x) * pg8::A8S, bfhi(a[q].x) * pg8::A8S, bflo(a[q].y) * pg8::A8S, bfhi(a[q].y) * pg8::A8S); o.y = pg8::pk_fp8x4(bflo(a[q].z) * pg8::A8S, bfhi(a[q].z) * pg8::A8S, bflo(a[q].w) * pg8::A8S, bfhi(a[q].w) * pg8::A8S);
            o.z = pg8::pk_fp8x4(bflo(b[q].x) * pg8::A8S, bfhi(b[q].x) * pg8::A8S, bflo(b[q].y) * pg8::A8S, bfhi(b[q].y) * pg8::A8S); o.w = pg8::pk_fp8x4(bflo(b[q].z) * pg8::A8S, bfhi(b[q].z) * pg8::A8S, bflo(b[q].w) * pg8::A8S, bfhi(b[q].w) * pg8::A8S);
            *((GAS v4u*)(Xs + (size_t)s0[q] * D) + F.lane) = o;
            *((GAS v4u*)(Xs + ((size_t)SLOTS_MAX + s1[q]) * D) + F.lane) = o;
        }
    }
}

__device__ __forceinline__ void assign_phase(Frame& F) {
    LAS unsigned* tot = (LAS unsigned*)(F.lds + RING_OFF);
    LAS unsigned* pre = tot + 16; LAS unsigned* base = tot + 32; LAS unsigned* cur = tot + 48; LAS unsigned* start = tot + 64;
    const int wg = blockIdx.x;
    if (F.tid < 128) tot[F.tid] = 0u;
    __syncthreads();
    const unsigned* wgcnt = (const unsigned*)(F.ws + WS_WGCNT);
    for (int idx = F.tid; idx < 256 * 16; idx += NWAVES * 64) { const unsigned v = wgcnt[idx]; const int w = idx >> 4, i = idx & 15; lds_add(tot + i, v); if (w < wg) lds_add(pre + i, v); }
    __syncthreads();
    if (F.tid < 2) { unsigned s = 0; for (int e = 0; e < 8; ++e) { start[F.tid * 9 + e] = s; s += (tot[F.tid * 8 + e] + 255u) & ~255u; } start[F.tid * 9 + 8] = s; }
    __syncthreads();
    if (F.tid < 16) { base[F.tid] = start[(F.tid >> 3) * 9 + (F.tid & 7)] + pre[F.tid]; }
    if (wg == 0 && F.tid < 18) ((int*)(F.ws + WS_RTS))[(F.tid / 9) * 16 + (F.tid % 9)] = (int)(start[F.tid] >> 8);
    __syncthreads();
    int* s2t = (int*)(F.ws + WS_S2T); float* sg = (float*)(F.ws + WS_SG); float* sr = (float*)(F.ws + WS_SR); int* toks = (int*)(F.ws + WS_TOKS);
    const int* toke = (const int*)(F.ws + WS_TOKE); const float* tokg = (const float*)(F.ws + WS_TOKG); const unsigned long long* st3 = (const unsigned long long*)(F.ws + WS_ST3);
    if (F.tid < 256) {
        const int m = wg * 256 + F.tid; const float r = pg8::st_rscale(st3, m);
#pragma unroll
        for (int rk = 0; rk < 2; ++rk) { const int e = toke[2 * m + rk]; const unsigned pos = lds_add(cur + rk * 8 + e, 1u); const int slot = (int)(base[rk * 8 + e] + pos);
            s2t[rk * SLOTS_MAX + slot] = m; sg[rk * SLOTS_MAX + slot] = tokg[2 * m + rk]; sr[rk * SLOTS_MAX + slot] = r; toks[2 * m + rk] = slot; }
    }
    if (wg < 16) {
        const int rk = wg >> 3, e = wg & 7; const unsigned lo = start[rk * 9 + e] + tot[wg], hi = start[rk * 9 + e + 1];
        for (unsigned s = lo + F.tid; s < hi; s += NWAVES * 64) { s2t[rk * SLOTS_MAX + s] = -1; sg[rk * SLOTS_MAX + s] = 0.f; sr[rk * SLOTS_MAX + s] = 0.f; }
    }
    __syncthreads();
    __threadfence_block();
    gather_rows(F);
}

struct Args { const float* in[23]; float* out; unsigned char* ws; int ph_lo, ph_hi; };
static_assert(sizeof(Args) == 25 * 8 + 8, "no padding in Args");
__global__ void __launch_bounds__(NWAVES * 64, 2) fwd_kernel(Args args) {
    extern __shared__ __attribute__((aligned(16))) unsigned char lds[];
    Frame F;
    F.lds = (LAS unsigned char*)lds;
    F.MISC = (volatile LAS unsigned*)(F.lds + MISC_OFF);
    F.tid = threadIdx.x; F.lane = F.tid & 63; F.wave = __builtin_amdgcn_readfirstlane(F.tid >> 6);
    F.G = gridDim.x; { const int bx = blockIdx.x; F.vcu = (F.G % 8 == 0) ? (bx % 8) * (F.G / 8) + bx / 8 : bx; }
    F.ws = args.ws; F.ctl = (gu32*)(args.ws + WS_CTL);
    unsigned char* ws = args.ws;
    for (int u = F.tid; u < (LDS_BYTES - LDSCTL_OFF) / 4; u += NWAVES * 64) ((LAS unsigned*)(F.lds + LDSCTL_OFF))[u] = 0u;
    __syncthreads();
    XcdBarrier bar; bar.bar = (unsigned*)(F.ctl + CW_BAR); bar.x = 0; bar.st = nullptr;
    if (N_LAUNCHES == 1) bar = xcd_barrier_post((unsigned*)(F.ctl + CW_BAR), F.MISC + 8);
#define GRID_BAR() do { if (N_LAUNCHES == 1) xcd_barrier(bar); } while (0)
    const int lo = args.ph_lo, hi = args.ph_hi;
#define IN(k) (lo <= (k) && (k) < hi)
#define BOTH(k) (IN(k) && IN((k) + 1))
    bf16* ACT0 = (bf16*)(ws + WS_ACT0); bf16* ACT1 = (bf16*)(ws + WS_ACT1); bf16* BIG = (bf16*)(ws + WS_BIG);
    float* ST0 = (float*)(ws + WS_ST0); unsigned long long* ST1 = (unsigned long long*)(ws + WS_ST1); unsigned long long* ST2 = (unsigned long long*)(ws + WS_ST2); unsigned long long* ST3 = (unsigned long long*)(ws + WS_ST3);

#if defined(MK_DUP_SMALL) || defined(MK_DUP_P0)
    if (IN(0)) { p0_prologue(F, args.in); GRID_BAR(); }
#endif
    if (IN(0)) { p0_prologue(F, args.in); if (BOTH(0)) GRID_BAR(); }
#ifdef MK_DUP_G1
    if (IN(1)) { pg8::Gemm g{ACT0, (const bf16*)(ws + WS_W1), M, 4096, D}; pg8::StaticOrder S; S.init(M, 4096, F.G, (int)blockIdx.x);
        pg8::EpiHgrnIn E{BIG, ST0, (const float*)(ws + WS_LB), (float*)(ws + WS_DEND)};
        pg8::gemm_phase<pg8::EpiHgrnIn, pg8::StaticOrder, true, true>(F.lds + RING_OFF, g, S, E); GRID_BAR(); }
#endif
    if (IN(1)) {
        pg8::Gemm g{ACT0, (const bf16*)(ws + WS_W1), M, 4096, D}; pg8::StaticOrder S; S.init(M, 4096, F.G, (int)blockIdx.x);
        pg8::EpiHgrnIn E{BIG, ST0, (const float*)(ws + WS_LB), (float*)(ws + WS_DEND)};
        pg8::gemm_phase<pg8::EpiHgrnIn, pg8::StaticOrder, true, true>(F.lds + RING_OFF, g, S, E);
        if (BOTH(1)) GRID_BAR();
    }
#if defined(MK_DUP_SMALL) || defined(MK_DUP_SCAN)
    if (IN(2)) { scan_phase(F); GRID_BAR(); }
#endif
    if (IN(2)) { scan_phase(F); if (BOTH(2)) GRID_BAR(); }
    if (IN(3)) { hgrn_gate_phase(F); if (BOTH(3)) GRID_BAR(); }
    if (IN(4)) {
        pg8::Gemm g{ACT1, (const bf16*)(ws + WS_W2), M, D, D}; pg8::StaticOrder S; S.init(M, D, F.G, (int)blockIdx.x);
        pg8::EpiRes<false> E{nullptr, ACT0, ST1, 1.f};
        pg8::gemm_phase<pg8::EpiRes<false>, pg8::StaticOrder, true, true>(F.lds + RING_OFF, g, S, E);
        if (BOTH(4)) GRID_BAR();
    }
    if (IN(5)) {
        pg8::Gemm g{ACT0, (const bf16*)(ws + WS_W3), M, 2 * FF, D}; pg8::StaticOrder S; S.init(M, 2 * FF, F.G, (int)blockIdx.x);
        pg8::EpiSwiGLU<true> E{nullptr, BIG, FF, ST1, nullptr, 2 * FF / 256, 1.f};
        pg8::gemm_phase<pg8::EpiSwiGLU<true>, pg8::StaticOrder, true, true>(F.lds + RING_OFF, g, S, E);
        if (BOTH(5)) GRID_BAR();
    }
    if (IN(6)) {
        pg8::Gemm g{BIG, (const bf16*)(ws + WS_W4), M, D, FF}; pg8::StaticOrder S; S.init(M, D, F.G, (int)blockIdx.x);
        pg8::EpiRes<false> E{nullptr, ACT0, ST2, pg8::ACC8};
        pg8::gemm_phase<pg8::EpiRes<false>, pg8::StaticOrder, true, true, true>(F.lds + RING_OFF, g, S, E);
        if (BOTH(6)) GRID_BAR();
    }
    if (IN(7)) {
        pg8::Gemm g{ACT0, (const bf16*)(ws + WS_W5), M, 3 * D, D}; pg8::StaticOrder S; S.init(M, 3 * D, F.G, (int)blockIdx.x);
        pg8::EpiQKV E{BIG, ST2, args.in[11], args.in[12]};
        pg8::gemm_phase<pg8::EpiQKV, pg8::StaticOrder, true, true>(F.lds + RING_OFF, g, S, E);
        if (BOTH(7)) GRID_BAR();
    }
#ifdef MK_DUP_ATT
    if (IN(8)) { attn_phase(F, args.in); GRID_BAR(); }
#endif
    if (IN(8)) { attn_phase(F, args.in); if (BOTH(8)) GRID_BAR(); }
    if (IN(9)) {
        pg8::Gemm g{ACT1, (const bf16*)(ws + WS_W6), M, D, D}; pg8::StaticOrder S; S.init(M, D, F.G, (int)blockIdx.x);
        pg8::EpiRes<false> E{nullptr, ACT0, ST3, 1.f};
        pg8::gemm_phase<pg8::EpiRes<false>, pg8::StaticOrder, true, true>(F.lds + RING_OFF, g, S, E);
        if (BOTH(9)) GRID_BAR();
    }
#ifdef MK_DUP_SMALL
    if (IN(10)) { router_phase(F, ACT0); GRID_BAR(); }
    if (IN(11)) { assign_phase(F); GRID_BAR(); }
#endif
    if (IN(10)) { router_phase(F, ACT0); if (BOTH(10)) GRID_BAR(); }
    if (IN(11)) { assign_phase(F); if (BOTH(11)) GRID_BAR(); }
#define MOE_UP(rk, NX) do { pg8::Gemm g{(const bf16*)(ws + WS_ACT1 + (size_t)(rk) * SLOTS_MAX * D), (const bf16*)(ws + WS_W7), 0, 0, D}; pg8::GroupedOrder S; S.init((const int*)(ws + WS_RTS) + 16 * (rk), 2 * EF / 256, F.G, (int)blockIdx.x); \
        S.so.nx = (NX); S.so.sk = 3; \
        pg8::EpiSwiGLU<true, false> E{(void*)(ws + 65536), (bf16*)((unsigned char*)BIG + (size_t)(rk) * SLOTS_MAX * EF), EF, nullptr, (const float*)(ws + WS_SR) + (rk) * SLOTS_MAX, 2 * EF / 256, pg8::ACC8}; \
        pg8::gemm_phase<pg8::EpiSwiGLU<true, false>, pg8::GroupedOrder, true, true, true>(F.lds + RING_OFF, g, S, E); } while (0)
#define MOE_DOWN(rk, FIN) do { pg8::Gemm g{(const bf16*)((const unsigned char*)BIG + (size_t)(rk) * SLOTS_MAX * EF), (const bf16*)(ws + WS_W8), 0, 0, EF}; pg8::GroupedOrder S; S.init((const int*)(ws + WS_RTS) + 16 * (rk), D / 256, F.G, (int)blockIdx.x); \
        pg8::EpiMoeDown<FIN> E{args.out, ACT0, (const int*)(ws + WS_S2T) + (rk) * SLOTS_MAX, (const float*)(ws + WS_SG) + (rk) * SLOTS_MAX, D / 256}; \
        pg8::gemm_phase<pg8::EpiMoeDown<FIN>, pg8::GroupedOrder, true, true, true>(F.lds + RING_OFF, g, S, E); } while (0)
    if (IN(12)) { MOE_UP(0, 0); if (BOTH(12)) GRID_BAR(); }
    if (IN(13)) { MOE_DOWN(0, false); if (BOTH(13)) __syncthreads(); }
    if (IN(14)) { MOE_UP(1, (N_LAUNCHES == 1) ? (__builtin_amdgcn_readfirstlane(((const int*)(ws + WS_RTS))[8]) * (D / 256)) % F.G : 0); if (BOTH(14)) GRID_BAR(); }
    constexpr int TAIL_KS = 7, TAIL_KB = EF / TAIL_KS;
    const unsigned char* Hm1_ = (const unsigned char*)BIG + (size_t)SLOTS_MAX * EF;
    const int* s2t1_ = (const int*)(ws + WS_S2T) + SLOTS_MAX; const float* sg1_ = (const float*)(ws + WS_SG) + SLOTS_MAX;
    if (IN(15)) {
        pg8::GroupedOrder S; S.init((const int*)(ws + WS_RTS) + 16, D / 256, F.G, (int)blockIdx.x); S.so.lim = 4 * F.G;
        { pg8::Gemm g{(const bf16*)Hm1_, (const bf16*)(ws + WS_W8), 0, 0, EF};
          pg8::EpiMoeDown<true> E{args.out, ACT0, s2t1_, sg1_, D / 256};
          pg8::gemm_phase<pg8::EpiMoeDown<true>, pg8::GroupedOrder, true, true, true>(F.lds + RING_OFF, g, S, E); }
        const int ntail = S.so.nwg > 4 * F.G ? (S.so.nwg - 4 * F.G < 36 ? S.so.nwg - 4 * F.G : 36) : 0;
        __syncthreads();
        if ((int)blockIdx.x < ntail * TAIL_KS) {
            const int tu = (int)blockIdx.x / TAIL_KS, ks = (int)blockIdx.x % TAIL_KS;
            pg8::PieceOrder PS; S.unit_at((long)(4 * F.G + tu), PS.u); PS.has = 1;
            int klen_ = TAIL_KB; asm volatile("" : "+s"(klen_));
            pg8::Gemm gp{(const bf16*)(Hm1_ + ks * TAIL_KB), (const bf16*)(ws + WS_W8 + ks * TAIL_KB), 0, 0, klen_, EF};
            pg8::EpiPartial EP{(float*)(ws + WS_ACT1) + (size_t)blockIdx.x * 65536};
            pg8::gemm_phase<pg8::EpiPartial, pg8::PieceOrder, true, true, true>(F.lds + RING_OFF, gp, PS, EP);
        }
        if (BOTH(15)) GRID_BAR();
    }
    if (IN(16)) {
        pg8::GroupedOrder S; S.init((const int*)(ws + WS_RTS) + 16, D / 256, F.G, (int)blockIdx.x);
        const int ntail = S.so.nwg > 4 * F.G ? (S.so.nwg - 4 * F.G < 36 ? S.so.nwg - 4 * F.G : 36) : 0;
        int tid16_ = (int)threadIdx.x; asm volatile("" : "+v"(tid16_));
        for (int idx = (int)blockIdx.x * (NWAVES * 64) + tid16_; idx < ntail * 16384; idx += 256 * (NWAVES * 64)) {
            const int tu = idx >> 14, row = (idx >> 6) & 255, c4 = (idx & 63) * 4;
            pg8::Unit uu; S.unit_at_v((long)(4 * F.G + tu), uu);
            const int slot = uu.pm * 256 + row; const int tok = s2t1_[slot];
            if (tok < 0) continue;
            const float gsc = sg1_[slot] * pg8::ACC8;
            const float* pp = (const float*)(ws + WS_ACT1) + (size_t)(tu * TAIL_KS) * 65536 + row * 256 + c4;
            pg8::f32x4 sum = *(const pg8::f32x4*)pp;
#pragma unroll
            for (int ks = 1; ks < TAIL_KS; ++ks) sum += *(const pg8::f32x4*)(pp + (size_t)ks * 65536);
            const size_t off = (size_t)tok * 1024 + (size_t)(uu.pn & 3) * 256 + c4;
            const pg8::u32x2e wv = *(const pg8::u32x2e*)(ACT0 + off);
            const pg8::f32x4 r = {__builtin_bit_cast(float, wv.x << 16), __builtin_bit_cast(float, wv.x & 0xffff0000u), __builtin_bit_cast(float, wv.y << 16), __builtin_bit_cast(float, wv.y & 0xffff0000u)};
            *(pg8::f32x4*)(args.out + off) = sum * gsc + r;
        }
    }
#undef IN
#undef BOTH
}

#ifdef MK_DEBUG_NAN
__global__ void chk_kernel(const unsigned* buf, size_t nwords, int is_f32, unsigned* flag, unsigned bit) {
    bool bad = false;
    for (size_t i = blockIdx.x * (size_t)blockDim.x + threadIdx.x; i < nwords; i += (size_t)gridDim.x * blockDim.x) { const unsigned w = buf[i];
        if (is_f32) bad |= (w & 0x7f800000u) == 0x7f800000u; else bad |= ((w & 0x7f80u) == 0x7f80u) || ((w & 0x7f800000u) == 0x7f800000u); }
    if (bad) atomicOr(flag, bit);
}
__global__ void cnt_kernel(const unsigned short* buf, size_t n, unsigned* cnt) {
    unsigned c = 0;
    for (size_t i = blockIdx.x * (size_t)blockDim.x + threadIdx.x; i < n; i += (size_t)gridDim.x * blockDim.x) c += ((buf[i] & 0x7f80u) == 0x7f80u) ? 1u : 0u;
    if (c) atomicAdd(cnt, c);
}
__global__ void minlf_kernel(const unsigned short* qfvg, unsigned* mx) {
    unsigned m = 0;
    for (size_t i = blockIdx.x * (size_t)blockDim.x + threadIdx.x; i < (size_t)M * 1024; i += (size_t)gridDim.x * blockDim.x) {
        const size_t row = i >> 10, c = i & 1023; const float v = __builtin_bit_cast(float, (unsigned)qfvg[row * 4096 + 1024 + c] << 16);
        const float q = fminf(fmaxf(-v * 2.f + 0.5f, 0.f), 15.f); m = max(m, (unsigned)q); }
    atomicMax(mx, m);
}
__global__ void maxabs_kernel(const unsigned short* qfvg, unsigned* mx) {
    unsigned m = 0;
    for (size_t i = blockIdx.x * (size_t)blockDim.x + threadIdx.x; i < (size_t)M * 4096; i += (size_t)gridDim.x * blockDim.x) {
        const size_t c = i & 4095; if (c >= 1024 && c < 2048) continue; m = max(m, ((unsigned)qfvg[i] << 16) & 0x7fffffffu); }
    atomicMax(mx, m);
}
__global__ void firstnan_kernel(const unsigned short* buf, size_t n, unsigned* mn) {
    unsigned m = 0xffffffffu;
    for (size_t i = blockIdx.x * (size_t)blockDim.x + threadIdx.x; i < n; i += (size_t)gridDim.x * blockDim.x) if ((buf[i] & 0x7f80u) == 0x7f80u) m = min(m, (unsigned)i);
    atomicMax(mn, ~m);
}
__global__ void report3_kernel(float* out, size_t n, const unsigned* w) {
    for (size_t i = blockIdx.x * (size_t)blockDim.x + threadIdx.x; i < n; i += (size_t)gridDim.x * blockDim.x) out[i] = 0.f;
    __syncthreads();
    if (blockIdx.x == 0 && threadIdx.x == 0) { const float mxv = __builtin_bit_cast(float, w[0]); int A = 0; while (A < 60 && __builtin_ldexpf(1.f, A) < mxv) ++A;
        const unsigned idx = ~w[1];    const unsigned row = idx >> 10; const unsigned B = (row & 8191u) >> 9;
        out[0] = 8192.f * (1.f + (float)B / 16.f) * __builtin_ldexpf(1.f, A); }
}
__global__ void report2_kernel(float* out, size_t n, const unsigned* w) {
    for (size_t i = blockIdx.x * (size_t)blockDim.x + threadIdx.x; i < n; i += (size_t)gridDim.x * blockDim.x) out[i] = 0.f;
    __syncthreads();
    if (blockIdx.x == 0 && threadIdx.x == 0) { const unsigned cnt = w[0], B = w[1]; int A = 0; while ((1ull << A) < (unsigned long long)cnt + 1ull) ++A; out[0] = 8192.f * (1.f + (float)B / 16.f) * __builtin_ldexpf(1.f, A); }
}
__global__ void report_prof_kernel(float* out, size_t n, const unsigned long long* g, int a, int b) {
    for (size_t i = blockIdx.x * (size_t)blockDim.x + threadIdx.x; i < n; i += (size_t)gridDim.x * blockDim.x) out[i] = 0.f;
    __syncthreads();
    if (blockIdx.x == 0 && threadIdx.x == 0) { double tot = 0; for (int i = 0; i < 6; ++i) tot += (double)g[i]; const double fa = (double)g[a] / tot, fb = (double)g[b < 0 ? 0 : b] / tot;
        if (b < 0) out[0] = (float)(1.0e4 * (double)(int)(fa * (double)(-b)) + 1.0e3); else
        out[0] = (float)(1.0e6 * ((double)(int)(fa * 10.0 + 0.5) * 10.0 + (double)(int)(fb * 10.0 + 0.5)) + 1.0e4); }
}
__global__ void report_kernel(float* out, size_t n, const unsigned* flag) {
    for (size_t i = blockIdx.x * (size_t)blockDim.x + threadIdx.x; i < n; i += (size_t)gridDim.x * blockDim.x) out[i] = 0.f;
    __syncthreads();
    if (blockIdx.x == 0 && threadIdx.x == 0) out[0] = 8192.f * __builtin_ldexpf(1.f, 2 * (int)(*flag & 15u));
}
#endif
extern "C" void kernel_launch(void* const* d_in, const int* in_sizes, int n_in, void* d_out, int out_size, void* d_ws, size_t ws_size, hipStream_t stream) {
    static int grid = 0;
    if (grid == 0) {
        if (n_in != 23 || in_sizes[0] != M * D || out_size != M * D || ws_size < WS_END) { fprintf(stderr, "kernel_launch: unexpected shapes (n_in %d, in0 %d, out %d, ws %zu); nothing launched\n", n_in, n_in > 0 ? in_sizes[0] : -1, out_size, ws_size); grid = -1; return; }
        int dev = 0, cus = 0, per_cu = 0;
        if (hipGetDevice(&dev) != hipSuccess || hipDeviceGetAttribute(&cus, hipDeviceAttributeMultiprocessorCount, dev) != hipSuccess) { grid = -1; return; }
        if (hipFuncSetAttribute((const void*)fwd_kernel, hipFuncAttributeMaxDynamicSharedMemorySize, LDS_BYTES) != hipSuccess) { fprintf(stderr, "kernel_launch: hipFuncSetAttribute failed\n"); grid = -1; return; }
        if (hipOccupancyMaxActiveBlocksPerMultiprocessor(&per_cu, (const void*)fwd_kernel, NWAVES * 64, LDS_BYTES) != hipSuccess || per_cu < 1) fprintf(stderr, "kernel_launch: occupancy query reports %d\n", per_cu);
        (void)hipGetLastError();
        grid = cus;
        if (grid != 256) fprintf(stderr, "kernel_launch: %d CUs; this kernel is built for 256\n", grid);
    }
    if (grid < 0) return;
    if (hipMemsetAsync((char*)d_ws + WS_CTL, 0, CTL_ZERO_BYTES, stream) != hipSuccess) return;
    Args a{};
    for (int i = 0; i < 23; ++i) a.in[i] = (const float*)d_in[i];
    a.out = (float*)d_out; a.ws = (unsigned char*)d_ws;
#ifndef MK_CUT
#define MK_CUT N_PHASES
#endif
    for (int li = 0; li < N_LAUNCHES; ++li) {
        a.ph_lo = (N_LAUNCHES == 1) ? 0 : li; a.ph_hi = (N_LAUNCHES == 1) ? MK_CUT : li + 1;
        if (a.ph_lo >= MK_CUT) break;
        hipLaunchKernelGGL(fwd_kernel, dim3(grid), dim3(NWAVES * 64), LDS_BYTES, stream, a);
        if (hipPeekAtLastError() != hipSuccess) break;
#ifdef MK_DEBUG_NAN
        { unsigned* flag = (unsigned*)d_ws + 2; unsigned char* w = (unsigned char*)d_ws;
          MK_DEBUG_CHECKS }
#endif
    }
#ifdef MK_DEBUG_NAN
    MK_DEBUG_REPORT
#endif
}
```
